# Optimizing an MI355X kernel written in HIP

```python
import math
import jax, jax.numpy as jnp
from jax import lax
import numpy as np

D_MODEL = 1024
BATCH = 4
SEQ = 4096
DEPTH = 2

CHUNK = 64
Q_BLOCK = 128
NORM_EPS = 1e-6

DIFF_HEADS = 4
DIFF_HEAD_DIM = 64
DIFF_V_DIM = 2 * DIFF_HEAD_DIM
DIFF_WIDTH = DIFF_HEADS * DIFF_V_DIM
DIFF_QK_COLS = DIFF_HEADS * 2 * DIFF_HEAD_DIM
CHK_HEADS = 8
CHK_HEAD_DIM = 64
CHK_WIDTH = CHK_HEADS * CHK_HEAD_DIM
CHK_LEFT_CHUNKS = 8
CHK_BAND = (CHK_LEFT_CHUNKS + 1) * CHUNK
REL_CLIP = 256
MLA_HEADS = 8
MLA_Q_LORA = 384
MLA_KV_LORA = 256
MLA_NOPE = 64
MLA_ROPE = 32
MLA_V = 64
MLA_WIDTH = MLA_HEADS * MLA_V
ROPE_THETA = 10000.0
N_BRANCHES = 3
IN_SPLITS = (DIFF_QK_COLS, DIFF_QK_COLS, DIFF_WIDTH,
             CHK_WIDTH, CHK_WIDTH, CHK_WIDTH,
             MLA_Q_LORA, MLA_KV_LORA + MLA_ROPE,
             N_BRANCHES * D_MODEL)
IN_WIDTH = sum(IN_SPLITS)
N_EXPERTS = 16
N_GROUPS = 4
EXPERTS_PER_GROUP = N_EXPERTS // N_GROUPS
TOP_K = 2
MOE_D_FF = 512

kernel_name = "hybrid_chunk_causal_diff_chunk_mla_grouped_moe"


def rms_norm(x, g, eps=NORM_EPS):
    xf = x.astype(jnp.float32)
    y = xf * lax.rsqrt(jnp.mean(xf * xf, axis=-1, keepdims=True) + eps)
    return (y * g.astype(jnp.float32)).astype(x.dtype)


def apply_rope(x, cos, sin):
    xf = x.astype(jnp.float32)
    x1, x2 = jnp.split(xf, 2, axis=-1)
    return jnp.concatenate([x1 * cos - x2 * sin, x1 * sin + x2 * cos], axis=-1).astype(x.dtype)


def to_blocks(t):
    b, s = t.shape[:2]
    return jnp.moveaxis(t.reshape(b, s // Q_BLOCK, Q_BLOCK, *t.shape[2:]), 1, 0)


def from_blocks(t):
    nb, b, qb = t.shape[:3]
    return jnp.moveaxis(t, 0, 1).reshape(b, nb * qb, *t.shape[3:])


def chunk_causal_mask(blk, seq):
    q_pos = blk * Q_BLOCK + jnp.arange(Q_BLOCK)
    k_pos = jnp.arange(seq)
    allowed = (k_pos[None, :] // CHUNK) <= (q_pos[:, None] // CHUNK)
    return allowed, q_pos, k_pos


def diff_attention(q, k, v, lam, slopes):
    seq = q.shape[1]
    scale = DIFF_HEAD_DIM ** -0.5

    def one_block(args):
        qb, blk = args
        allowed, q_pos, k_pos = chunk_causal_mask(blk, seq)
        dist = jnp.abs(q_pos[:, None] - k_pos[None, :]).astype(jnp.float32)
        alibi = -slopes[:, None, None] * dist[None]
        s = jnp.einsum('bqhcd,bkhcd->bhcqk', qb, k).astype(jnp.float32) * scale
        s = jnp.where(allowed, s + alibi[None, :, None], -jnp.inf)
        p = jax.nn.softmax(s, axis=-1)
        a = p[:, :, 0] - lam * p[:, :, 1]
        return jnp.einsum('bhqk,bkhe->bqhe', a.astype(v.dtype), v)

    out = lax.map(one_block, (to_blocks(q), jnp.arange(seq // Q_BLOCK)))
    return from_blocks(out)


def chunked_band_attention(q, k, v, rel_table):
    b, seq, h, d = q.shape
    nc = seq // CHUNK
    qc = q.reshape(b, nc, CHUNK, h, d)
    pad = ((0, 0), (CHK_LEFT_CHUNKS, 0), (0, 0), (0, 0), (0, 0))
    kp = jnp.pad(k.reshape(b, nc, CHUNK, h, d), pad)
    vp = jnp.pad(v.reshape(b, nc, CHUNK, h, d), pad)
    band_idx = jnp.arange(nc)[:, None] + jnp.arange(CHK_LEFT_CHUNKS + 1)[None, :]
    kb = kp[:, band_idx].reshape(b, nc, CHK_BAND, h, d)
    vb = vp[:, band_idx].reshape(b, nc, CHK_BAND, h, d)
    q_i = jnp.arange(CHUNK)
    k_i = jnp.arange(CHK_BAND)
    rel = jnp.clip(q_i[:, None] + CHK_LEFT_CHUNKS * CHUNK - k_i[None, :], -REL_CLIP, REL_CLIP) + REL_CLIP
    bias = rel_table[:, rel].astype(jnp.float32)
    src_chunk = jnp.arange(nc)[:, None] - CHK_LEFT_CHUNKS + (k_i // CHUNK)[None, :]
    valid = src_chunk >= 0
    s = jnp.einsum('bnqhd,bnkhd->bhnqk', qc, kb).astype(jnp.float32) * (d ** -0.5)
    s = jnp.where(valid[None, None, :, None, :], s + bias[None, :, None], -jnp.inf)
    p = jax.nn.softmax(s, axis=-1)
    o = jnp.einsum('bhnqk,bnkhd->bnqhd', p.astype(v.dtype), vb)
    return o.reshape(b, seq, h, d)


def mla_attention(q_nope, q_rope, k_nope, k_rope, v):
    seq = q_nope.shape[1]
    scale = (MLA_NOPE + MLA_ROPE) ** -0.5

    def one_block(args):
        qn, qr, blk = args
        allowed, _, _ = chunk_causal_mask(blk, seq)
        s = (jnp.einsum('bqhd,bkhd->bhqk', qn, k_nope)
             + jnp.einsum('bqhr,bkr->bhqk', qr, k_rope)).astype(jnp.float32) * scale
        s = jnp.where(allowed, s, -jnp.inf)
        p = jax.nn.softmax(s, axis=-1)
        return jnp.einsum('bhqk,bkhd->bqhd', p.astype(v.dtype), v)

    out = lax.map(one_block, (to_blocks(q_nope), to_blocks(q_rope), jnp.arange(seq // Q_BLOCK)))
    return from_blocks(out)


def token_mixer(h, layer, cos, sin, w_in, lq1, lk1, lq2, lk2, subln_g, rel_table,
                q_norm_g, w_q_b, kv_norm_g, w_kv_b, w_br_diff, w_br_chunk, w_br_mla, w_out):
    b, seq, _ = h.shape
    f32 = jnp.float32
    split_points = np.cumsum(IN_SPLITS)[:-1].tolist()
    dq, dk, dv, cq, ck, cv, mq, mkv, gate_logits = jnp.split(h @ w_in, split_points, axis=-1)

    lam_init = 0.8 - 0.6 * math.exp(-0.3 * layer)
    lam = (jnp.exp(jnp.sum(lq1.astype(f32) * lk1.astype(f32)))
           - jnp.exp(jnp.sum(lq2.astype(f32) * lk2.astype(f32))) + lam_init)
    slopes = jnp.exp2(-8.0 / DIFF_HEADS * jnp.arange(1, DIFF_HEADS + 1, dtype=f32))
    y_a = diff_attention(dq.reshape(b, seq, DIFF_HEADS, 2, DIFF_HEAD_DIM),
                         dk.reshape(b, seq, DIFF_HEADS, 2, DIFF_HEAD_DIM),
                         dv.reshape(b, seq, DIFF_HEADS, DIFF_V_DIM), lam, slopes)
    y_a = (rms_norm(y_a, subln_g) * (1.0 - lam_init)).reshape(b, seq, DIFF_WIDTH)

    y_b = chunked_band_attention(cq.reshape(b, seq, CHK_HEADS, CHK_HEAD_DIM),
                                 ck.reshape(b, seq, CHK_HEADS, CHK_HEAD_DIM),
                                 cv.reshape(b, seq, CHK_HEADS, CHK_HEAD_DIM), rel_table)
    y_b = y_b.reshape(b, seq, CHK_WIDTH)

    q_full = (rms_norm(mq, q_norm_g) @ w_q_b).reshape(b, seq, MLA_HEADS, MLA_NOPE + MLA_ROPE)
    q_nope, q_rope = jnp.split(q_full, [MLA_NOPE], axis=-1)
    c_kv, k_rope = jnp.split(mkv, [MLA_KV_LORA], axis=-1)
    kv = (rms_norm(c_kv, kv_norm_g) @ w_kv_b).reshape(b, seq, MLA_HEADS, MLA_NOPE + MLA_V)
    k_nope, v_c = jnp.split(kv, [MLA_NOPE], axis=-1)
    q_rope = apply_rope(q_rope, cos[None, :, None, :], sin[None, :, None, :])
    k_rope = apply_rope(k_rope, cos[None], sin[None])
    y_c = mla_attention(q_nope, q_rope, k_nope, k_rope, v_c).reshape(b, seq, MLA_WIDTH)

    g = jax.nn.sigmoid(gate_logits.astype(f32)).astype(h.dtype).reshape(b, seq, N_BRANCHES, D_MODEL)
    merged = (g[:, :, 0] * (y_a @ w_br_diff) + g[:, :, 1] * (y_b @ w_br_chunk)
              + g[:, :, 2] * (y_c @ w_br_mla))
    return merged @ w_out


def grouped_moe(h, w_router, router_bias, w_gate, w_up, w_down):
    b, seq, d = h.shape
    t = h.reshape(-1, d)
    scores = jax.nn.sigmoid((t @ w_router).astype(jnp.float32))
    sel = scores + router_bias.astype(jnp.float32)
    grouped = sel.reshape(-1, N_GROUPS, EXPERTS_PER_GROUP)
    group_score = lax.top_k(grouped, TOP_K)[0].sum(-1)
    best_group = jnp.argmax(group_score, axis=-1)
    in_group = (jnp.arange(N_EXPERTS) // EXPERTS_PER_GROUP)[None, :] == best_group[:, None]
    _, idx = lax.top_k(jnp.where(in_group, sel, -jnp.inf), TOP_K)
    w = jnp.take_along_axis(scores, idx, axis=-1)
    w = w / jnp.sum(w, axis=-1, keepdims=True)
    combine = jnp.sum(jax.nn.one_hot(idx, N_EXPERTS, dtype=jnp.float32) * w[..., None], axis=1)
    combine = combine.astype(t.dtype)
    out = jnp.zeros(t.shape, t.dtype)
    for e in range(N_EXPERTS):
        he = jax.nn.silu(t @ w_gate[e]) * (t @ w_up[e])
        out = out + combine[:, e:e + 1] * (he @ w_down[e])
    return out.reshape(b, seq, d)


def setup_inputs(seed: int = 0) -> dict:
    key = jax.random.key(seed)
    keys = iter(jax.random.split(key, 40))
    f32 = jnp.float32

    def nrm(shape, scale):
        return scale * jax.random.normal(next(keys), shape, f32)

    def gain(shape):
        return 1.0 + nrm(shape, 0.05)

    L = DEPTH
    return {
        "x": nrm((BATCH, SEQ, D_MODEL), 1.0),
        "c": nrm((BATCH, D_MODEL), 1.0),
        "w_mod": nrm((L, D_MODEL, 6 * D_MODEL), 0.5 * D_MODEL ** -0.5),
        "b_mod": nrm((L, 6 * D_MODEL), 0.02),
        "g_norm_mix": gain((L, D_MODEL)),
        "g_norm_ffn": gain((L, D_MODEL)),
        "w_in": nrm((L, D_MODEL, IN_WIDTH), D_MODEL ** -0.5),
        "diff_lambda_q1": nrm((L, DIFF_HEAD_DIM), 0.1),
        "diff_lambda_k1": nrm((L, DIFF_HEAD_DIM), 0.1),
        "diff_lambda_q2": nrm((L, DIFF_HEAD_DIM), 0.1),
        "diff_lambda_k2": nrm((L, DIFF_HEAD_DIM), 0.1),
        "diff_subln_g": gain((L, DIFF_V_DIM)),
        "chunk_rel_bias": nrm((L, CHK_HEADS, 2 * REL_CLIP + 1), 0.2),
        "mla_q_norm_g": gain((L, MLA_Q_LORA)),
        "mla_w_q_b": nrm((L, MLA_Q_LORA, MLA_HEADS * (MLA_NOPE + MLA_ROPE)), MLA_Q_LORA ** -0.5),
        "mla_kv_norm_g": gain((L, MLA_KV_LORA)),
        "mla_w_kv_b": nrm((L, MLA_KV_LORA, MLA_HEADS * (MLA_NOPE + MLA_V)), MLA_KV_LORA ** -0.5),
        "w_branch_diff": nrm((L, DIFF_WIDTH, D_MODEL), DIFF_WIDTH ** -0.5),
        "w_branch_chunk": nrm((L, CHK_WIDTH, D_MODEL), CHK_WIDTH ** -0.5),
        "w_branch_mla": nrm((L, MLA_WIDTH, D_MODEL), MLA_WIDTH ** -0.5),
        "w_out": nrm((L, D_MODEL, D_MODEL), D_MODEL ** -0.5),
        "w_router": nrm((D_MODEL, N_EXPERTS), D_MODEL ** -0.5),
        "router_bias": nrm((N_EXPERTS,), 0.01),
        "w_exp_gate": nrm((L, N_EXPERTS, D_MODEL, MOE_D_FF), D_MODEL ** -0.5),
        "w_exp_up": nrm((L, N_EXPERTS, D_MODEL, MOE_D_FF), D_MODEL ** -0.5),
        "w_exp_down": nrm((L, N_EXPERTS, MOE_D_FF, D_MODEL), MOE_D_FF ** -0.5),
        "g_final": gain((D_MODEL,)),
    }


def reference(x, c, w_mod, b_mod, g_norm_mix, g_norm_ffn, w_in,
              diff_lambda_q1, diff_lambda_k1, diff_lambda_q2, diff_lambda_k2, diff_subln_g,
              chunk_rel_bias, mla_q_norm_g, mla_w_q_b, mla_kv_norm_g, mla_w_kv_b,
              w_branch_diff, w_branch_chunk, w_branch_mla, w_out,
              w_router, router_bias, w_exp_gate, w_exp_up, w_exp_down, g_final):
    seq = x.shape[1]
    pos = jnp.arange(seq, dtype=jnp.float32)
    inv_freq = 1.0 / (ROPE_THETA ** (jnp.arange(0, MLA_ROPE, 2, dtype=jnp.float32) / MLA_ROPE))
    ang = pos[:, None] * inv_freq[None, :]
    cos, sin = jnp.cos(ang), jnp.sin(ang)
    c_act = jax.nn.silu(c)
    for l in range(DEPTH):
        mod = c_act @ w_mod[l] + b_mod[l]
        sh1, sc1, gt1, sh2, sc2, gt2 = jnp.split(mod[:, None, :], 6, axis=-1)
        h = rms_norm(x, g_norm_mix[l]) * (1 + sc1) + sh1
        y = token_mixer(h, l, cos, sin, w_in[l],
                        diff_lambda_q1[l], diff_lambda_k1[l], diff_lambda_q2[l], diff_lambda_k2[l],
                        diff_subln_g[l], chunk_rel_bias[l],
                        mla_q_norm_g[l], mla_w_q_b[l], mla_kv_norm_g[l], mla_w_kv_b[l],
                        w_branch_diff[l], w_branch_chunk[l], w_branch_mla[l], w_out[l])
        x = x + gt1 * y
        h = rms_norm(x, g_norm_ffn[l]) * (1 + sc2) + sh2
        x = x + gt2 * grouped_moe(h, w_router, router_bias, w_exp_gate[l], w_exp_up[l], w_exp_down[l])
    return rms_norm(x, g_final)
```

```cpp
#include <hip/hip_runtime.h>
#include <cstdio>
#include <cstdint>

constexpr int T = 16384, D = 1024, NB = 4, S = 4096, NL = 2;
constexpr int YP = 3840;
constexpr int C_DQ = 0, C_DK = 512, C_DV = 1024, C_CQ = 1536, C_CK = 2048, C_CV = 2560, C_MQ = 3072, C_CKV = 3456, C_KR = 3712, C_G = 3840;
constexpr int INW = 6816;
constexpr float EPS = 1e-6f;
constexpr int NE = 16, FF = 512;
constexpr int HC_ROWS = 36864;

constexpr size_t MiB = 1u << 20;
constexpr size_t WS_CTL = 0, CTL_BYTES = 128 * 1024;
constexpr size_t WS_MODP = 1 * MiB;
constexpr size_t WS_MOD = 4 * MiB;
constexpr size_t WS_SSQ = 4 * MiB + 512 * 1024;
constexpr size_t WS_TOKW = 6 * MiB;
constexpr size_t WS_ROPE = 6 * MiB + 512 * 1024;
constexpr size_t WS_LIST = 7 * MiB;
constexpr size_t WS_WIN = 8 * MiB;
constexpr size_t WS_WQ = 22 * MiB;
constexpr size_t WS_WKV = 23 * MiB;
constexpr size_t WS_WBR = 24 * MiB;
constexpr size_t WS_WOUT = 27 * MiB;
constexpr size_t WS_WGU = 30 * MiB;
constexpr size_t WS_WD = 62 * MiB;
constexpr size_t WS_HB = 78 * MiB;
constexpr size_t WS_KM = 110 * MiB;
constexpr size_t WS_VM = 134 * MiB;
constexpr size_t WS_Y = 150 * MiB;
constexpr size_t WS_G = 270 * MiB;
constexpr size_t WS_QM = 318 * MiB;
constexpr size_t WS_HC = 150 * MiB;
constexpr size_t WS_OS = 186 * MiB;
constexpr size_t WS_END = 366 * MiB;
constexpr int CW_CNT = 64;
constexpr int CW_LAM = 256;
constexpr int CW_CMAX = 16384;
constexpr int CW_MLAP = 1024;
constexpr int CW_Q = 512;
constexpr int CW_GUD = 2048;
constexpr int CW_BRO = 2560;
constexpr int CW_OUT = 2816;
constexpr int CW_INQ = 3072;
constexpr int CW_BAR = 4096;

typedef unsigned short bf16_t;
typedef float f32x4 __attribute__((ext_vector_type(4)));
typedef float f32x2 __attribute__((ext_vector_type(2)));
typedef unsigned u32x4 __attribute__((ext_vector_type(4)));
typedef unsigned u32x2 __attribute__((ext_vector_type(2)));
#define LAS __attribute__((address_space(3)))
#define GAS __attribute__((address_space(1)))
typedef GAS unsigned char* gptr;
#define INP(i) ((const GAS float*)p.in[i])

__device__ __forceinline__ unsigned f2bf(float f) { unsigned u = __builtin_bit_cast(unsigned, f); return (u + 0x7fffu + ((u >> 16) & 1u)) >> 16; }
__device__ __forceinline__ float bf2f(unsigned h) { return __builtin_bit_cast(float, (h & 0xffffu) << 16); }
__device__ __forceinline__ float bflo(unsigned w) { return __builtin_bit_cast(float, w << 16); }
__device__ __forceinline__ float bfhi(unsigned w) { return __builtin_bit_cast(float, w & 0xffff0000u); }
__device__ __forceinline__ unsigned pk2(float lo, float hi) { return f2bf(lo) | (f2bf(hi) << 16); }
typedef _Float16 h16x2 __attribute__((ext_vector_type(2)));
__device__ __forceinline__ unsigned pkh(float lo, float hi) { h16x2 h; h.x = (_Float16)lo; h.y = (_Float16)hi; return __builtin_bit_cast(unsigned, h); }
__device__ __forceinline__ float hlo(unsigned w) { return (float)__builtin_bit_cast(h16x2, w).x; }
__device__ __forceinline__ float hhi(unsigned w) { return (float)__builtin_bit_cast(h16x2, w).y; }
__device__ __forceinline__ float wave_sum(float v) {
#pragma unroll
    for (int o = 1; o < 64; o <<= 1) v += __shfl_xor(v, o);
    return v;
}
__device__ __forceinline__ float wave_max(float v) {
#pragma unroll
    for (int o = 1; o < 64; o <<= 1) v = fmaxf(v, __shfl_xor(v, o));
    return v;
}
__device__ __forceinline__ float sigmoidf_(float x) { return 1.f / (1.f + __expf(-x)); }

__device__ __forceinline__ int ltid() { int t = threadIdx.x; asm volatile("" : "+v"(t)); return t; }
__device__ __forceinline__ int lsg(int v) { asm volatile("" : "+s"(v)); return v; }
struct P {
    const float* in[27];
    float* out;
    unsigned char* ws;
    int ph_lo, ph_hi, heavy, pad;
};
enum { I_X = 0, I_C, I_WMOD, I_BMOD, I_GMIX, I_GFFN, I_WIN, I_LQ1, I_LK1, I_LQ2, I_LK2, I_SUBLN, I_REL, I_QNG, I_WQB, I_KVNG, I_WKVB, I_WBD, I_WBC, I_WBM, I_WOUT, I_WR, I_RB, I_WEG, I_WEU, I_WED, I_GF };

__device__ __forceinline__ void ph0(const P& p, gptr ws, LAS unsigned char* lds, int vb, int nvb) {
    const int tid = ltid(), lane = tid & 63, wave = tid >> 6;
    LAS float* cact = (LAS float*)lds;
    for (int i = tid; i < 4096; i += 512) { const float c = INP(I_C)[i]; cact[i] = c / (1.f + expf(-c)); }
    __syncthreads();
    GAS float* modp = (GAS float*)(ws + WS_MODP);
    const int gw = vb * 8 + wave, NGW = nvb * 8;
    for (int task = gw; task < 1536; task += NGW) {
        const int l = task / 768, r = task % 768, kc = r / 48, jg = r % 48;
        const GAS float* w = INP(I_WMOD) + (size_t)l * 1024 * 6144 + (size_t)(kc * 64) * 6144 + jg * 128 + lane * 2;
        f32x2 acc[4] = {{0.f, 0.f}, {0.f, 0.f}, {0.f, 0.f}, {0.f, 0.f}};
#pragma unroll 32
        for (int k = 0; k < 64; ++k) {
            const f32x2 v = *(const GAS f32x2*)(w + (size_t)k * 6144);
#pragma unroll
            for (int b = 0; b < 4; ++b) { const float c = cact[b * 1024 + kc * 64 + k]; acc[b] += c * v; }
        }
#pragma unroll
        for (int b = 0; b < 4; ++b) *(GAS f32x2*)(modp + ((size_t)((kc * 2 + l) * 4 + b)) * 6144 + jg * 128 + lane * 2) = acc[b];
    }
    GAS float* rope = (GAS float*)(ws + WS_ROPE);
    for (int i = vb * 512 + tid; i < S * 16; i += nvb * 512) {
        const int pos = i >> 4, f = i & 15;
        const float invf = exp2f(-(float)f * (13.287712379549449f / 16.f));
        const float ang = (float)pos * invf;
        const float n = rintf(ang * 0.15915494309189535f);
        float r = fmaf(-n, 6.2831854820251465f, ang); r = fmaf(-n, -1.7484555e-7f, r);
        rope[2 * i] = cosf(r); rope[2 * i + 1] = sinf(r);
    }
    if (vb == 0 && wave == 0) {
        for (int l = 0; l < NL; ++l) {
            const float a = wave_sum(INP(I_LQ1)[l * 64 + lane] * INP(I_LK1)[l * 64 + lane]);
            const float b = wave_sum(INP(I_LQ2)[l * 64 + lane] * INP(I_LK2)[l * 64 + lane]);
            const float lam_init = 0.8f - 0.6f * expf(-0.3f * (float)l);
            if (lane == 0) ((GAS float*)(ws + WS_CTL))[CW_LAM + l] = expf(a) - expf(b) + lam_init;
        }
    }
}

template <int layer>
__device__ __forceinline__ void ph_norm1(const P& p, gptr ws, LAS unsigned char* lds, int vb, int nvb) {
    const int tid = ltid(), lane = tid & 63, wave = tid >> 6;
    LAS float* vec = (LAS float*)lds;
    const GAS float* modp = (const GAS float*)(ws + WS_MODP);
    GAS float* mod = (GAS float*)(ws + WS_MOD);
    const GAS float* tokw = (const GAS float*)(ws + WS_TOKW);
    const GAS bf16_t* os = (const GAS bf16_t*)(ws + WS_OS);
    GAS bf16_t* hb = (GAS bf16_t*)(ws + WS_HB);
    constexpr int RB = (layer == 0) ? 4 : 2;
    for (int ci = vb; ci < 256; ci += nvb) {
        const int b = ci >> 6;
        __syncthreads();
        for (int j = tid; j < 1024; j += 512) {
            if (layer < 2) {
                float sc, sh;
                if (layer == 0) {
                    sc = INP(I_BMOD)[1024 + j]; sh = INP(I_BMOD)[j];
                    for (int kc = 0; kc < 16; ++kc) { const GAS float* q = modp + ((size_t)((kc * 2 + 0) * 4 + b)) * 6144; sc += q[1024 + j]; sh += q[j]; }
                } else { sc = mod[(size_t)(4 + b) * 6144 + 1024 + j]; sh = mod[(size_t)(4 + b) * 6144 + j]; }
                vec[j] = INP(I_GMIX)[(layer < 2 ? layer : 0) * 1024 + j] * (1.f + sc); vec[1024 + j] = sh;
            } else { vec[j] = INP(I_GF)[j]; vec[1024 + j] = 0.f; }
            if (layer > 0) vec[2048 + j] = mod[(size_t)((layer > 0 ? layer - 1 : 0) * 4 + b) * 6144 + 5120 + j];
        }
        __syncthreads();
        for (int rr0 = 0; rr0 < 8; rr0 += RB) {
            f32x4 v[RB][4]; u32x2 oa[RB][4], oc[RB][4]; float w0[RB], w1[RB];
#pragma unroll
            for (int q = 0; q < RB; ++q) { const int row = ci * 64 + wave * 8 + rr0 + q;
                if (layer == 0) { const GAS float* xr = INP(I_X) + (size_t)row * D;
#pragma unroll
                    for (int j = 0; j < 4; ++j) v[q][j] = *(const GAS f32x4*)(xr + 4 * lane + 256 * j);
                } else { const GAS bf16_t* xr = (layer == 1 ? (const GAS bf16_t*)p.out : (const GAS bf16_t*)(ws + WS_KM)) + (size_t)row * D;
#pragma unroll
                    for (int j = 0; j < 4; ++j) { const u32x2 w = *(const GAS u32x2*)(xr + 4 * lane + 256 * j); v[q][j] = (f32x4){hlo(w.x), hhi(w.x), hlo(w.y), hhi(w.y)}; } }
                if (layer > 0) { w0[q] = tokw[row * 2]; w1[q] = tokw[row * 2 + 1];
#pragma unroll
                    for (int j = 0; j < 4; ++j) { oa[q][j] = *(const GAS u32x2*)(os + (size_t)(row * 2) * D + 4 * lane + 256 * j); oc[q][j] = *(const GAS u32x2*)(os + (size_t)(row * 2 + 1) * D + 4 * lane + 256 * j); } } }
#pragma unroll
            for (int q = 0; q < RB; ++q) { const int row = ci * 64 + wave * 8 + rr0 + q;
                if (layer > 0) {
#pragma unroll
                    for (int j = 0; j < 4; ++j) { const u32x2 a = oa[q][j], c = oc[q][j];
                        const f32x4 g = *(const LAS f32x4*)(vec + 2048 + 4 * lane + 256 * j);
                        v[q][j].x += g.x * (w0[q] * bflo(a.x) + w1[q] * bflo(c.x)); v[q][j].y += g.y * (w0[q] * bfhi(a.x) + w1[q] * bfhi(c.x));
                        v[q][j].z += g.z * (w0[q] * bflo(a.y) + w1[q] * bflo(c.y)); v[q][j].w += g.w * (w0[q] * bfhi(a.y) + w1[q] * bfhi(c.y)); }
                    if (layer < 2) {
#pragma unroll
                        for (int j = 0; j < 4; ++j) { u32x2 o; o.x = pkh(v[q][j].x, v[q][j].y); o.y = pkh(v[q][j].z, v[q][j].w); *(GAS u32x2*)(((GAS bf16_t*)p.out) + (size_t)row * D + 4 * lane + 256 * j) = o;
                            v[q][j] = (f32x4){hlo(o.x), hhi(o.x), hlo(o.y), hhi(o.y)}; }
                    }
                }
                float s = 0.f;
#pragma unroll
                for (int j = 0; j < 4; ++j) s += (v[q][j].x * v[q][j].x + v[q][j].y * v[q][j].y) + (v[q][j].z * v[q][j].z + v[q][j].w * v[q][j].w);
                const float rstd = rsqrtf(wave_sum(s) * (1.f / D) + EPS);
#pragma unroll
                for (int j = 0; j < 4; ++j) {
                    const f32x4 g = *(const LAS f32x4*)(vec + 4 * lane + 256 * j), sh = *(const LAS f32x4*)(vec + 1024 + 4 * lane + 256 * j);
                    const f32x4 y = v[q][j] * rstd * g + sh;
                    if (layer < 2) { u32x2 o; o.x = pk2(y.x, y.y); o.y = pk2(y.z, y.w); *(GAS u32x2*)(hb + (size_t)row * D + 4 * lane + 256 * j) = o; }
                    else *(GAS f32x4*)(((GAS float*)p.out) + (size_t)row * D + 4 * lane + 256 * j) = y;
                }
            }
        }
    }
    if (layer == 0) {
        for (int o = vb * 512 + tid; o < NL * 4 * 6144; o += nvb * 512) {
            const int l = o / (4 * 6144), r = o % (4 * 6144), b = r / 6144, j = r % 6144;
            float s = INP(I_BMOD)[l * 6144 + j];
            for (int kc = 0; kc < 16; ++kc) s += modp[((size_t)((kc * 2 + l) * 4 + b)) * 6144 + j];
            mod[o] = s;
        }
    }
}

__device__ __forceinline__ void ph_krope(const P& p, gptr ws, int vb, int nvb) {
    const GAS bf16_t* Y = (const GAS bf16_t*)(ws + WS_Y);
    GAS bf16_t* Km = (GAS bf16_t*)(ws + WS_KM);
    const GAS float* rope = (const GAS float*)(ws + WS_ROPE);
    const int tid = ltid();
    for (int i = vb * 512 + tid; i < T * 16; i += nvb * 512) {
        const int t = i >> 4, f = i & 15, pos = t & (S - 1);
        const float x1 = bf2f(Y[(size_t)t * YP + C_KR + f]), x2 = bf2f(Y[(size_t)t * YP + C_KR + 16 + f]);
        const float c = rope[(pos * 16 + f) * 2], s = rope[(pos * 16 + f) * 2 + 1];
        const bf16_t o1 = (bf16_t)f2bf(x1 * c - x2 * s), o2 = (bf16_t)f2bf(x1 * s + x2 * c);
#pragma unroll
        for (int h = 0; h < 8; ++h) { Km[(size_t)t * 768 + h * 96 + 64 + f] = o1; Km[(size_t)t * 768 + h * 96 + 80 + f] = o2; }
    }
}

__device__ __forceinline__ void ph_router(const P& p, gptr ws, LAS unsigned char* lds, int vb, int nvb, int layer, const GAS unsigned* dep) {
    const int tid = ltid(), lane = tid & 63, wave = tid >> 6;
    LAS float* wsw = (LAS float*)lds;
    LAS float* vec = (LAS float*)(lds + 65536);
    LAS int* lcnt = (LAS int*)(lds + 65536 + 8192);
    LAS int* rinfo = (LAS int*)(lds + 65536 + 8192 + 128);
    LAS float* rstd_l = (LAS float*)(lds + 65536 + 8192 + 2048);
    LAS float* lg = (LAS float*)(lds + 65536 + 8192 + 4096);
    const GAS float* mod = (const GAS float*)(ws + WS_MOD);
    GAS bf16_t* hb = (GAS bf16_t*)(ws + WS_HB);
    GAS float* tokw = (GAS float*)(ws + WS_TOKW);
    GAS int* list = (GAS int*)(ws + WS_LIST);
    GAS unsigned* cnt = (GAS unsigned*)(ws + WS_CTL) + CW_CNT + 64 * layer;
    const GAS bf16_t* xres = layer == 0 ? (const GAS bf16_t*)p.out : (const GAS bf16_t*)(ws + WS_KM);
    for (int i = tid; i < 16384; i += 512) { const int k = i >> 4, e = i & 15; wsw[((k >> 4) * 4 + ((k >> 2) & 3)) * 64 + e * 4 + (k & 3)] = INP(I_WR)[i]; }
    float rb[16];
#pragma unroll
    for (int e = 0; e < 16; ++e) rb[e] = INP(I_RB)[e];
    for (int ci = vb; ci < 256; ci += nvb) {
        const int b = ci >> 6;
        if (tid < 64) {
            if (tid == 0) { unsigned sp = 0; while (__hip_atomic_load((GAS unsigned*)dep + (ci >> 2), __ATOMIC_RELAXED, __HIP_MEMORY_SCOPE_AGENT) < 4u) { __builtin_amdgcn_s_sleep(2); if (++sp > (1u << 22)) break; } }
            __builtin_amdgcn_fence(__ATOMIC_ACQUIRE, "agent"); asm volatile("s_waitcnt vmcnt(0)" ::: "memory");
        }
        __syncthreads();
        for (int j = tid; j < 1024; j += 512) {
            vec[j] = INP(I_GFFN)[layer * 1024 + j] * (1.f + mod[(size_t)(layer * 4 + b) * 6144 + 4096 + j]);
            vec[1024 + j] = mod[(size_t)(layer * 4 + b) * 6144 + 3072 + j];
        }
        if (tid < 16) lcnt[tid] = 0;
#pragma unroll
        for (int r0 = 0; r0 < 8; r0 += 4) { f32x4 v[4][4];
#pragma unroll
            for (int q = 0; q < 4; ++q) { const GAS bf16_t* xr = xres + (size_t)(ci * 64 + wave * 8 + r0 + q) * D;
#pragma unroll
                for (int j = 0; j < 4; ++j) { const u32x2 w = *(const GAS u32x2*)(xr + 4 * lane + 256 * j); v[q][j] = (f32x4){hlo(w.x), hhi(w.x), hlo(w.y), hhi(w.y)}; } }
#pragma unroll
            for (int q = 0; q < 4; ++q) { float s = 0.f;
#pragma unroll
                for (int j = 0; j < 4; ++j) s += (v[q][j].x * v[q][j].x + v[q][j].y * v[q][j].y) + (v[q][j].z * v[q][j].z + v[q][j].w * v[q][j].w);
                s = wave_sum(s); if (lane == 0) rstd_l[wave * 8 + r0 + q] = rsqrtf(s * (1.f / D) + EPS); } }
        __syncthreads();
        { const int gI = wave & 3, hI = wave >> 2, r = lane & 15, kq = lane >> 4, row = ci * 64 + gI * 16 + r;
          const float rs = rstd_l[gI * 16 + r];
          const GAS bf16_t* xr = xres + (size_t)row * D + 4 * kq;
          GAS bf16_t* hr = hb + (size_t)row * D + 4 * kq;
          f32x4 acc = {0.f, 0.f, 0.f, 0.f};
#pragma unroll 8
          for (int jj = 0; jj < 32; ++jj) { const int j = hI * 32 + jj;
              const u32x2 xw = *(const GAS u32x2*)(xr + 16 * j); const f32x4 x4 = {hlo(xw.x), hhi(xw.x), hlo(xw.y), hhi(xw.y)};
              const f32x4 gv = *(const LAS f32x4*)(vec + 16 * j + 4 * kq), sv = *(const LAS f32x4*)(vec + 1024 + 16 * j + 4 * kq);
              const f32x4 w4 = *(const LAS f32x4*)(wsw + (j * 4 + kq) * 64 + r * 4);
              const f32x4 y = x4 * rs * gv + sv;
              u32x2 o; o.x = pk2(y.x, y.y); o.y = pk2(y.z, y.w); *(GAS u32x2*)(hr + 16 * j) = o;
              acc = __builtin_amdgcn_mfma_f32_16x16x4f32(y.x, w4.x, acc, 0, 0, 0); acc = __builtin_amdgcn_mfma_f32_16x16x4f32(y.y, w4.y, acc, 0, 0, 0);
              acc = __builtin_amdgcn_mfma_f32_16x16x4f32(y.z, w4.z, acc, 0, 0, 0); acc = __builtin_amdgcn_mfma_f32_16x16x4f32(y.w, w4.w, acc, 0, 0, 0); }
#pragma unroll
          for (int g = 0; g < 4; ++g) lg[((gI * 2 + hI) * 16 + 4 * kq + g) * 16 + r] = acc[g]; }
        __syncthreads();
        if (wave == 0) {
            const int lr = lane, gI = lr >> 4, r = lr & 15, row = ci * 64 + lr;
            float sc[16], sel[16];
#pragma unroll
            for (int e4 = 0; e4 < 4; ++e4) { const f32x4 a0 = *(const LAS f32x4*)(lg + ((gI * 2 + 0) * 16 + r) * 16 + 4 * e4), a1 = *(const LAS f32x4*)(lg + ((gI * 2 + 1) * 16 + r) * 16 + 4 * e4);
#pragma unroll
                for (int i = 0; i < 4; ++i) { const float lgt = a0[i] + a1[i]; sc[4 * e4 + i] = 1.f / (1.f + expf(-lgt)); sel[4 * e4 + i] = sc[4 * e4 + i] + rb[4 * e4 + i]; } }
            float gs[4];
#pragma unroll
            for (int g = 0; g < 4; ++g) {
                const float a = sel[4 * g], bq = sel[4 * g + 1], c = sel[4 * g + 2], d = sel[4 * g + 3];
                const float m1 = fmaxf(fmaxf(a, bq), fmaxf(c, d));
                const float m2 = fmaxf(fmaxf(fminf(a, bq), fminf(c, d)), fminf(fmaxf(a, bq), fmaxf(c, d)));
                gs[g] = m1 + m2;
            }
            int bg = 0; float bgs = gs[0];
#pragma unroll
            for (int g = 1; g < 4; ++g) if (gs[g] > bgs) { bgs = gs[g]; bg = g; }
            float s4[4], c4[4];
#pragma unroll
            for (int i = 0; i < 4; ++i) { s4[i] = bg == 0 ? sel[i] : bg == 1 ? sel[4 + i] : bg == 2 ? sel[8 + i] : sel[12 + i]; c4[i] = bg == 0 ? sc[i] : bg == 1 ? sc[4 + i] : bg == 2 ? sc[8 + i] : sc[12 + i]; }
            int i0 = 0; float b0 = s4[0];
#pragma unroll
            for (int i = 1; i < 4; ++i) if (s4[i] > b0) { b0 = s4[i]; i0 = i; }
            int i1 = -1; float b1 = -INFINITY;
#pragma unroll
            for (int i = 0; i < 4; ++i) if (i != i0 && s4[i] > b1) { b1 = s4[i]; i1 = i; }
            const float w0 = i0 == 0 ? c4[0] : i0 == 1 ? c4[1] : i0 == 2 ? c4[2] : c4[3];
            const float w1 = i1 == 0 ? c4[0] : i1 == 1 ? c4[1] : i1 == 2 ? c4[2] : c4[3];
            const float inv = 1.f / (w0 + w1);
            const int e0 = bg * 4 + i0, e1 = bg * 4 + i1;
            const int p0 = __hip_atomic_fetch_add(&lcnt[e0], 1, __ATOMIC_RELAXED, __HIP_MEMORY_SCOPE_WORKGROUP), p1 = __hip_atomic_fetch_add(&lcnt[e1], 1, __ATOMIC_RELAXED, __HIP_MEMORY_SCOPE_WORKGROUP);
            rinfo[lr * 4 + 0] = e0; rinfo[lr * 4 + 1] = e1; rinfo[lr * 4 + 2] = p0; rinfo[lr * 4 + 3] = p1;
            *(GAS f32x2*)(tokw + row * 2) = (f32x2){w0 * inv, w1 * inv};
        }
        __syncthreads();
        if (tid < 16) lcnt[16 + tid] = (int)__hip_atomic_fetch_add(cnt + tid, (unsigned)lcnt[tid], __ATOMIC_RELAXED, __HIP_MEMORY_SCOPE_AGENT);
        __syncthreads();
        if (tid < 128) {
            const int lr = tid >> 1, sl = tid & 1, e = rinfo[lr * 4 + sl], pos = rinfo[lr * 4 + 2 + sl];
            list[e * 16384 + lcnt[16 + e] + pos] = (ci * 64 + lr) * 2 + sl;
        }
    }
}


namespace pg8 {
typedef short bf16x8 __attribute__((ext_vector_type(8)));
constexpr int BM = 256, BK = 64, HALF = 128, HTB = HALF * BK * 2, STAGE_BYTES = 8 * HTB, NXCD = 8, WGM = 8;
__host__ __device__ __forceinline__ int lds_byte(int r, int c) { const int st = (r >> 4) * 2 + (c >> 5), rr = r & 15, cc = c & 31, ob = rr * 64 + cc * 2; return st * 1024 + (ob ^ (((ob >> 9) & 1) << 5)); }
__host__ __device__ __forceinline__ void stage_rc(int b, int& R, int& C) { const int st = b / 1024, sb = b % 1024, swz = sb ^ (((sb >> 9) & 1) << 5); R = (st >> 1) * 16 + swz / 64; C = (st & 1) * 32 + (swz % 64) / 2; }
__host__ __device__ __forceinline__ int perm32(int rho) { const int n = rho >> 4, i = rho & 15; return 8 * (i >> 2) + 4 * n + (i & 3); }
struct Unit { int pm, pn, x0, x1, x2; };
__device__ __forceinline__ void tile_of(int L, int nM, int nN, int& pm, int& pn) {
    const int nwg = nM * nN; int wgid = L;
    { const int q = nwg / NXCD, r = nwg % NXCD, xcd = wgid % NXCD, off = wgid / NXCD; wgid = (xcd < r ? xcd * (q + 1) : r * (q + 1) + (xcd - r) * q) + off; }
    const int nig = WGM * nN, gid = wgid / nig, fm = gid * WGM, gsz = (nM - fm) < WGM ? (nM - fm) : WGM;
    pm = fm + ((wgid % nig) % gsz); pn = (wgid % nig) / gsz;
}
__device__ __forceinline__ unsigned cvt_pk_bf16(float lo, float hi) { unsigned r; asm volatile("v_cvt_pk_bf16_f32 %0, %1, %2" : "=v"(r) : "v"(lo), "v"(hi)); return r; }

template <class Epi, class Sched, bool ALIGN_EPI>
__device__ __forceinline__ void gemm_phase(LAS unsigned char* lds, const int Kc, const Sched& S, const Epi& E) {
    const int K = lsg(Kc);
    constexpr bool GA = Sched::GATHER;
    const int tid = ltid(), wid = __builtin_amdgcn_readfirstlane(tid >> 6), lane = tid & 63, wr = wid >> 2, wc = wid & 3, fr = lane & 15, fq = lane >> 4;
    const int nt = K / BK;
    unsigned voffB[2], voffA[2];
#pragma unroll
    for (int i = 0; i < 2; ++i) { int R, C; stage_rc(tid * 16 + i * 8192, R, C); const int Rb = Epi::PERM ? ((R & ~31) + perm32(R & 31)) : R; voffB[i] = (unsigned)(Rb * K + C) * 2u; voffA[i] = S.a_lane(R, C); }
    const size_t kstep = (size_t)(BK * 2);
    const size_t hstepB = (size_t)HALF * K * 2;
    const unsigned ldsw = (unsigned)wid * 1024u;
    const int aoff = lds_byte(wr * 64 + fr, fq * 8), boff = lds_byte(wc * 32 + fr, fq * 8);
#define PG8_SA(b, h) (((b) * 2 + (h)) * HTB)
#define PG8_SB(b, h) ((4 + (b) * 2 + (h)) * HTB)
#define PG8_STAGE(bufoff, gbase, voff) do { _Pragma("unroll") for (int _i = 0; _i < 2; ++_i) \
        __builtin_amdgcn_global_load_lds((const GAS unsigned*)((const GAS char*)(gbase) + (voff)[_i]), (LAS unsigned*)(lds + (bufoff) + ldsw + _i * 8192), 16, 0, 0); } while (0)
#define PG8_LDA(dst, b, h) do { _Pragma("unroll") for (int m = 0; m < 4; ++m) _Pragma("unroll") for (int k = 0; k < 2; ++k) dst[m][k] = *(const LAS bf16x8*)(lds + PG8_SA(b, h) + aoff + m * 2048 + k * 1024); } while (0)
#define PG8_LDB(dst, b, h) do { _Pragma("unroll") for (int n = 0; n < 2; ++n) _Pragma("unroll") for (int k = 0; k < 2; ++k) dst[n][k] = *(const LAS bf16x8*)(lds + PG8_SB(b, h) + boff + n * 2048 + k * 1024); } while (0)
#define PG8_MMA(ai, bj, At, Bt) do { __builtin_amdgcn_s_setprio(1); _Pragma("unroll") for (int m = 0; m < 4; ++m) _Pragma("unroll") for (int n = 0; n < 2; ++n) _Pragma("unroll") for (int k = 0; k < 2; ++k) \
        acc[ai][bj][m][n] = __builtin_amdgcn_mfma_f32_16x16x32_bf16(Bt[n][k], At[m][k], acc[ai][bj][m][n], 0, 0, 0); __builtin_amdgcn_s_setprio(0); } while (0)
#define PG8_WAIT_V(n) asm volatile("s_waitcnt vmcnt(" #n ")" ::: "memory")
#define PG8_WAIT_L(n) asm volatile("s_waitcnt lgkmcnt(" #n ")" ::: "memory")
#define PG8_BAR __builtin_amdgcn_s_barrier()
#define PG8_SCHED __builtin_amdgcn_sched_barrier(0)
    Unit cur, nxt; int ui = 0;
    if (!S.next(0, cur)) return;
    f32x4 acc[2][2][4][2];
#pragma unroll
    for (int a = 0; a < 2; ++a)
#pragma unroll
        for (int b = 0; b < 2; ++b)
#pragma unroll
            for (int m = 0; m < 4; ++m)
#pragma unroll
                for (int n = 0; n < 2; ++n) { asm volatile("v_mov_b32 %0, 0" : "=v"(acc[a][b][m][n][0])); asm volatile("v_mov_b32 %0, 0" : "=v"(acc[a][b][m][n][1])); asm volatile("v_mov_b32 %0, 0" : "=v"(acc[a][b][m][n][2])); asm volatile("v_mov_b32 %0, 0" : "=v"(acc[a][b][m][n][3])); }
    bf16x8 At[4][2], B0[2][2], B1[2][2];
    const GAS char* cA0 = S.a_base(cur, 0); const GAS char* cA1 = S.a_base(cur, 1); const GAS char* cB = S.b_base(cur);
    unsigned cO[2][2];
    if constexpr (GA) S.a_offs(cur, cO); else { cO[0][0] = voffA[0]; cO[0][1] = voffA[1]; cO[1][0] = voffA[0]; cO[1][1] = voffA[1]; }
    if constexpr (Sched::DEPS) S.wait_ready(cur, true);
    PG8_STAGE(PG8_SB(0, 0), cB, voffB); PG8_STAGE(PG8_SB(0, 1), cB + hstepB, voffB); PG8_STAGE(PG8_SA(0, 0), cA0, cO[0]); PG8_STAGE(PG8_SA(0, 1), cA1, cO[1]);
    if (wr == 1) PG8_BAR;
    PG8_WAIT_V(2); PG8_BAR;
    PG8_STAGE(PG8_SB(1, 0), cB + kstep, voffB); PG8_STAGE(PG8_SA(1, 0), cA0 + kstep, cO[0]); PG8_STAGE(PG8_SB(1, 1), cB + hstepB + kstep, voffB);
    PG8_WAIT_V(6); PG8_BAR;
    for (;;) {
        const bool has_next = S.next(ui + 1, nxt);
        if constexpr (Sched::DEPS) { if (has_next) S.wait_ready(nxt, false); }
        const GAS char* nA0 = has_next ? S.a_base(nxt, 0) : cA0; const GAS char* nA1 = has_next ? S.a_base(nxt, 1) : cA1; const GAS char* nB = has_next ? S.b_base(nxt) : cB;
        unsigned nO[2][2];
        if constexpr (GA) { if (has_next) S.a_offs(nxt, nO); else { nO[0][0] = cO[0][0]; nO[0][1] = cO[0][1]; nO[1][0] = cO[1][0]; nO[1][1] = cO[1][1]; } }
        for (int t = 0; t < nt; t += 2) {
            const bool last = (t == nt - 2);
            const GAS char* a1 = cA1 + (size_t)(t + 1) * kstep;
            const GAS char* a20 = last ? nA0 : cA0 + (size_t)(t + 2) * kstep; const GAS char* a21 = last ? nA1 : cA1 + (size_t)(t + 2) * kstep; const GAS char* b2 = last ? nB : cB + (size_t)(t + 2) * kstep;
            const GAS char* a30 = a20 + kstep; const GAS char* b3 = b2 + kstep;
            unsigned o2[2][2];
            if constexpr (GA) { o2[0][0] = last ? nO[0][0] : cO[0][0]; o2[0][1] = last ? nO[0][1] : cO[0][1]; o2[1][0] = last ? nO[1][0] : cO[1][0]; o2[1][1] = last ? nO[1][1] : cO[1][1]; }
            else { o2[0][0] = voffA[0]; o2[0][1] = voffA[1]; o2[1][0] = voffA[0]; o2[1][1] = voffA[1]; }
            PG8_LDB(B0, 0, 0); PG8_LDB(B1, 0, 1); PG8_SCHED; PG8_LDA(At, 0, 0); PG8_STAGE(PG8_SA(1, 1), a1, cO[1]);
            PG8_WAIT_V(8); PG8_WAIT_L(0); PG8_BAR; PG8_MMA(0, 0, At, B0); PG8_MMA(0, 1, At, B1); PG8_BAR; PG8_SCHED;
            PG8_LDA(At, 0, 1); PG8_STAGE(PG8_SB(0, 0), b2, voffB); PG8_STAGE(PG8_SB(0, 1), b2 + hstepB, voffB); PG8_STAGE(PG8_SA(0, 0), a20, o2[0]);
            PG8_WAIT_V(8); PG8_WAIT_L(0); PG8_BAR; PG8_MMA(1, 0, At, B0); PG8_MMA(1, 1, At, B1); PG8_BAR; PG8_SCHED;
            PG8_LDB(B0, 1, 0); PG8_LDB(B1, 1, 1); PG8_SCHED; PG8_LDA(At, 1, 0); PG8_STAGE(PG8_SA(0, 1), a21, o2[1]);
            PG8_WAIT_V(8); PG8_WAIT_L(0); PG8_BAR; PG8_MMA(0, 0, At, B0); PG8_MMA(0, 1, At, B1); PG8_BAR; PG8_SCHED;
            PG8_LDA(At, 1, 1); PG8_STAGE(PG8_SB(1, 0), b3, voffB); PG8_STAGE(PG8_SB(1, 1), b3 + hstepB, voffB); PG8_STAGE(PG8_SA(1, 0), a30, o2[0]);
            PG8_WAIT_V(8); PG8_WAIT_L(0); PG8_BAR; PG8_MMA(1, 0, At, B0); PG8_MMA(1, 1, At, B1); PG8_BAR; PG8_SCHED;
        }
        if constexpr (ALIGN_EPI) { if (wr == 0) PG8_BAR; }
        E(acc, cur, wr, wc, fr, fq);
        if constexpr (Epi::PUBLISH) { if (E.pub(cur)) { asm volatile("s_waitcnt vmcnt(0)" ::: "memory"); PG8_BAR; asm volatile("" ::: "memory"); E.publish(cur, tid); } }
        if (!has_next) break;
        if (!E.keep(cur))
#pragma unroll
        for (int a = 0; a < 2; ++a)
#pragma unroll
            for (int b = 0; b < 2; ++b)
#pragma unroll
                for (int m = 0; m < 4; ++m)
#pragma unroll
                    for (int n = 0; n < 2; ++n) { asm volatile("v_mov_b32 %0, 0" : "=v"(acc[a][b][m][n][0])); asm volatile("v_mov_b32 %0, 0" : "=v"(acc[a][b][m][n][1])); asm volatile("v_mov_b32 %0, 0" : "=v"(acc[a][b][m][n][2])); asm volatile("v_mov_b32 %0, 0" : "=v"(acc[a][b][m][n][3])); }
        cur = nxt; cA0 = nA0; cA1 = nA1; cB = nB; ++ui;
        if constexpr (GA) { cO[0][0] = nO[0][0]; cO[0][1] = nO[0][1]; cO[1][0] = nO[1][0]; cO[1][1] = nO[1][1]; }
        if constexpr (ALIGN_EPI) { if (wr == 1) PG8_BAR; }
    }
    PG8_WAIT_V(0);
    if constexpr (!ALIGN_EPI) { if (wr == 0) PG8_BAR; }
    PG8_BAR;
#undef PG8_SA
#undef PG8_SB
#undef PG8_STAGE
#undef PG8_LDA
#undef PG8_LDB
#undef PG8_MMA
#undef PG8_WAIT_V
#undef PG8_WAIT_L
#undef PG8_BAR
#undef PG8_SCHED
}

struct SchedPlain {
    static constexpr bool GATHER = false, DEPS = false;
    const GAS char* A; const GAS char* Bt; int lda, K, nM, nN, G, c;
    __device__ __forceinline__ bool next(int i, Unit& u) const { const int L = i * G + c; if (L >= nM * nN) return false; tile_of(L, nM, nN, u.pm, u.pn); u.x0 = 0; u.x1 = 0; u.x2 = 0; return true; }
    __device__ __forceinline__ unsigned a_lane(int R, int C) const { return (unsigned)(R * lda + C) * 2u; }
    __device__ __forceinline__ const GAS char* a_base(const Unit& u, int h) const { return A + (size_t)(u.pm * 256 + h * 128) * lda * 2; }
    __device__ __forceinline__ void a_offs(const Unit&, unsigned (&)[2][2]) const {}
    __device__ __forceinline__ const GAS char* b_base(const Unit& u) const { return Bt + (size_t)u.pn * 256 * K * 2; }
};

struct EpiInproj {
    __device__ __forceinline__ bool keep(const Unit&) const { return false; }
    static constexpr bool PERM = true, PUBLISH = true;
    __device__ __forceinline__ bool pub(const Unit& u) const { return u.pn == 12 || u.pn == 13; }
    __device__ __forceinline__ void publish(const Unit& u, int tid) const { if (tid == 0) __hip_atomic_fetch_add(dep + u.pm, 1u, __ATOMIC_RELAXED, __HIP_MEMORY_SCOPE_AGENT); }
    GAS unsigned* dep;
    GAS bf16_t* Y; GAS float* ssq; GAS unsigned* cmax; GAS bf16_t* G;
    __device__ __forceinline__ void operator()(const f32x4 (&acc)[2][2][4][2], const Unit& u, int wr, int wc, int fr, int fq) const {
        const int row0 = u.pm * BM + wr * 64 + fr, col0 = u.pn * BM + wc * 32 + 8 * fq;
        const bool sg = u.pn >= 15, sq = (u.pn >= 12 && u.pn <= 14), wt = (u.pn == 12 || u.pn == 13);
        if (u.pn == 2 || u.pn == 3) {
#pragma unroll
            for (int bj = 0; bj < 2; ++bj) { float cm[8];
#pragma unroll
                for (int e = 0; e < 8; ++e) { float m_ = 0.f;
#pragma unroll
                    for (int ai = 0; ai < 2; ++ai)
#pragma unroll
                        for (int m = 0; m < 4; ++m) m_ = fmaxf(m_, fabsf(acc[ai][bj][m][e >> 2][e & 3]));
#pragma unroll
                    for (int sh = 1; sh < 16; sh <<= 1) m_ = fmaxf(m_, __shfl_xor(m_, sh));
                    cm[e] = m_; }
                if (fr == 0) {
#pragma unroll
                    for (int e = 0; e < 8; ++e) __hip_atomic_fetch_max(cmax + (u.pm >> 4) * 512 + (col0 + bj * HALF - 512) + e, __float_as_uint(cm[e]), __ATOMIC_RELAXED, __HIP_MEMORY_SCOPE_AGENT); } }
        }
#pragma unroll
        for (int ai = 0; ai < 2; ++ai)
#pragma unroll
            for (int m = 0; m < 4; ++m) { const int row = row0 + ai * HALF + m * 16; GAS bf16_t* rowp = Y + (size_t)row * YP + col0;
#pragma unroll
                for (int bj = 0; bj < 2; ++bj) { f32x4 v0 = acc[ai][bj][m][0], v1 = acc[ai][bj][m][1];
                    if (sg) {
#pragma unroll
                        for (int e = 0; e < 4; ++e) { v0[e] = __builtin_amdgcn_rcpf(1.f + __builtin_amdgcn_exp2f(-1.4426950408889634f * v0[e])); v1[e] = __builtin_amdgcn_rcpf(1.f + __builtin_amdgcn_exp2f(-1.4426950408889634f * v1[e])); }
                    }
                    u32x4 w; w.x = cvt_pk_bf16(v0[0], v0[1]); w.y = cvt_pk_bf16(v0[2], v0[3]); w.z = cvt_pk_bf16(v1[0], v1[1]); w.w = cvt_pk_bf16(v1[2], v1[3]);
                    if (sg) {
                        u32x2 q2 = {0u, 0u};
#pragma unroll
                        for (int e = 0; e < 4; ++e) { q2.x = __builtin_amdgcn_cvt_pk_u8_f32(v0[e] * 255.f, e, q2.x); q2.y = __builtin_amdgcn_cvt_pk_u8_f32(v1[e] * 255.f, e, q2.y); }
                        __builtin_nontemporal_store(q2, (GAS u32x2*)((GAS unsigned char*)G + ((size_t)(u.pm * 12 + (u.pn - 15)) * 16 + (ai * 4 + m) * 2 + bj) * 4096 + ((wr * 4 + wc) * 64 + fq * 16 + fr) * 8)); }
                    else if (wt) asm volatile("global_store_dwordx4 %0, %1, off sc1\n\ts_nop 1" :: "v"(rowp + bj * HALF), "v"(w) : "memory");
                    else __builtin_nontemporal_store(w, (GAS u32x4*)(rowp + bj * HALF));
                    if (sq) { float s = (v0[0] * v0[0] + v0[1] * v0[1]) + (v0[2] * v0[2] + v0[3] * v0[3]) + (v1[0] * v1[0] + v1[1] * v1[1]) + (v1[2] * v1[2] + v1[3] * v1[3]);
                        s += __shfl_xor(s, 16); s += __shfl_xor(s, 32);
                        if (fq == 0) { if (wt) __hip_atomic_store(ssq + (size_t)row * 24 + (u.pn - 12) * 8 + bj * 4 + wc, s, __ATOMIC_RELAXED, __HIP_MEMORY_SCOPE_AGENT); else ssq[(size_t)row * 24 + (u.pn - 12) * 8 + bj * 4 + wc] = s; } } } }
    }
};

__device__ __forceinline__ void store16_wt(GAS void* p, u32x4 v) { *(GAS u32x4*)p = v; }
struct EpiMlaQ {
    __device__ __forceinline__ bool keep(const Unit&) const { return false; }
    static constexpr bool PERM = true, PUBLISH = false;
    GAS bf16_t* Qm; const GAS float* ssq;
    __device__ __forceinline__ void operator()(const f32x4 (&acc)[2][2][4][2], const Unit& u, int wr, int wc, int fr, int fq) const {
        const int row0 = u.pm * BM + wr * 64 + fr, col0 = u.pn * BM + wc * 32 + 8 * fq;
        float rs[2][4];
#pragma unroll
        for (int ai = 0; ai < 2; ++ai)
#pragma unroll
            for (int m = 0; m < 4; ++m) { const int row = row0 + ai * HALF + m * 16;
                const f32x4 s0 = *(const GAS f32x4*)(ssq + (size_t)row * 24), s1 = *(const GAS f32x4*)(ssq + (size_t)row * 24 + 4), s2 = *(const GAS f32x4*)(ssq + (size_t)row * 24 + 8);
                const float s = ((s0[0] + s0[1]) + (s0[2] + s0[3])) + ((s1[0] + s1[1]) + (s1[2] + s1[3])) + ((s2[0] + s2[1]) + (s2[2] + s2[3]));
                rs[ai][m] = rsqrtf(s * (1.f / 384.f) + EPS); }
#pragma unroll
        for (int ai = 0; ai < 2; ++ai)
#pragma unroll
            for (int m = 0; m < 4; ++m) { const int row = row0 + ai * HALF + m * 16;
#pragma unroll
                for (int bj = 0; bj < 2; ++bj) { const f32x4 v0 = acc[ai][bj][m][0] * rs[ai][m], v1 = acc[ai][bj][m][1] * rs[ai][m];
                    u32x4 w; w.x = cvt_pk_bf16(v0[0], v0[1]); w.y = cvt_pk_bf16(v0[2], v0[3]); w.z = cvt_pk_bf16(v1[0], v1[1]); w.w = cvt_pk_bf16(v1[2], v1[3]);
                    store16_wt(Qm + (size_t)row * 768 + col0 + bj * HALF, w); } }
    }
};
struct EpiMlaKV {
    __device__ __forceinline__ bool keep(const Unit&) const { return false; }
    static constexpr bool PERM = true, PUBLISH = false;
    GAS bf16_t* Km; GAS bf16_t* Vm; const GAS float* ssq;
    __device__ __forceinline__ void operator()(const f32x4 (&acc)[2][2][4][2], const Unit& u, int wr, int wc, int fr, int fq) const {
        const int row0 = u.pm * BM + wr * 64 + fr, col0 = u.pn * BM + wc * 32 + 8 * fq;
        float rs[2][4];
#pragma unroll
        for (int ai = 0; ai < 2; ++ai)
#pragma unroll
            for (int m = 0; m < 4; ++m) { const int row = row0 + ai * HALF + m * 16;
                const f32x4 s0 = *(const GAS f32x4*)(ssq + (size_t)row * 24 + 12), s1 = *(const GAS f32x4*)(ssq + (size_t)row * 24 + 16);
                const float s = ((s0[0] + s0[1]) + (s0[2] + s0[3])) + ((s1[0] + s1[1]) + (s1[2] + s1[3]));
                rs[ai][m] = rsqrtf(s * (1.f / 256.f) + EPS); }
#pragma unroll
        for (int ai = 0; ai < 2; ++ai)
#pragma unroll
            for (int m = 0; m < 4; ++m) { const int row = row0 + ai * HALF + m * 16;
#pragma unroll
                for (int bj = 0; bj < 2; ++bj) { const f32x4 v0 = acc[ai][bj][m][0] * rs[ai][m], v1 = acc[ai][bj][m][1] * rs[ai][m];
                    u32x4 w; w.x = cvt_pk_bf16(v0[0], v0[1]); w.y = cvt_pk_bf16(v0[2], v0[3]); w.z = cvt_pk_bf16(v1[0], v1[1]); w.w = cvt_pk_bf16(v1[2], v1[3]);
                    const int n = col0 + bj * HALF;
                    GAS bf16_t* dst = n < 512 ? Km + (size_t)row * 768 + (n >> 6) * 96 + (n & 63) : Vm + (size_t)row * 512 + (n - 512);
                    store16_wt(dst, w); } }
    }
};
struct SchedPlainDep {
    static constexpr bool GATHER = false, DEPS = true;
    const GAS char* A; const GAS char* Bt; int lda, K, nM, nN, G, c; const GAS unsigned* dep; int need;
    __device__ __forceinline__ bool next(int i, Unit& u) const { const int L = i * G + c; if (L >= nM * nN) return false; tile_of(L, nM, nN, u.pm, u.pn); u.x0 = 0; u.x1 = 0; u.x2 = 0; return true; }
    __device__ __forceinline__ void wait_ready(const Unit& u, bool first) const {
        const int t = ltid();
        if ((t >> 6) == 0) {
            if (t == 0) { unsigned sp = 0; while (__hip_atomic_load((GAS unsigned*)dep + u.pm, __ATOMIC_RELAXED, __HIP_MEMORY_SCOPE_AGENT) < (unsigned)need) { __builtin_amdgcn_s_sleep(2); if (++sp > (1u << 22)) break; } }
            __builtin_amdgcn_fence(__ATOMIC_ACQUIRE, "agent"); asm volatile("s_waitcnt vmcnt(0)" ::: "memory");
        }
        if (first) { asm volatile("s_waitcnt vmcnt(0) lgkmcnt(0)" ::: "memory"); __builtin_amdgcn_s_barrier(); asm volatile("" ::: "memory"); }
    }
    __device__ __forceinline__ unsigned a_lane(int R, int C) const { return (unsigned)(R * lda + C) * 2u; }
    __device__ __forceinline__ const GAS char* a_base(const Unit& u, int h) const { return A + (size_t)(u.pm * 256 + h * 128) * lda * 2; }
    __device__ __forceinline__ void a_offs(const Unit&, unsigned (&)[2][2]) const {}
    __device__ __forceinline__ const GAS char* b_base(const Unit& u) const { return Bt + (size_t)u.pn * 256 * K * 2; }
};
struct SchedBranch {
    static constexpr bool GATHER = false, DEPS = false;
    const GAS char* Y; const GAS char* WBR; int G, c;
    __device__ __forceinline__ bool next(int i, Unit& u) const { const int rnd = i / 3, br = i - rnd * 3; const int L = rnd * G + c; if (L >= 256) return false; tile_of(L, 64, 4, u.pm, u.pn); u.x0 = br; u.x1 = 0; u.x2 = 0; return true; }
    __device__ __forceinline__ unsigned a_lane(int R, int C) const { return (unsigned)(R * YP + C) * 2u; }
    __device__ __forceinline__ const GAS char* a_base(const Unit& u, int h) const { return Y + (u.x0 == 0 ? C_DQ : u.x0 == 1 ? C_CQ : C_MQ) * 2 + (size_t)(u.pm * 256 + h * 128) * YP * 2; }
    __device__ __forceinline__ void a_offs(const Unit&, unsigned (&)[2][2]) const {}
    __device__ __forceinline__ const GAS char* b_base(const Unit& u) const { return WBR + ((size_t)u.x0 * 1024 + (size_t)u.pn * 256) * 512 * 2; }
};
struct EpiBranch {
    static constexpr bool PERM = true, PUBLISH = true;
    const GAS bf16_t* Y; GAS bf16_t* MG; GAS unsigned* dep;
    __device__ __forceinline__ bool keep(const Unit& u) const { return u.x0 < 2; }
    __device__ __forceinline__ bool pub(const Unit& u) const { return u.x0 == 2; }
    __device__ __forceinline__ void publish(const Unit& u, int tid) const { if (tid == 0) __hip_atomic_fetch_add(dep + u.pm, 1u, __ATOMIC_RELAXED, __HIP_MEMORY_SCOPE_AGENT); }
    __device__ __forceinline__ void operator()(f32x4 (&acc)[2][2][4][2], const Unit& u, int wr, int wc, int fr, int fq) const {
        const int row0 = u.pm * BM + wr * 64 + fr, col0 = u.pn * BM + wc * 32 + 8 * fq, br = u.x0;
#pragma unroll
        for (int ai = 0; ai < 2; ++ai) {
            u32x2 g[4][2], gn[4][2];
#pragma unroll
            for (int m = 0; m < 4; ++m)
#pragma unroll
                for (int bj = 0; bj < 2; ++bj) { const int row = row0 + ai * HALF + m * 16, col = col0 + bj * HALF;
                    const size_t go = ((size_t)(u.pm * 12 + br * 4 + u.pn) * 16 + (ai * 4 + m) * 2 + bj) * 4096 + ((wr * 4 + wc) * 64 + fq * 16 + fr) * 8;
                    g[m][bj] = *(const GAS u32x2*)((const GAS unsigned char*)Y + go);
                    if (br < 2) gn[m][bj] = *(const GAS u32x2*)((const GAS unsigned char*)Y + go + (size_t)4 * 16 * 4096); else gn[m][bj] = (u32x2){0x01010101u, 0x01010101u}; }
#pragma unroll
            for (int m = 0; m < 4; ++m)
#pragma unroll
                for (int bj = 0; bj < 2; ++bj) { const int row = row0 + ai * HALF + m * 16, col = col0 + bj * HALF;
                    const u32x2 gg = g[m][bj], nn = gn[m][bj];
                    float s[8];
#pragma unroll
                    for (int e = 0; e < 8; ++e) { const float gq = (float)((gg[e >> 2] >> (8 * (e & 3))) & 255u), nq = (float)((nn[e >> 2] >> (8 * (e & 3))) & 255u);
                        s[e] = (br < 2) ? gq * __builtin_amdgcn_rcpf(fmaxf(nq, 1.f)) : gq * (1.f / 255.f); }
                    f32x4 v0 = acc[ai][bj][m][0], v1 = acc[ai][bj][m][1];
                    v0[0] *= s[0]; v0[1] *= s[1]; v0[2] *= s[2]; v0[3] *= s[3]; v1[0] *= s[4]; v1[1] *= s[5]; v1[2] *= s[6]; v1[3] *= s[7];
                    if (br < 2) { acc[ai][bj][m][0] = v0; acc[ai][bj][m][1] = v1; }
                    else { u32x4 w; w.x = cvt_pk_bf16(v0[0], v0[1]); w.y = cvt_pk_bf16(v0[2], v0[3]); w.z = cvt_pk_bf16(v1[0], v1[1]); w.w = cvt_pk_bf16(v1[2], v1[3]);
                        asm volatile("global_store_dwordx4 %0, %1, off sc1\n\ts_nop 1" :: "v"(MG + (size_t)row * D + col), "v"(w) : "memory"); } }
        }
    }
};
template <bool XBF>
struct EpiOut {
    __device__ __forceinline__ bool keep(const Unit&) const { return false; }
    static constexpr bool PERM = true, PUBLISH = true;
    __device__ __forceinline__ bool pub(const Unit&) const { return true; }
    __device__ __forceinline__ void publish(const Unit& u, int tid) const { if (tid == 0) __hip_atomic_fetch_add(dep + u.pm, 1u, __ATOMIC_RELAXED, __HIP_MEMORY_SCOPE_AGENT); }
    GAS unsigned* dep;
    const GAS void* xcur; GAS bf16_t* xo; const GAS float* gt;
    __device__ __forceinline__ void operator()(const f32x4 (&acc)[2][2][4][2], const Unit& u, int wr, int wc, int fr, int fq) const {
        const int row0 = u.pm * BM + wr * 64 + fr, col0 = u.pn * BM + wc * 32 + 8 * fq;
        const GAS float* g = gt + (size_t)(u.pm >> 4) * 6144;
#pragma unroll
        for (int bj = 0; bj < 2; ++bj) { const int col = col0 + bj * HALF; const f32x4 g0 = *(const GAS f32x4*)(g + col), g1 = *(const GAS f32x4*)(g + col + 4);
            if constexpr (XBF) {
                u32x4 xb[2][4];
#pragma unroll
                for (int ai = 0; ai < 2; ++ai)
#pragma unroll
                    for (int m = 0; m < 4; ++m) xb[ai][m] = *(const GAS u32x4*)((const GAS bf16_t*)xcur + (size_t)(row0 + ai * HALF + m * 16) * D + col);
#pragma unroll
                for (int ai = 0; ai < 2; ++ai)
#pragma unroll
                    for (int m = 0; m < 4; ++m) { const u32x4 x = xb[ai][m]; const f32x4 a0 = acc[ai][bj][m][0], a1 = acc[ai][bj][m][1];
                        u32x4 w; w.x = pkh(hlo(x.x) + g0.x * a0.x, hhi(x.x) + g0.y * a0.y); w.y = pkh(hlo(x.y) + g0.z * a0.z, hhi(x.y) + g0.w * a0.w);
                        w.z = pkh(hlo(x.z) + g1.x * a1.x, hhi(x.z) + g1.y * a1.y); w.w = pkh(hlo(x.w) + g1.z * a1.z, hhi(x.w) + g1.w * a1.w);
                        asm volatile("global_store_dwordx4 %0, %1, off sc1\n\ts_nop 1" :: "v"(xo + (size_t)(row0 + ai * HALF + m * 16) * D + col), "v"(w) : "memory"); }
            } else {
#pragma unroll
                for (int ai = 0; ai < 2; ++ai) { f32x4 xa[4][2];
#pragma unroll
                    for (int m = 0; m < 4; ++m) { const GAS float* xr = (const GAS float*)xcur + (size_t)(row0 + ai * HALF + m * 16) * D + col; xa[m][0] = *(const GAS f32x4*)xr; xa[m][1] = *(const GAS f32x4*)(xr + 4); }
#pragma unroll
                    for (int m = 0; m < 4; ++m) { const f32x4 v0 = xa[m][0] + g0 * acc[ai][bj][m][0], v1 = xa[m][1] + g1 * acc[ai][bj][m][1];
                        u32x4 w; w.x = pkh(v0[0], v0[1]); w.y = pkh(v0[2], v0[3]); w.z = pkh(v1[0], v1[1]); w.w = pkh(v1[2], v1[3]);
                        asm volatile("global_store_dwordx4 %0, %1, off sc1\n\ts_nop 1" :: "v"(xo + (size_t)(row0 + ai * HALF + m * 16) * D + col), "v"(w) : "memory"); } }
            } }
    }
};
template <bool GA_> struct SchedMoe {
    static constexpr bool GATHER = GA_, DEPS = !GA_;
    const GAS char* A; const GAS char* Bt; const GAS int* list; const LAS int* tab; int lda, K, nN, G, c; GAS unsigned* dep;
    __device__ __forceinline__ void wait_ready(const Unit& u, bool first) const {
        const int t = ltid();
        if ((t >> 6) == 0) {
            if (t == 0) { unsigned sp = 0; while (__hip_atomic_load(dep + u.pm, __ATOMIC_RELAXED, __HIP_MEMORY_SCOPE_AGENT) < (unsigned)nN) { __builtin_amdgcn_s_sleep(2); if (++sp > (1u << 22)) break; } }
            __builtin_amdgcn_fence(__ATOMIC_ACQUIRE, "agent"); asm volatile("s_waitcnt vmcnt(0)" ::: "memory");
        }
        if (first) { asm volatile("s_waitcnt vmcnt(0) lgkmcnt(0)" ::: "memory"); __builtin_amdgcn_s_barrier(); asm volatile("" ::: "memory"); }
    }
    __device__ __forceinline__ bool next(int i, Unit& u) const {
        const int total = __builtin_amdgcn_readfirstlane(tab[16]) * nN; int L = i * G + c;
        const int d = total - 2 * G;
        if (G == 256 && d > 0 && d <= 48) {
            const int ca = 3 * d, cb = G - 5 * d, cc = 2 * d;
            if constexpr (GA_) { if (i == 0) L = c; else if (i == 1) { if (c >= ca + cb) return false; L = G + c; } else if (i == 2) { if (c >= ca) return false; L = G + ca + cb + c; } else return false; }
            else { if (c < ca) { if (i > 0) return false; L = 4 * cc + 2 * cb + c; }
                   else if (c < ca + cb) { if (i > 1) return false; L = 4 * cc + (c - ca) + cb * i; }
                   else { if (i > 3) return false; L = (c - ca - cb) + cc * i; } }
        } else if constexpr (!GA_) {
            const int ra = total % G, v = c >= ra ? c - ra : c + G - ra, nl = G - ra;
            L = v < nl ? (i == 0 ? v : nl + (i - 1) * G + v) : nl + i * G + v;
        }
        if (L >= total) return false;
        const int mt = L / nN, pn = L - mt * nN; int e = 0;
#pragma unroll
        for (int j = 1; j < 16; ++j) e += (mt >= __builtin_amdgcn_readfirstlane(tab[j])) ? 1 : 0;
        const int lt = mt - __builtin_amdgcn_readfirstlane(tab[e]); const int rem = __builtin_amdgcn_readfirstlane(tab[32 + e]) - lt * 256;
        u.pm = mt; u.pn = pn; u.x0 = e; u.x1 = lt * 256; u.x2 = rem < 256 ? rem : 256; return true;
    }
    __device__ __forceinline__ unsigned a_lane(int R, int C) const { return (unsigned)(R * lda + C) * 2u; }
    __device__ __forceinline__ const GAS char* a_base(const Unit& u, int h) const { return GA_ ? A : A + (size_t)(u.pm * 256 + h * 128) * lda * 2; }
    __device__ __forceinline__ void a_offs(const Unit& u, unsigned (&o)[2][2]) const {
        const int t2 = ltid();
#pragma unroll
        for (int h = 0; h < 2; ++h)
#pragma unroll
            for (int i = 0; i < 2; ++i) { int R, C; stage_rc(t2 * 16 + i * 8192, R, C); const int rl = h * 128 + R; int tok = 0; if (rl < u.x2) tok = list[u.x0 * 16384 + u.x1 + rl] >> 1; o[h][i] = (unsigned)(tok * lda + C) * 2u; }
    }
    __device__ __forceinline__ const GAS char* b_base(const Unit& u) const { return Bt + ((size_t)u.x0 * 1024 + (size_t)u.pn * 256) * K * 2; }
};
struct EpiGU {
    __device__ __forceinline__ bool keep(const Unit&) const { return false; }
    static constexpr bool PERM = true, PUBLISH = true;
    GAS bf16_t* HC; GAS unsigned* dep;
    __device__ __forceinline__ void operator()(const f32x4 (&acc)[2][2][4][2], const Unit& u, int wr, int wc, int fr, int fq) const {
        const int row0 = u.pm * BM + wr * 64 + fr, col0 = u.pn * 128 + wc * 32 + 8 * fq;
#pragma unroll
        for (int ai = 0; ai < 2; ++ai)
#pragma unroll
            for (int m = 0; m < 4; ++m) { const int row = row0 + ai * HALF + m * 16;
                f32x4 h0, h1;
#pragma unroll
                for (int e = 0; e < 4; ++e) { const float g0 = acc[ai][0][m][0][e], g1 = acc[ai][0][m][1][e];
                    h0[e] = g0 * __builtin_amdgcn_rcpf(1.f + __builtin_amdgcn_exp2f(-1.4426950408889634f * g0)) * acc[ai][1][m][0][e];
                    h1[e] = g1 * __builtin_amdgcn_rcpf(1.f + __builtin_amdgcn_exp2f(-1.4426950408889634f * g1)) * acc[ai][1][m][1][e]; }
                u32x4 w; w.x = cvt_pk_bf16(h0[0], h0[1]); w.y = cvt_pk_bf16(h0[2], h0[3]); w.z = cvt_pk_bf16(h1[0], h1[1]); w.w = cvt_pk_bf16(h1[2], h1[3]);
                asm volatile("global_store_dwordx4 %0, %1, off sc1\n\ts_nop 1" :: "v"(HC + (size_t)row * FF + col0), "v"(w) : "memory"); }
    }
    __device__ __forceinline__ bool pub(const Unit&) const { return true; }
    __device__ __forceinline__ void publish(const Unit& u, int tid) const { if (tid == 0) __hip_atomic_fetch_add(dep + u.pm, 1u, __ATOMIC_RELAXED, __HIP_MEMORY_SCOPE_AGENT); }
};
struct EpiDown {
    __device__ __forceinline__ bool keep(const Unit&) const { return false; }
    static constexpr bool PERM = true, PUBLISH = false;
    GAS bf16_t* OS; const GAS int* list;
    __device__ __forceinline__ void operator()(const f32x4 (&acc)[2][2][4][2], const Unit& u, int wr, int wc, int fr, int fq) const {
        const int col0 = u.pn * BM + wc * 32 + 8 * fq;
        int ts[2][4];
#pragma unroll
        for (int ai = 0; ai < 2; ++ai)
#pragma unroll
            for (int m = 0; m < 4; ++m) { const int rl = ai * HALF + wr * 64 + m * 16 + fr; ts[ai][m] = rl < u.x2 ? list[u.x0 * 16384 + u.x1 + rl] : -1; }
#pragma unroll
        for (int ai = 0; ai < 2; ++ai)
#pragma unroll
            for (int m = 0; m < 4; ++m) {
                if (ts[ai][m] >= 0) {
#pragma unroll
                    for (int bj = 0; bj < 2; ++bj) { const f32x4 v0 = acc[ai][bj][m][0], v1 = acc[ai][bj][m][1];
                        u32x4 w; w.x = cvt_pk_bf16(v0[0], v0[1]); w.y = cvt_pk_bf16(v0[2], v0[3]); w.z = cvt_pk_bf16(v1[0], v1[1]); w.w = cvt_pk_bf16(v1[2], v1[3]);
                        *(GAS u32x4*)(OS + (size_t)ts[ai][m] * D + col0 + bj * HALF) = w; } } }
    }
};
}


namespace att {
typedef short bf16x8 __attribute__((ext_vector_type(8)));
typedef short s16x4 __attribute__((ext_vector_type(4)));
typedef float f32x16 __attribute__((ext_vector_type(16)));
#define ASBAR() __builtin_amdgcn_sched_barrier(0)
template <bool B> struct BoolC { static constexpr bool value = B; };
__device__ __forceinline__ int crow(int r, int hi) { return (r & 3) + 8 * (r >> 2) + 4 * hi; }
__device__ __forceinline__ unsigned cvtpk(float lo, float hi) { unsigned r; asm volatile("v_cvt_pk_bf16_f32 %0, %1, %2" : "=v"(r) : "v"(lo), "v"(hi)); return r; }
template <int OFF> __device__ __forceinline__ s16x4 tr_read(int vb) { s16x4 r; asm volatile("ds_read_b64_tr_b16 %0, %1 offset:%2" : "=&v"(r) : "v"(vb), "i"(OFF) : "memory"); return r; }
__device__ __forceinline__ int v_rd_base(int lane) { return ((lane & 3) << 3) | (((lane >> 2) & 3) << 6) | (((lane >> 4) & 1) << 5) | (((lane >> 5) & 1) << 8); }

struct Args {
    const GAS bf16_t* Q; int qp, qgs;
    const GAS bf16_t* K; int kp, kgs;
    const GAS bf16_t* V; int vp;
    GAS bf16_t* O; int op;
    int q0;
    int jlo, jhi;
    float C;
    float sl2;
    const GAS float* relb;
    const GAS float* rope;
    float lam, osc; const GAS float* subln;
    const GAS unsigned* cmax;
};

template <int DQK, int DV, int NG, int MODE>
struct Body {
    static constexpr int KROWB = (DQK == 64) ? 128 : 256, KTILE = 64 * KROWB, VTILE = 64 * DV * 2, NSLOT = 4, KA = NSLOT - 1, VA = NSLOT - 2;
    static constexpr int OFF_K = 0, OFF_V = NSLOT * NG * KTILE, OFF_WS = OFF_V + NSLOT * VTILE, OFF_TB = OFF_WS + 8 * 64 * 4, LDS_END = OFF_TB + 2304;
    static constexpr int ND0 = DQK / 16, NDV = DV / 32, KCPR = DQK / 8;
    static constexpr int NKD = NG * KTILE / 1024 / 8, NVD = VTILE / 1024 / 8;
    static constexpr int WPG = 8 / NG;
    static constexpr float THR2 = 11.5f, SKIP2 = 40.f;
    static __device__ __forceinline__ int kswz(int row, int ch) { return row * KROWB + ((ch ^ (KROWB == 128 ? ((row >> 1) & 7) : (row & 15))) << 4); }
    static constexpr int v_rd_off(int d0, int ks, int half) { return d0 * 512 + ks * (2 * NDV * 512) + half * (NDV * 512); }

    template <int D0> static __device__ __forceinline__ void pv_one(f32x16& od, int vb, bf16x8 pa0, bf16x8 pa1, bf16x8 pa2, bf16x8 pa3) {
        const s16x4 l0 = tr_read<v_rd_off(D0, 0, 0)>(vb), h0 = tr_read<v_rd_off(D0, 0, 1)>(vb), l1 = tr_read<v_rd_off(D0, 1, 0)>(vb), h1 = tr_read<v_rd_off(D0, 1, 1)>(vb);
        const s16x4 l2 = tr_read<v_rd_off(D0, 2, 0)>(vb), h2 = tr_read<v_rd_off(D0, 2, 1)>(vb), l3 = tr_read<v_rd_off(D0, 3, 0)>(vb), h3 = tr_read<v_rd_off(D0, 3, 1)>(vb);
        asm volatile("s_waitcnt lgkmcnt(0)" ::: "memory"); ASBAR();
#define APK(L, H) (bf16x8){L[0], L[1], L[2], L[3], H[0], H[1], H[2], H[3]}
        od = __builtin_amdgcn_mfma_f32_32x32x16_bf16(pa0, APK(l0, h0), od, 0, 0, 0);
        od = __builtin_amdgcn_mfma_f32_32x32x16_bf16(pa1, APK(l1, h1), od, 0, 0, 0);
        od = __builtin_amdgcn_mfma_f32_32x32x16_bf16(pa2, APK(l2, h2), od, 0, 0, 0);
        od = __builtin_amdgcn_mfma_f32_32x32x16_bf16(pa3, APK(l3, h3), od, 0, 0, 0);
#undef APK
    }
    static __device__ __forceinline__ void pv_ld0(int vb, s16x4 (&f)[8]) {
        f[0] = tr_read<v_rd_off(0, 0, 0)>(vb); f[1] = tr_read<v_rd_off(0, 0, 1)>(vb); f[2] = tr_read<v_rd_off(0, 1, 0)>(vb); f[3] = tr_read<v_rd_off(0, 1, 1)>(vb);
        f[4] = tr_read<v_rd_off(0, 2, 0)>(vb); f[5] = tr_read<v_rd_off(0, 2, 1)>(vb); f[6] = tr_read<v_rd_off(0, 3, 0)>(vb); f[7] = tr_read<v_rd_off(0, 3, 1)>(vb);
    }
    static __device__ __forceinline__ void pv_mm0(f32x16& od, const s16x4 (&f)[8], bf16x8 pa0, bf16x8 pa1, bf16x8 pa2, bf16x8 pa3) {
        asm volatile("s_waitcnt lgkmcnt(0)" ::: "memory"); ASBAR();
#define APK(L, H) (bf16x8){L[0], L[1], L[2], L[3], H[0], H[1], H[2], H[3]}
        od = __builtin_amdgcn_mfma_f32_32x32x16_bf16(pa0, APK(f[0], f[1]), od, 0, 0, 0);
        od = __builtin_amdgcn_mfma_f32_32x32x16_bf16(pa1, APK(f[2], f[3]), od, 0, 0, 0);
        od = __builtin_amdgcn_mfma_f32_32x32x16_bf16(pa2, APK(f[4], f[5]), od, 0, 0, 0);
        od = __builtin_amdgcn_mfma_f32_32x32x16_bf16(pa3, APK(f[6], f[7]), od, 0, 0, 0);
#undef APK
    }
    static __device__ __forceinline__ void pv_all(f32x16 (&o)[NDV], int vb, bf16x8 pa0, bf16x8 pa1, bf16x8 pa2, bf16x8 pa3) {
        pv_one<0>(o[0], vb, pa0, pa1, pa2, pa3); pv_one<1>(o[1], vb, pa0, pa1, pa2, pa3);
        if constexpr (NDV == 4) { pv_one<2>(o[2], vb, pa0, pa1, pa2, pa3); pv_one<3>(o[3], vb, pa0, pa1, pa2, pa3); }
    }
    static __device__ __forceinline__ void qkt(f32x16& p0, f32x16& p1, const LAS unsigned char* Ks, const bf16x8 (&qr)[ND0], const f32x16& c0, float c1off, int r32, int hi) {
        constexpr int KAH = (MODE == 0) ? 0 : 2, KW = KAH + 1;
        bf16x8 f0[KW], f1[KW];
#pragma unroll
        for (int d0 = 0; d0 < KAH; ++d0) { f0[d0] = *(const LAS bf16x8*)(Ks + kswz(r32, d0 * 2 + hi)); f1[d0] = *(const LAS bf16x8*)(Ks + kswz(32 + r32, d0 * 2 + hi)); }
#pragma unroll
        for (int d0 = 0; d0 < ND0; ++d0) {
            if (d0 + KAH < ND0) { f0[(d0 + KAH) % KW] = *(const LAS bf16x8*)(Ks + kswz(r32, (d0 + KAH) * 2 + hi)); f1[(d0 + KAH) % KW] = *(const LAS bf16x8*)(Ks + kswz(32 + r32, (d0 + KAH) * 2 + hi)); }
            const bf16x8 b0 = f0[d0 % KW], b1 = f1[d0 % KW];
            if (d0 == 0) { p0 = __builtin_amdgcn_mfma_f32_32x32x16_bf16(b0, qr[0], c0, 0, 0, 0);
                if constexpr (MODE == 0) { f32x16 t;
#pragma unroll
                    for (int r = 0; r < 16; ++r) t[r] = c0[r] + c1off;
                    p1 = __builtin_amdgcn_mfma_f32_32x32x16_bf16(b1, qr[0], t, 0, 0, 0); }
                else p1 = __builtin_amdgcn_mfma_f32_32x32x16_bf16(b1, qr[0], c0, 0, 0, 0); }
            else { p0 = __builtin_amdgcn_mfma_f32_32x32x16_bf16(b0, qr[d0], p0, 0, 0, 0); p1 = __builtin_amdgcn_mfma_f32_32x32x16_bf16(b1, qr[d0], p1, 0, 0, 0); }
        }
    }
    static __device__ __forceinline__ void finishSM(f32x16& p0, f32x16& p1, float alpha, float& l_reg, bf16x8& pa0, bf16x8& pa1, bf16x8& pa2, bf16x8& pa3) {
        if constexpr (MODE != 0) {
#pragma unroll
            for (int r = 0; r < 16; ++r) p1[r] = __builtin_amdgcn_exp2f(p1[r]); }
        float ps = 0.f;
#pragma unroll
        for (int r = 0; r < 16; ++r) ps += p0[r];
#pragma unroll
        for (int r = 0; r < 16; ++r) ps += p1[r];
        { auto rr = __builtin_amdgcn_permlane32_swap(__float_as_uint(ps), __float_as_uint(ps), false, false); ps = __uint_as_float(rr[0]) + __uint_as_float(rr[1]); }
        l_reg = l_reg * alpha + ps;
#define APK4(P, BASE, OUT) do { unsigned a0 = cvtpk(P[BASE + 0], P[BASE + 1]), a1 = cvtpk(P[BASE + 2], P[BASE + 3]); \
        unsigned b0 = cvtpk(P[BASE + 4], P[BASE + 5]), b1 = cvtpk(P[BASE + 6], P[BASE + 7]); \
        auto r0 = __builtin_amdgcn_permlane32_swap(a0, b0, false, false); auto r1 = __builtin_amdgcn_permlane32_swap(a1, b1, false, false); \
        u32x4 w = {r0[0], r1[0], r0[1], r1[1]}; OUT = __builtin_bit_cast(bf16x8, w); } while (0)
        APK4(p0, 0, pa0); APK4(p0, 8, pa1); APK4(p1, 0, pa2); APK4(p1, 8, pa3);
#undef APK4
    }

    static __device__ __forceinline__ void unit(LAS unsigned char* lds, const Args& a) {
        const int tid = ltid(), wid = __builtin_amdgcn_readfirstlane(tid >> 6), lane = tid & 63, r32 = lane & 31, hi = lane >> 5;
        const int grp = wid / WPG, wg = wid % WPG;
        const int qrow = wg * 32 + r32, qpos = a.q0 + qrow, q0w = a.q0 + wg * 32, cw = q0w >> 6;
        const int wlo = (MODE == 1) ? cw - 8 : 0, whi = cw;
        LAS float* wsf = (LAS float*)(lds + OFF_WS) + wid * 64; LAS float* li_l = wsf; LAS float* al_l = wsf + 32;
        unsigned koff[NKD], voff[NVD]; int kdst[NKD], vdst[NVD];
#pragma unroll
        for (int c = 0; c < NKD; ++c) { const int pi = wid + 8 * c, g = pi / (KTILE / 1024), lp = pi % (KTILE / 1024), si = lp * 64 + lane;
            int row, ch; if (KROWB == 128) { row = si >> 3; ch = (si & 7) ^ ((row >> 1) & 7); } else { row = si >> 4; ch = (si & 15) ^ (row & 15); if (ch >= KCPR) ch = 0; }
            koff[c] = (unsigned)(g * a.kgs + row * a.kp + ch * 8) * 2u; kdst[c] = OFF_K + g * KTILE + lp * 1024; }
#pragma unroll
        for (int c = 0; c < NVD; ++c) { const int pi = wid + 8 * c, si = pi * 64 + lane, blk = si >> 5, kkh = blk / NDV, cblk = blk % NDV, within = si & 31, kk = kkh * 8 + (within >> 2);
            const int k = (kk & ~0xC) | ((kk & 4) << 1) | ((kk & 8) >> 1), cc = cblk * 32 + (within & 3) * 8;
            voff[c] = (unsigned)(k * a.vp + cc) * 2u; vdst[c] = OFF_V + pi * 1024; }
        const int NT = a.jhi - a.jlo + 1;
#define DMA_K(i) do { const GAS char* kb_ = (const GAS char*)a.K + (size_t)(a.jhi - (i)) * 64 * a.kp * 2; const int so_ = ((i) % NSLOT) * NG * KTILE; \
        _Pragma("unroll") for (int c = 0; c < NKD; ++c) __builtin_amdgcn_global_load_lds((const GAS unsigned*)(kb_ + koff[c]), (LAS unsigned*)(lds + so_ + kdst[c]), 16, 0, 0); } while (0)
#define DMA_V(i) do { const GAS char* vb_ = (const GAS char*)a.V + (size_t)(a.jhi - (i)) * 64 * a.vp * 2; const int so_ = ((i) % NSLOT) * VTILE; \
        _Pragma("unroll") for (int c = 0; c < NVD; ++c) __builtin_amdgcn_global_load_lds((const GAS unsigned*)(vb_ + voff[c]), (LAS unsigned*)(lds + so_ + vdst[c]), 16, 0, 0); } while (0)
#define WAITBAR(i) do { if ((i) + KA < NT) asm volatile("s_waitcnt vmcnt(%0)" :: "n"((KA - 1) * (NKD + NVD)) : "memory"); else asm volatile("s_waitcnt vmcnt(0)" ::: "memory"); \
        asm volatile("s_waitcnt lgkmcnt(0)" ::: "memory"); __builtin_amdgcn_s_barrier(); asm volatile("" ::: "memory"); } while (0)
        asm volatile("s_waitcnt vmcnt(0) lgkmcnt(0)" ::: "memory"); __builtin_amdgcn_s_barrier(); asm volatile("" ::: "memory");
        _Pragma("unroll") for (int t = 0; t < KA; ++t) { if (t < NT) DMA_K(t); if (t >= 1 && t - 1 < NT) DMA_V(t - 1); }
        LAS float* tb = (LAS float*)(lds + OFF_TB);
        if constexpr (MODE == 1) { for (int i = tid; i < 513; i += 512) tb[i] = a.relb[i] * 1.4426950408889634f; }
        bf16x8 qr[ND0];
        { const GAS bf16_t* Qw = a.Q + (size_t)qrow * a.qp + grp * a.qgs + hi * 8;
          u32x4 qraw[ND0];
#pragma unroll
          for (int d0 = 0; d0 < ND0; ++d0) qraw[d0] = *(const GAS u32x4*)(Qw + d0 * 16);
          if constexpr (MODE == 2) {
              const GAS float* rp = a.rope + ((size_t)qpos * 16 + hi * 8) * 2;
              const u32x4 w1 = qraw[4], w2 = qraw[5]; u32x4 o1, o2;
#pragma unroll
              for (int e = 0; e < 4; ++e) {
                  const f32x4 cs = *(const GAS f32x4*)(rp + e * 4);
                  const float x1a = bflo(w1[e]), x1b = bfhi(w1[e]), x2a = bflo(w2[e]), x2b = bfhi(w2[e]);
                  o1[e] = cvtpk((x1a * cs[0] - x2a * cs[1]) * a.C, (x1b * cs[2] - x2b * cs[3]) * a.C);
                  o2[e] = cvtpk((x1a * cs[1] + x2a * cs[0]) * a.C, (x1b * cs[3] + x2b * cs[2]) * a.C);
              }
              qr[4] = __builtin_bit_cast(bf16x8, o1); qr[5] = __builtin_bit_cast(bf16x8, o2);
          }
#pragma unroll
          for (int d0 = 0; d0 < ((MODE == 2) ? 4 : ND0); ++d0) { u32x4 w;
#pragma unroll
              for (int e = 0; e < 4; ++e) w[e] = cvtpk(bflo(qraw[d0][e]) * a.C, bfhi(qraw[d0][e]) * a.C);
              qr[d0] = __builtin_bit_cast(bf16x8, w); }
        }
        float bq = 0.f;
        if constexpr (MODE == 0) {
#pragma unroll
            for (int d0 = 0; d0 < ND0; ++d0) { const u32x4 cma = *(const GAS u32x4*)(a.cmax + grp * 64 + d0 * 16 + hi * 8), cmb = *(const GAS u32x4*)(a.cmax + grp * 64 + d0 * 16 + hi * 8 + 4);
                const u32x4 qw = __builtin_bit_cast(u32x4, qr[d0]);
                bq += fabsf(bflo(qw[0])) * __uint_as_float(cma[0]) + fabsf(bfhi(qw[0])) * __uint_as_float(cma[1]) + fabsf(bflo(qw[1])) * __uint_as_float(cma[2]) + fabsf(bfhi(qw[1])) * __uint_as_float(cma[3])
                    + fabsf(bflo(qw[2])) * __uint_as_float(cmb[0]) + fabsf(bfhi(qw[2])) * __uint_as_float(cmb[1]) + fabsf(bflo(qw[3])) * __uint_as_float(cmb[2]) + fabsf(bfhi(qw[3])) * __uint_as_float(cmb[3]); }
            { auto rr = __builtin_amdgcn_permlane32_swap(__float_as_uint(bq), __float_as_uint(bq), false, false); bq = (__uint_as_float(rr[0]) + __uint_as_float(rr[1])) * 1.01f; }
        }
        LAS int* flg = (LAS int*)(lds + OFF_TB);
        if constexpr (MODE == 0) { if (tid < 16) flg[tid] = 0; }
        float m_reg = 0.f, l_reg = 0.f; f32x16 o[NDV];
#pragma unroll
        for (int d = 0; d < NDV; ++d) o[d] = f32x16{};
        f32x16 cin0;
        const float c1off_ = (MODE == 0) ? a.sl2 * 32.f : 0.f;
#pragma unroll
        for (int r = 0; r < 16; ++r) { const float kr = (float)crow(r, hi); cin0[r] = (MODE == 0) ? a.sl2 * kr : 0.f; }
        const int vb0 = (int)(uintptr_t)(lds + OFF_V) + v_rd_base(lane);
        f32x16 pA0, pA1, pB0, pB1; float alA = 1.f, alB = 1.f; bool liveA = false, liveB = false; bf16x8 pa0, pa1, pa2, pa3;
        asm volatile("s_waitcnt vmcnt(0) lgkmcnt(0)" ::: "memory"); __builtin_amdgcn_s_barrier(); asm volatile("" ::: "memory");
#define ISSUE(i) do { if ((i) + KA < NT) DMA_K((i) + KA); if ((i) + VA < NT) DMA_V((i) + VA); } while (0)
#define RESC(al) do { if (__any((al) < 1.f)) { if (hi == 0) al_l[r32] = (al); asm volatile("s_waitcnt lgkmcnt(0)" ::: "memory"); \
        _Pragma("unroll") for (int d = 0; d < NDV; ++d) _Pragma("unroll") for (int r = 0; r < 16; ++r) o[d][r] *= al_l[crow(r, hi)]; } } while (0)
        auto head_first = [&](f32x16& p0, f32x16& p1, int j) __attribute__((always_inline)) {
            float tj = 0.f;
            if constexpr (MODE == 0) {
                tj = -a.sl2 * (float)(qpos - j * 64);
                const int dk = j * 64 + 4 * hi - qpos;
#pragma unroll
                for (int r = 0; r < 16; ++r) { const int d0_ = dk + (r & 3) + 8 * (r >> 2); if (d0_ > 0) p0[r] -= 2.f * a.sl2 * (float)d0_; if (d0_ + 32 > 0) p1[r] -= 2.f * a.sl2 * (float)(d0_ + 32); }
            } else if constexpr (MODE == 1) {
                const int dq = qpos - j * 64 - 4 * hi + 256;
#pragma unroll
                for (int r = 0; r < 16; ++r) { const int c0 = (r & 3) + 8 * (r >> 2); int i0 = dq - c0, i1 = dq - c0 - 32; i0 = i0 < 0 ? 0 : i0 > 512 ? 512 : i0; i1 = i1 < 0 ? 0 : i1 > 512 ? 512 : i1;
                    p0[r] += tb[i0]; p1[r] += tb[i1]; }
            }
            float pm = fmaxf(fmaxf(p0[0], p0[1]), p1[0]);
#pragma unroll
            for (int r = 2; r < 16; r += 2) pm = fmaxf(fmaxf(pm, p0[r]), p0[r + 1]);
#pragma unroll
            for (int r = 1; r < 15; r += 2) pm = fmaxf(fmaxf(pm, p1[r]), p1[r + 1]);
            pm = fmaxf(pm, p1[15]);
            { auto rr = __builtin_amdgcn_permlane32_swap(__float_as_uint(pm), __float_as_uint(pm), false, false); pm = fmaxf(__uint_as_float(rr[0]), __uint_as_float(rr[1])); }
            const float dl = pm + tj; m_reg += dl; tj -= dl;
#pragma unroll
            for (int r = 0; r < 16; ++r) { cin0[r] -= dl; p0[r] += tj; p1[r] += tj; }
#pragma unroll
            for (int r = 0; r < 16; ++r) p0[r] = __builtin_amdgcn_exp2f(p0[r]);
            if constexpr (MODE == 0) {
#pragma unroll
                for (int r = 0; r < 16; ++r) p1[r] = __builtin_amdgcn_exp2f(p1[r]); }
        };
        auto head = [&](f32x16& p0, f32x16& p1, float& alpha, bool& live, int j, auto doexp_c) __attribute__((always_inline)) { constexpr bool DOEXP = decltype(doexp_c)::value;
            float tj = 0.f;
            if constexpr (MODE == 0) tj = -a.sl2 * (float)(qpos - j * 64);
            else if constexpr (MODE == 1) {
                if (j <= cw - 5) tj = tb[512];
                else { const int dq = qpos - j * 64 - 4 * hi + 256;
#pragma unroll
                    for (int r = 0; r < 16; ++r) { const int c0 = (r & 3) + 8 * (r >> 2); int i0 = dq - c0, i1 = dq - c0 - 32; i0 = i0 < 0 ? 0 : i0 > 512 ? 512 : i0; i1 = i1 < 0 ? 0 : i1 > 512 ? 512 : i1;
                        p0[r] += tb[i0]; p1[r] += tb[i1]; } }
            }
            float pm = fmaxf(fmaxf(p0[0], p0[1]), p1[0]);
#pragma unroll
            for (int r = 2; r < 16; r += 2) pm = fmaxf(fmaxf(pm, p0[r]), p0[r + 1]);
#pragma unroll
            for (int r = 1; r < 15; r += 2) pm = fmaxf(fmaxf(pm, p1[r]), p1[r + 1]);
            pm = fmaxf(pm, p1[15]);
            { auto rr = __builtin_amdgcn_permlane32_swap(__float_as_uint(pm), __float_as_uint(pm), false, false); pm = fmaxf(__uint_as_float(rr[0]), __uint_as_float(rr[1])); }
            pm += tj;
            alpha = 1.f; live = true;
            if constexpr (MODE == 0) { if (__all(pm < -SKIP2)) { live = false; return; } }
            if (__builtin_expect(!__all(pm <= THR2), 0)) {
                const float dl = fmaxf(pm, 0.f);
                alpha = __builtin_amdgcn_exp2f(-dl); m_reg += dl; tj -= dl;
#pragma unroll
                for (int r = 0; r < 16; ++r) { cin0[r] -= dl; }
            }
            if (MODE != 2) {
#pragma unroll
                for (int r = 0; r < 16; ++r) { p0[r] += tj; p1[r] += tj; }
            } else if (tj != 0.f) {
#pragma unroll
                for (int r = 0; r < 16; ++r) { p0[r] += tj; p1[r] += tj; }
            }
            if constexpr (DOEXP) {
#pragma unroll
                for (int r = 0; r < 16; ++r) p0[r] = __builtin_amdgcn_exp2f(p0[r]); }
        };
#define KSLOT(i) (lds + OFF_K + (((i) % NSLOT) * NG + grp) * KTILE)
#define VSLOT(i) (vb0 + ((i) % NSLOT) * VTILE)
#define SSTEP(X0, X1, ALX, LIVEX, Y0, Y1, ALY, LIVEY, i) do { \
        ISSUE(i); \
        if constexpr (MODE != 0) { ASBAR(); qkt(X0, X1, KSLOT(i), qr, cin0, c1off_, r32, hi); } \
        if constexpr (MODE != 0) { s16x4 vf_[8]; pv_ld0(VSLOT((i) + NSLOT - 1), vf_); finishSM(Y0, Y1, ALY, l_reg, pa0, pa1, pa2, pa3); ASBAR(); \
              \
            head(X0, X1, ALX, LIVEX, a.jhi - (i), BoolC<false>{}); ASBAR(); \
            pv_mm0(o[0], vf_, pa0, pa1, pa2, pa3); \
            _Pragma("unroll") for (int r_ = 0; r_ < 8; ++r_) { X0[r_] = __builtin_amdgcn_exp2f(X0[r_]); asm volatile("" : "+v"(X0[r_])); }   \
            pv_one<1>(o[1], VSLOT((i) + NSLOT - 1), pa0, pa1, pa2, pa3); \
            _Pragma("unroll") for (int r_ = 8; r_ < 16; ++r_) { X0[r_] = __builtin_amdgcn_exp2f(X0[r_]); asm volatile("" : "+v"(X0[r_])); } ASBAR(); } \
        else if (LIVEY) {   \
            ASBAR(); qkt(X0, X1, KSLOT(i), qr, cin0, c1off_, r32, hi); finishSM(Y0, Y1, ALY, l_reg, pa0, pa1, pa2, pa3); ASBAR(); \
            head(X0, X1, ALX, LIVEX, a.jhi - (i), BoolC<false>{}); ASBAR(); \
            pv_one<0>(o[0], VSLOT((i) + NSLOT - 1), pa0, pa1, pa2, pa3); \
            _Pragma("unroll") for (int r_ = 0; r_ < 4; ++r_) { X0[r_] = __builtin_amdgcn_exp2f(X0[r_]); asm volatile("" : "+v"(X0[r_])); X1[r_] = __builtin_amdgcn_exp2f(X1[r_]); asm volatile("" : "+v"(X1[r_])); } \
            pv_one<1>(o[1], VSLOT((i) + NSLOT - 1), pa0, pa1, pa2, pa3); \
            _Pragma("unroll") for (int r_ = 4; r_ < 8; ++r_) { X0[r_] = __builtin_amdgcn_exp2f(X0[r_]); asm volatile("" : "+v"(X0[r_])); X1[r_] = __builtin_amdgcn_exp2f(X1[r_]); asm volatile("" : "+v"(X1[r_])); } \
            pv_one<NDV == 4 ? 2 : 0>(o[NDV == 4 ? 2 : 0], VSLOT((i) + NSLOT - 1), pa0, pa1, pa2, pa3); \
            _Pragma("unroll") for (int r_ = 8; r_ < 12; ++r_) { X0[r_] = __builtin_amdgcn_exp2f(X0[r_]); asm volatile("" : "+v"(X0[r_])); X1[r_] = __builtin_amdgcn_exp2f(X1[r_]); asm volatile("" : "+v"(X1[r_])); } \
            pv_one<NDV == 4 ? 3 : 1>(o[NDV == 4 ? 3 : 1], VSLOT((i) + NSLOT - 1), pa0, pa1, pa2, pa3); \
            _Pragma("unroll") for (int r_ = 12; r_ < 16; ++r_) { X0[r_] = __builtin_amdgcn_exp2f(X0[r_]); asm volatile("" : "+v"(X0[r_])); X1[r_] = __builtin_amdgcn_exp2f(X1[r_]); asm volatile("" : "+v"(X1[r_])); } ASBAR(); } \
        else { ASBAR(); qkt(X0, X1, KSLOT(i), qr, cin0, c1off_, r32, hi); ASBAR(); head(X0, X1, ALX, LIVEX, a.jhi - (i), BoolC<true>{}); \
            _Pragma("unroll") for (int r_ = 0; r_ < 16; ++r_) X1[r_] = __builtin_amdgcn_exp2f(X1[r_]); } \
        if constexpr (MODE == 0) { const int jn_ = a.jhi - (i);   \
            const bool fin_ = __all(bq - a.sl2 * (float)(qpos - 64 * jn_ + 1) - m_reg < -SKIP2); if (lane == 0) flg[((i) & 1) * 8 + wid] = fin_ ? 1 : 0; } \
        WAITBAR(i); \
        if constexpr (MODE == 0) { const u32x4 f0_ = *(const LAS u32x4*)(flg + ((i) & 1) * 8), f1_ = *(const LAS u32x4*)(flg + ((i) & 1) * 8 + 4); \
            stop = __builtin_amdgcn_readfirstlane((int)(f0_.x & f0_.y & f0_.z & f0_.w & f1_.x & f1_.y & f1_.z & f1_.w)) != 0; } \
        if (MODE != 0 || LIVEX) RESC(ALX); } while (0)
        const int jmin_ = wlo > a.jlo ? wlo : a.jlo;
        const int ia = a.jhi - whi, ib = a.jhi - jmin_;
        bool stop = false, lastB = false;
        int i = 0;
        for (; i < ia; ++i) { ISSUE(i); if constexpr (MODE == 0) { if (lane == 0) flg[(i & 1) * 8 + wid] = 0; } WAITBAR(i); }
        { ISSUE(i); ASBAR(); qkt(pA0, pA1, KSLOT(i), qr, cin0, c1off_, r32, hi); head_first(pA0, pA1, a.jhi - i); liveA = true; alA = 1.f;
          if constexpr (MODE == 0) { if (lane == 0) flg[(i & 1) * 8 + wid] = 0; }
          WAITBAR(i); ++i; }
        for (; i + 1 <= ib; i += 2) {
            SSTEP(pB0, pB1, alB, liveB, pA0, pA1, alA, liveA, i); if (MODE == 0 && stop) { lastB = true; ++i; break; }
            SSTEP(pA0, pA1, alA, liveA, pB0, pB1, alB, liveB, i + 1); if (MODE == 0 && stop) { lastB = false; i += 2; break; }
        }
        if (!stop && i <= ib) { SSTEP(pB0, pB1, alB, liveB, pA0, pA1, alA, liveA, i); ++i; lastB = true; }
        if (lastB) { if (MODE != 0 || liveB) { finishSM(pB0, pB1, alB, l_reg, pa0, pa1, pa2, pa3); ASBAR(); pv_all(o, VSLOT(i + NSLOT - 1), pa0, pa1, pa2, pa3); } }
        else if (MODE != 0 || liveA) { finishSM(pA0, pA1, alA, l_reg, pa0, pa1, pa2, pa3); ASBAR(); pv_all(o, VSLOT(i + NSLOT - 1), pa0, pa1, pa2, pa3); }
        if (!stop) { for (; i < NT; ++i) { ISSUE(i); WAITBAR(i); } }
        asm volatile("s_waitcnt vmcnt(0)" ::: "memory");
#undef ISSUE
#undef SSTEP
#undef KSLOT
#undef VSLOT
        int r32e = r32, hie = hi; asm volatile("" : "+v"(r32e), "+v"(hie));
        if (hi == 0) li_l[r32] = l_reg; asm volatile("s_waitcnt lgkmcnt(0)" ::: "memory");
        float rli[16];
#pragma unroll
        for (int r = 0; r < 16; ++r) rli[r] = __builtin_amdgcn_rcpf(li_l[crow(r, hi)]);
        if constexpr (MODE != 0) {
            GAS bf16_t* Ow = a.O + (size_t)(wg * 32) * a.op;
#pragma unroll
            for (int r = 0; r < 16; ++r) { const int orow = crow(r, hie);
#pragma unroll
                for (int d0 = 0; d0 < NDV; ++d0) Ow[(size_t)orow * a.op + d0 * 32 + r32e] = (bf16_t)f2bf(o[d0][r] * rli[r]); }
        } else {
            asm volatile("s_waitcnt lgkmcnt(0)" ::: "memory"); __builtin_amdgcn_s_barrier(); asm volatile("" ::: "memory");
            LAS float* xs = (LAS float*)lds + wg * 4096;
            if (grp == 1) {
#pragma unroll
                for (int d0 = 0; d0 < NDV; ++d0)
#pragma unroll
                    for (int r = 0; r < 16; ++r) xs[(d0 * 16 + r) * 64 + lane] = o[d0][r] * rli[r];
            }
            asm volatile("s_waitcnt lgkmcnt(0)" ::: "memory"); __builtin_amdgcn_s_barrier(); asm volatile("" ::: "memory");
            if (grp == 0) {
                float ss[16];
#pragma unroll
                for (int r = 0; r < 16; ++r) { float s = 0.f;
#pragma unroll
                    for (int d0 = 0; d0 < NDV; ++d0) { const float y = o[d0][r] * rli[r] - a.lam * xs[(d0 * 16 + r) * 64 + lane]; o[d0][r] = y; s += y * y; }
                    ss[r] = s; }
#pragma unroll
                for (int r = 0; r < 16; ++r) { float s = ss[r];
#pragma unroll
                    for (int sh = 1; sh < 32; sh <<= 1) s += __shfl_xor(s, sh);
                    ss[r] = rsqrtf(s * (1.f / 128.f) + EPS) * a.osc; }
                GAS bf16_t* Ow = a.O + (size_t)(wg * 32) * a.op;
#pragma unroll
                for (int d0 = 0; d0 < NDV; ++d0) { const float g = a.subln[d0 * 32 + r32e];
#pragma unroll
                    for (int r = 0; r < 16; ++r) Ow[(size_t)crow(r, hie) * a.op + d0 * 32 + r32e] = (bf16_t)f2bf(o[d0][r] * ss[r] * g); }
            }
        }
#undef DMA_K
#undef DMA_V
#undef WAITBAR
#undef RESC
    }
};
typedef Body<64, 128, 2, 0> Diff;
typedef Body<64, 64, 1, 1> Band;
typedef Body<96, 64, 1, 2> Mla;
#undef ASBAR
}

struct TrItem { const GAS float* src; const GAS float* ksc; GAS bf16_t* dst; int ldw, Kd; };
__device__ __forceinline__ void tr_load(const TrItem& t, float (&v)[32], int lane) {
#pragma unroll
    for (int i = 0; i < 32; ++i) v[i] = __builtin_nontemporal_load(t.src + (size_t)(2 * i) * t.ldw);
}
__device__ __forceinline__ void tr_store(const TrItem& t, float (&v)[32], LAS float* scr, int lane) {
    if (t.ksc) {
#pragma unroll
        for (int i = 0; i < 32; ++i) v[i] *= t.ksc[2 * i + (lane >> 5)];
    }
#pragma unroll
    for (int i = 0; i < 32; ++i) scr[(2 * i + (lane >> 5)) * 33 + (lane & 31)] = v[i];
    asm volatile("s_waitcnt lgkmcnt(0)" ::: "memory");
    const int c = lane & 7;
#pragma unroll
    for (int j = 0; j < 4; ++j) { const int n = (lane >> 3) + 8 * j; const LAS float* s = scr + (8 * c) * 33 + n;
        u32x4 o; o.x = pk2(s[0 * 33], s[1 * 33]); o.y = pk2(s[2 * 33], s[3 * 33]); o.z = pk2(s[4 * 33], s[5 * 33]); o.w = pk2(s[6 * 33], s[7 * 33]);
        *(GAS u32x4*)(t.dst + (size_t)n * t.Kd + 8 * c) = o; }
    asm volatile("s_waitcnt lgkmcnt(0)" ::: "memory");
}
__device__ __forceinline__ TrItem tr_decode(const P& p, gptr ws, int l, int it, int lane) {
    GAS bf16_t* WIN = (GAS bf16_t*)(ws + WS_WIN); GAS bf16_t* WQ = (GAS bf16_t*)(ws + WS_WQ); GAS bf16_t* WKV = (GAS bf16_t*)(ws + WS_WKV); GAS bf16_t* WBR = (GAS bf16_t*)(ws + WS_WBR);
    GAS bf16_t* WOUT = (GAS bf16_t*)(ws + WS_WOUT); GAS bf16_t* WGU = (GAS bf16_t*)(ws + WS_WGU); GAS bf16_t* WD = (GAS bf16_t*)(ws + WS_WD);
    constexpr int I_IN = 16 * 213, I_Q = 6 * 24, I_KV = 4 * 32, I_BR = 3 * 8 * 32, I_O = 16 * 32, I_G = 16 * 16 * 16;
    const GAS float* W; const GAS float* ks = nullptr; GAS bf16_t* WT; int ldw, Kd, k0, n0, dst0;
    int r = it;
    if (r < I_IN) { const int kb = r / 213, nb = r % 213; W = INP(I_WIN) + (size_t)l * D * INW; ldw = INW; k0 = kb * 64; n0 = nb * 32; WT = WIN; Kd = D; dst0 = n0 < 3744 ? n0 : n0 + 96; }
    else if ((r -= I_IN) < I_Q) { const int kb = r / 24, nb = r % 24; W = INP(I_WQB) + (size_t)l * 384 * 768; ldw = 768; k0 = kb * 64; n0 = nb * 32; WT = WQ; Kd = 384; dst0 = n0; ks = INP(I_QNG) + l * 384; }
    else if ((r -= I_Q) < I_KV) { const int kb = r / 32, nb = r % 32; n0 = nb * 32; const int h = n0 >> 7, d = n0 & 127; W = INP(I_WKVB) + (size_t)l * 256 * 1024; ldw = 1024; k0 = kb * 64; WT = WKV; Kd = 256; dst0 = d < 64 ? h * 64 + d : 512 + h * 64 + d - 64; ks = INP(I_KVNG) + l * 256; }
    else if ((r -= I_KV) < I_BR) { const int br = r / 256, q = r % 256, kb = q / 32, nb = q % 32; W = (br == 0 ? INP(I_WBD) : br == 1 ? INP(I_WBC) : INP(I_WBM)) + (size_t)l * 512 * D; ldw = D; k0 = kb * 64; n0 = nb * 32; WT = WBR + (size_t)br * D * 512; Kd = 512; dst0 = n0; }
    else if ((r -= I_BR) < I_O) { const int kb = r / 32, nb = r % 32; W = INP(I_WOUT) + (size_t)l * D * D; ldw = D; k0 = kb * 64; n0 = nb * 32; WT = WOUT; Kd = D; dst0 = n0; }
    else if ((r -= I_O) < 2 * I_G) { const int up = r / I_G, q = r % I_G, e = q / 256, q2 = q % 256, kb = q2 / 16, nb = q2 % 16; n0 = nb * 32;
        W = (up ? INP(I_WEU) : INP(I_WEG)) + ((size_t)l * NE + e) * D * FF; ldw = FF; k0 = kb * 64; WT = WGU + (size_t)e * D * D; Kd = D; dst0 = (n0 >> 7) * 256 + up * 128 + (n0 & 127); }
    else { r -= 2 * I_G; const int e = r / 256, q2 = r % 256, kb = q2 / 32, nb = q2 % 32; W = INP(I_WED) + ((size_t)l * NE + e) * FF * D; ldw = D; k0 = kb * 64; n0 = nb * 32; WT = WD + (size_t)e * D * FF; Kd = FF; dst0 = n0; }
    TrItem t; t.src = W + (size_t)(k0 + (lane >> 5)) * ldw + n0 + (lane & 31); t.ksc = ks ? ks + k0 : nullptr; t.dst = WT + (size_t)dst0 * Kd + k0; t.ldw = ldw; t.Kd = Kd; return t;
}
constexpr int CV_EARLY = 16 * 213 + 6 * 24 + 4 * 32, CV_NIT = CV_EARLY + 3 * 8 * 32 + 16 * 32 + 2 * 16 * 16 * 16 + 16 * 8 * 32, CV_UNITS = (CV_NIT - CV_EARLY) / 64;
static_assert((CV_NIT - CV_EARLY) % 64 == 0, "late items per unit");
__device__ __forceinline__ void ph_convert(const P& p, gptr ws, LAS unsigned char* lds, int l, int gw, int NGW, int NIT) {
    const int tid = ltid(), lane = tid & 63, wave = tid >> 6;
    LAS float* scr = (LAS float*)(lds + wave * 16384);
    float va[32], vb_[32];
    int it = gw;
    TrItem ta, tb; if (it < NIT) { ta = tr_decode(p, ws, l, it, lane); tr_load(ta, va, lane); }
    while (it < NIT) {
        const int it1 = it + NGW;
        if (it1 < NIT) { tb = tr_decode(p, ws, l, it1, lane); tr_load(tb, vb_, lane); }
        tr_store(ta, va, scr, lane);
        const int it2 = it1 + NGW;
        if (it1 >= NIT) break;
        if (it2 < NIT) { ta = tr_decode(p, ws, l, it2, lane); tr_load(ta, va, lane); }
        tr_store(tb, vb_, scr, lane);
        it = it2;
    }
}
__device__ __forceinline__ void ph_convert_early(const P& p, gptr ws, LAS unsigned char* lds, int vb, int nvb, int l) {
    const int tid = ltid();
    ph_convert(p, ws, lds, l, vb * 8 + (tid >> 6), nvb * 8, CV_EARLY);
    GAS bf16_t* WIN = (GAS bf16_t*)(ws + WS_WIN);
    for (int i = vb * 512 + tid; i < 96 * D / 8; i += nvb * 512) *(GAS u32x4*)(WIN + (size_t)3744 * D + (size_t)i * 8) = (u32x4){0u, 0u, 0u, 0u};
}


__device__ __forceinline__ void moe_table(gptr ws, LAS int* tab, int layer) {
    const int tid = ltid();
    __syncthreads();
    if (tid < 16) tab[32 + tid] = (int)__hip_atomic_load((GAS unsigned*)(ws + WS_CTL) + CW_CNT + 64 * layer + tid, __ATOMIC_RELAXED, __HIP_MEMORY_SCOPE_AGENT);
    __syncthreads();
    if (tid == 0) { int s = 0; tab[0] = 0; for (int e = 0; e < 16; ++e) { s += (tab[32 + e] + 255) >> 8; tab[e + 1] = s; } }
    __syncthreads();
}

#define XB_TMO      128
#define XB_XCNT(j)  (256  + 64 * (j))
#define XB_XSUB(j)  (1280 + 64 * (j))
#define XB_XGEN(j)  (2304 + 64 * (j))
#define XB_TOP      3328
#define XB_TOPGEN   3392
#define XCD_BAR_WORDS 3456
#define XB_SPIN_CAP (1u << 18)
__device__ __forceinline__ unsigned xb_ld(unsigned* p)              { return __hip_atomic_load(p, __ATOMIC_RELAXED, __HIP_MEMORY_SCOPE_AGENT); }
__device__ __forceinline__ unsigned xb_add(unsigned* p, unsigned v) { return __hip_atomic_fetch_add(p, v, __ATOMIC_RELAXED, __HIP_MEMORY_SCOPE_AGENT); }
__device__ __forceinline__ unsigned xb_xcc_id() { return (unsigned)__builtin_amdgcn_s_getreg((3 << 11) | 20) & 0xFu; }
#define XB_SPIN(cond, bar) do { unsigned _sp = 0; while (cond) { __builtin_amdgcn_s_sleep(1); \
    if ((++_sp & 255u) == 0u) { if (xb_ld(&(bar)[XB_TMO])) break; if (_sp > XB_SPIN_CAP) { atomicAdd(&(bar)[XB_TMO], 1u); break; } } } } while (0)
struct XcdBarrier { unsigned* bar; unsigned x; volatile LAS unsigned* st; };
__device__ __forceinline__ XcdBarrier xcd_barrier_post(unsigned* bar, volatile LAS unsigned* st) {
    XcdBarrier b; b.bar = bar; b.x = xb_xcc_id(); b.st = st;
    if (threadIdx.x == 0) (void)xb_add(&bar[XB_XCNT(b.x)], 1u);
    return b;
}
__device__ __forceinline__ void xcd_barrier_complete(unsigned* bar, unsigned x, unsigned& nloc, unsigned& nx) {
    const unsigned G = gridDim.x * gridDim.y * gridDim.z;
    unsigned sum, cnt, mine, sp = 0u;
    for (;;) {
        sum = 0u; cnt = 0u; mine = 0u;
#pragma unroll
        for (unsigned j = 0; j < 16; ++j) { const unsigned c = xb_ld(&bar[XB_XCNT(j)]); sum += c; cnt += (c > 0u) ? 1u : 0u; mine = (j == x) ? c : mine; }
        if (sum == G) break;
        __builtin_amdgcn_s_sleep(1);
        if ((++sp & 255u) == 0u) { if (xb_ld(&bar[XB_TMO])) break; if (sp > XB_SPIN_CAP) { atomicAdd(&bar[XB_TMO], 1u); break; } }
    }
    nloc = mine > 0u ? mine : 1u; nx = cnt > 0u ? cnt : 1u;
}
__device__ __forceinline__ void xcd_barrier(const XcdBarrier& b) {
    asm volatile("s_waitcnt vmcnt(0)" ::: "memory");
    __syncthreads();
    if (threadIdx.x == 0) {
        unsigned* bar = b.bar;
        __builtin_amdgcn_s_waitcnt(0);
        unsigned nloc = b.st[0], nx = b.st[1];
        if (nloc == 0u) { xcd_barrier_complete(bar, b.x, nloc, nx); b.st[0] = nloc; b.st[1] = nx; }
        const unsigned old = xb_add(&bar[XB_XSUB(b.x)], 1u);
        const unsigned gen = old / nloc;
        if (old + 1u == (gen + 1u) * nloc) {
            __builtin_amdgcn_fence(__ATOMIC_RELEASE, "agent");
            asm volatile("s_waitcnt vmcnt(0)" ::: "memory");
            const unsigned og = xb_add(&bar[XB_TOP], 1u);
            const unsigned tg = og / nx;
            if (og + 1u == (tg + 1u) * nx) xb_add(&bar[XB_TOPGEN], 1u);
            else XB_SPIN(xb_ld(&bar[XB_TOPGEN]) == tg, bar);
            __builtin_amdgcn_fence(__ATOMIC_ACQUIRE, "agent");
            xb_add(&bar[XB_XGEN(b.x)], 1u);
            asm volatile("s_waitcnt vmcnt(0)" ::: "memory");
        } else {
            XB_SPIN(xb_ld(&bar[XB_XGEN(b.x)]) == gen, bar);
            __builtin_amdgcn_fence(__ATOMIC_ACQUIRE, "agent");
            asm volatile("s_waitcnt vmcnt(0)" ::: "memory");
        }
    }
    __syncthreads();
}

constexpr int LDS_BYTES = 147456;
constexpr int MISC_OFF = 131072 + 8192;
constexpr int NPHASE = 20;
enum { HV_INPROJ = 1, HV_MLAPROJ = 2, HV_DIFF = 4, HV_BAND = 8, HV_MLAATT = 16, HV_BRANCH = 32, HV_OUT = 64, HV_GU = 128, HV_DOWN = 256 };

__device__ const unsigned short ATT_ORDER[1536] = {4111,4175,4239,4303,4367,4431,4495,4559,5135,5199,5263,5327,5391,5455,5519,5583,6159,6223,6287,6351,6415,6479,6543,6607,7183,7247,7311,7375,7439,7503,7567,7631,4110,4174,4238,4302,4366,4430,4494,4558,5134,5198,5262,5326,5390,5454,5518,5582,6158,6222,6286,6350,6414,6478,6542,6606,7182,7246,7310,7374,7438,7502,7566,7630,4109,4173,4237,4301,4365,4429,4493,4557,5133,5197,5261,5325,5389,5453,5517,5581,6157,6221,6285,6349,6413,6477,6541,6605,7181,7245,7309,7373,7437,7501,7565,7629,4108,4172,4236,4300,4364,4428,4492,4556,5132,5196,5260,5324,5388,5452,5516,5580,6156,6220,6284,6348,6412,6476,6540,6604,7180,7244,7308,7372,7436,7500,7564,7628,223,1247,2271,3295,222,1246,2270,3294,4107,4171,4235,4299,4363,4427,4491,4555,5131,5195,5259,5323,5387,5451,5515,5579,6155,6219,6283,6347,6411,6475,6539,6603,7179,7243,7307,7371,7435,7499,7563,7627,221,1245,2269,3293,220,1244,2268,3292,4106,4170,4234,4298,4362,4426,4490,4554,5130,5194,5258,5322,5386,5450,5514,5578,6154,6218,6282,6346,6410,6474,6538,6602,7178,7242,7306,7370,7434,7498,7562,7626,219,1243,2267,3291,218,1242,2266,3290,217,1241,2265,3289,4105,4169,4233,4297,4361,4425,4489,4553,5129,5193,5257,5321,5385,5449,5513,5577,6153,6217,6281,6345,6409,6473,6537,6601,7177,7241,7305,7369,7433,7497,7561,7625,216,1240,2264,3288,215,1239,2263,3287,214,1238,2262,3286,4104,4168,4232,4296,4360,4424,4488,4552,5128,5192,5256,5320,5384,5448,5512,5576,6152,6216,6280,6344,6408,6472,6536,6600,7176,7240,7304,7368,7432,7496,7560,7624,213,1237,2261,3285,212,1236,2260,3284,4103,4167,4231,4295,4359,4423,4487,4551,5127,5191,5255,5319,5383,5447,5511,5575,6151,6215,6279,6343,6407,6471,6535,6599,7175,7239,7303,7367,7431,7495,7559,7623,211,1235,2259,3283,210,1234,2258,3282,209,1233,2257,3281,4102,4166,4230,4294,4358,4422,4486,4550,5126,5190,5254,5318,5382,5446,5510,5574,6150,6214,6278,6342,6406,6470,6534,6598,7174,7238,7302,7366,7430,7494,7558,7622,208,1232,2256,3280,207,1231,2255,3279,4101,4165,4229,4293,4357,4421,4485,4549,5125,5189,5253,5317,5381,5445,5509,5573,6149,6213,6277,6341,6405,6469,6533,6597,7173,7237,7301,7365,7429,7493,7557,7621,159,1183,2207,3231,158,1182,2206,3230,157,1181,2205,3229,156,1180,2204,3228,155,1179,2203,3227,154,1178,2202,3226,153,1177,2201,3225,152,1176,2200,3224,151,1175,2199,3223,150,1174,2198,3222,149,1173,2197,3221,148,1172,2196,3220,147,1171,2195,3219,146,1170,2194,3218,145,1169,2193,3217,144,1168,2192,3216,143,1167,2191,3215,206,1230,2254,3278,142,1166,2190,3214,205,1229,2253,3277,141,1165,2189,3213,204,1228,2252,3276,140,1164,2188,3212,4100,4164,4228,4292,4356,4420,4484,4548,5124,5188,5252,5316,5380,5444,5508,5572,6148,6212,6276,6340,6404,6468,6532,6596,7172,7236,7300,7364,7428,7492,7556,7620,203,1227,2251,3275,139,1163,2187,3211,202,1226,2250,3274,138,1162,2186,3210,4099,4163,4227,4291,4355,4419,4483,4547,5123,5187,5251,5315,5379,5443,5507,5571,6147,6211,6275,6339,6403,6467,6531,6595,7171,7235,7299,7363,7427,7491,7555,7619,201,1225,2249,3273,137,1161,2185,3209,200,1224,2248,3272,136,1160,2184,3208,199,1223,2247,3271,135,1159,2183,3207,4098,4162,4226,4290,4354,4418,4482,4546,5122,5186,5250,5314,5378,5442,5506,5570,6146,6210,6274,6338,6402,6466,6530,6594,7170,7234,7298,7362,7426,7490,7554,7618,198,1222,2246,3270,134,1158,2182,3206,197,1221,2245,3269,133,1157,2181,3205,4097,4161,4225,4289,4353,4417,4481,4545,5121,5185,5249,5313,5377,5441,5505,5569,6145,6209,6273,6337,6401,6465,6529,6593,7169,7233,7297,7361,7425,7489,7553,7617,196,1220,2244,3268,132,1156,2180,3204,8194,8258,8322,8386,8450,8514,8578,8642,9218,9282,9346,9410,9474,9538,9602,9666,10242,10306,10370,10434,10498,10562,10626,10690,11266,11330,11394,11458,11522,11586,11650,11714,8195,8259,8323,8387,8451,8515,8579,8643,9219,9283,9347,9411,9475,9539,9603,9667,10243,10307,10371,10435,10499,10563,10627,10691,11267,11331,11395,11459,11523,11587,11651,11715,8196,8260,8324,8388,8452,8516,8580,8644,9220,9284,9348,9412,9476,9540,9604,9668,10244,10308,10372,10436,10500,10564,10628,10692,11268,11332,11396,11460,11524,11588,11652,11716,8197,8261,8325,8389,8453,8517,8581,8645,9221,9285,9349,9413,9477,9541,9605,9669,10245,10309,10373,10437,10501,10565,10629,10693,11269,11333,11397,11461,11525,11589,11653,11717,8198,8262,8326,8390,8454,8518,8582,8646,9222,9286,9350,9414,9478,9542,9606,9670,10246,10310,10374,10438,10502,10566,10630,10694,11270,11334,11398,11462,11526,11590,11654,11718,8199,8263,8327,8391,8455,8519,8583,8647,9223,9287,9351,9415,9479,9543,9607,9671,10247,10311,10375,10439,10503,10567,10631,10695,11271,11335,11399,11463,11527,11591,11655,11719,8200,8264,8328,8392,8456,8520,8584,8648,9224,9288,9352,9416,9480,9544,9608,9672,10248,10312,10376,10440,10504,10568,10632,10696,11272,11336,11400,11464,11528,11592,11656,11720,8201,8265,8329,8393,8457,8521,8585,8649,9225,9289,9353,9417,9481,9545,9609,9673,10249,10313,10377,10441,10505,10569,10633,10697,11273,11337,11401,11465,11529,11593,11657,11721,8202,8266,8330,8394,8458,8522,8586,8650,9226,9290,9354,9418,9482,9546,9610,9674,10250,10314,10378,10442,10506,10570,10634,10698,11274,11338,11402,11466,11530,11594,11658,11722,8203,8267,8331,8395,8459,8523,8587,8651,9227,9291,9355,9419,9483,9547,9611,9675,10251,10315,10379,10443,10507,10571,10635,10699,11275,11339,11403,11467,11531,11595,11659,11723,8204,8268,8332,8396,8460,8524,8588,8652,9228,9292,9356,9420,9484,9548,9612,9676,10252,10316,10380,10444,10508,10572,10636,10700,11276,11340,11404,11468,11532,11596,11660,11724,8205,8269,8333,8397,8461,8525,8589,8653,9229,9293,9357,9421,9485,9549,9613,9677,10253,10317,10381,10445,10509,10573,10637,10701,11277,11341,11405,11469,11533,11597,11661,11725,8206,8270,8334,8398,8462,8526,8590,8654,9230,9294,9358,9422,9486,9550,9614,9678,10254,10318,10382,10446,10510,10574,10638,10702,11278,11342,11406,11470,11534,11598,11662,11726,8207,8271,8335,8399,8463,8527,8591,8655,9231,9295,9359,9423,9487,9551,9615,9679,10255,10319,10383,10447,10511,10575,10639,10703,11279,11343,11407,11471,11535,11599,11663,11727,8193,8257,8321,8385,8449,8513,8577,8641,9217,9281,9345,9409,9473,9537,9601,9665,10241,10305,10369,10433,10497,10561,10625,10689,11265,11329,11393,11457,11521,11585,11649,11713,8192,8256,8320,8384,8448,8512,8576,8640,9216,9280,9344,9408,9472,9536,9600,9664,10240,10304,10368,10432,10496,10560,10624,10688,11264,11328,11392,11456,11520,11584,11648,11712,95,1119,2143,3167,94,1118,2142,3166,93,1117,2141,3165,92,1116,2140,3164,91,1115,2139,3163,90,1114,2138,3162,89,1113,2137,3161,88,1112,2136,3160,87,1111,2135,3159,86,1110,2134,3158,85,1109,2133,3157,84,1108,2132,3156,83,1107,2131,3155,82,1106,2130,3154,81,1105,2129,3153,80,1104,2128,3152,79,1103,2127,3151,78,1102,2126,3150,77,1101,2125,3149,76,1100,2124,3148,75,1099,2123,3147,74,1098,2122,3146,73,1097,2121,3145,72,1096,2120,3144,71,1095,2119,3143,70,1094,2118,3142,69,1093,2117,3141,68,1092,2116,3140,195,1219,2243,3267,131,1155,2179,3203,67,1091,2115,3139,194,1218,2242,3266,130,1154,2178,3202,66,1090,2114,3138,4096,4160,4224,4288,4352,4416,4480,4544,5120,5184,5248,5312,5376,5440,5504,5568,6144,6208,6272,6336,6400,6464,6528,6592,7168,7232,7296,7360,7424,7488,7552,7616,31,1055,2079,3103,30,1054,2078,3102,29,1053,2077,3101,28,1052,2076,3100,27,1051,2075,3099,26,1050,2074,3098,25,1049,2073,3097,24,1048,2072,3096,23,1047,2071,3095,22,1046,2070,3094,21,1045,2069,3093,20,1044,2068,3092,19,1043,2067,3091,18,1042,2066,3090,17,1041,2065,3089,16,1040,2064,3088,15,1039,2063,3087,14,1038,2062,3086,13,1037,2061,3085,12,1036,2060,3084,11,1035,2059,3083,10,1034,2058,3082,9,1033,2057,3081,8,1032,2056,3080,7,1031,2055,3079,6,1030,2054,3078,5,1029,2053,3077,4,1028,2052,3076,193,1217,2241,3265,3,1027,2051,3075,129,1153,2177,3201,2,1026,2050,3074,65,1089,2113,3137,1,1025,2049,3073,192,1216,2240,3264,128,1152,2176,3200,64,1088,2112,3136,0,1024,2048,3072};
#define IN(k) (lo <= (k) && (k) < hi)
#define LP() unsigned char* ws_ = p.ws; asm volatile("" : "+s"(ws_)); gptr ws = (gptr)ws_; LAS unsigned char* ldsl = (LAS unsigned char*)lds; asm volatile("" : "+s"(ldsl)); const int vb = lsg(vb0), nvb = lsg(nvb0); (void)ws; (void)vb; (void)nvb; (void)ldsl
#define SEAM(k) do { if (IN(k) && IN((k) + 1)) { XcdBarrier b2 = bar; asm volatile("" : "+s"(b2.bar), "+s"(b2.x)); xcd_barrier(b2); } } while (0)
#define NREP(bit) (1 + ((p.pad >> (bit)) & 1))
template <int l>
__device__ __forceinline__ void layer_body(const P& p, unsigned char* lds, const XcdBarrier& bar, int vb0, int nvb0, int lo, int hi) {
        const int base = 1 + 9 * l;
        if (IN(base + 0)) { LP(); if (l > 0) { for (int rep = 0, nr = NREP(10); rep < nr; ++rep) { ph_convert_early(p, ws, ldsl, vb, nvb, l); __syncthreads(); } } for (int rep = 0, nr = (l == 0 ? NREP(11) : 1); rep < nr; ++rep) { ph_norm1<l>(p, ws, ldsl, vb, nvb); __syncthreads(); } } SEAM(base + 0);
        if (IN(base + 1)) { LP();
            if (p.heavy & HV_INPROJ) for (int rep = 0, nr = NREP(0); rep < nr; ++rep) { pg8::SchedPlain S{(const GAS char*)(ws + WS_HB), (const GAS char*)(ws + WS_WIN), D, D, 64, 27, nvb, vb}; pg8::EpiInproj E{(GAS unsigned*)(ws + WS_CTL) + CW_INQ + 64 * l, (GAS bf16_t*)(ws + WS_Y), (GAS float*)(ws + WS_SSQ), (GAS unsigned*)(ws + WS_CTL) + CW_CMAX + 2048 * l, (GAS bf16_t*)(ws + WS_G)};
                pg8::gemm_phase<pg8::EpiInproj, pg8::SchedPlain, true>(ldsl, D, S, E); }
            if ((p.heavy & HV_MLAPROJ) && nvb == 256 && vb >= 192) {
                pg8::SchedPlainDep S{(const GAS char*)(ws + WS_Y) + C_MQ * 2, (const GAS char*)(ws + WS_WQ), YP, 384, 64, 3, 64, vb - 192, (const GAS unsigned*)(ws + WS_CTL) + CW_INQ + 64 * l, 2};
                pg8::EpiMlaQ E{(GAS bf16_t*)(ws + WS_QM), (const GAS float*)(ws + WS_SSQ)};
                pg8::gemm_phase<pg8::EpiMlaQ, pg8::SchedPlainDep, true>(ldsl, 384, S, E); }
        } SEAM(base + 1);
        if (IN(base + 2)) { LP();
            constexpr float LOG2E = 1.4426950408889634f;
            ph_krope(p, ws, vb, nvb);
            if (p.heavy & HV_MLAPROJ) for (int rep = 0, nr = NREP(1); rep < nr; ++rep) {
                if (nvb != 256) { pg8::SchedPlain S{(const GAS char*)(ws + WS_Y) + C_MQ * 2, (const GAS char*)(ws + WS_WQ), YP, 384, 64, 3, nvb, vb}; pg8::EpiMlaQ E{(GAS bf16_t*)(ws + WS_QM), (const GAS float*)(ws + WS_SSQ)};
                  pg8::gemm_phase<pg8::EpiMlaQ, pg8::SchedPlain, true>(ldsl, 384, S, E); }
                { pg8::SchedPlain S{(const GAS char*)(ws + WS_Y) + C_CKV * 2, (const GAS char*)(ws + WS_WKV), YP, 256, 64, 4, nvb, vb}; pg8::EpiMlaKV E{(GAS bf16_t*)(ws + WS_KM), (GAS bf16_t*)(ws + WS_VM), (const GAS float*)(ws + WS_SSQ)};
                  pg8::gemm_phase<pg8::EpiMlaKV, pg8::SchedPlain, true>(ldsl, 256, S, E); }
            }
            { const int tid_ = ltid();
              asm volatile("s_waitcnt vmcnt(0)" ::: "memory"); __builtin_amdgcn_s_barrier(); asm volatile("" ::: "memory");
              if (tid_ == 0) { __builtin_amdgcn_fence(__ATOMIC_RELEASE, "agent"); asm volatile("s_waitcnt vmcnt(0)" ::: "memory"); }
              if (tid_ == 0) __hip_atomic_fetch_add((GAS unsigned*)(ws + WS_CTL) + CW_MLAP + 64 * l, 1u, __ATOMIC_RELAXED, __HIP_MEMORY_SCOPE_AGENT); }
            {
                const float lam = ((const GAS float*)(ws + WS_CTL))[CW_LAM + l];
                GAS unsigned* qctr = (GAS unsigned*)(ws + WS_CTL) + CW_Q + 64 * l;
                GAS unsigned* mlap = (GAS unsigned*)(ws + WS_CTL) + CW_MLAP + 64 * l;
                LAS int* qslot = (LAS int*)(ldsl + 143360 + 64);
                const int tid_ = ltid();
                bool mla_ready = false;
                int u = vb;
                while (u < 1536 + CV_UNITS) {
                    unsigned nxt = 0u;
                    if (tid_ == 0) nxt = __hip_atomic_fetch_add(qctr, 1u, __ATOMIC_RELAXED, __HIP_MEMORY_SCOPE_AGENT);
                    const bool cvu = (u & 7) == 7 && (u >> 3) < CV_UNITS;
                    const int ncb = ((u + 1) >> 3) < CV_UNITS ? ((u + 1) >> 3) : CV_UNITS, ai_ = cvu ? 0 : u - ncb;
                    const int code = cvu ? (3 << 12) : __builtin_amdgcn_readfirstlane((int)ATT_ORDER[ai_]), ty = code >> 12, b = (code >> 10) & 3, h = (code >> 6) & 15, qb = code & 63;
                    if (ty == 3) { const int i0 = CV_EARLY + (u >> 3) * 64; ph_convert(p, ws, ldsl, l, i0 + (ltid() >> 6), 8, i0 + 64); }
                    else if (ty == 0) {
                        GAS bf16_t* Yb = (GAS bf16_t*)(ws + WS_Y) + (size_t)b * S * YP;
                        att::Args a; a.Q = Yb + (size_t)(qb * 128) * YP + C_DQ + h * 128; a.qp = YP; a.qgs = 64; a.K = Yb + C_DK + h * 128; a.kp = YP; a.kgs = 64; a.V = Yb + C_DV + h * 128; a.vp = YP;
                        a.O = Yb + (size_t)(qb * 128) * YP + C_DQ + h * 128; a.op = YP; a.q0 = qb * 128; a.jlo = 0; a.jhi = 2 * qb + 1; a.C = 0.125f * LOG2E; a.sl2 = exp2f(-2.f * (float)(h + 1)) * LOG2E;
                        a.relb = nullptr; a.rope = nullptr; a.lam = lam; a.osc = (l == 0) ? 0.8f : 0.64449093f; a.subln = INP(I_SUBLN) + l * 128;
                        a.cmax = (const GAS unsigned*)(ws + WS_CTL) + CW_CMAX + 2048 * l + b * 512 + h * 128;
                        att::Diff::unit(ldsl, a);
                    } else if (ty == 1) {
                        if (!mla_ready) {
                            if (tid_ == 0) { unsigned sp = 0; while (__hip_atomic_load(mlap, __ATOMIC_RELAXED, __HIP_MEMORY_SCOPE_AGENT) < (unsigned)nvb) { __builtin_amdgcn_s_sleep(2); if (++sp > (1u << 22)) break; } }
                            asm volatile("s_waitcnt vmcnt(0) lgkmcnt(0)" ::: "memory"); __builtin_amdgcn_s_barrier(); asm volatile("" ::: "memory");
                            __builtin_amdgcn_fence(__ATOMIC_ACQUIRE, "agent"); asm volatile("s_waitcnt vmcnt(0)" ::: "memory");
                            mla_ready = true;
                        }
                        att::Args a; a.Q = (const GAS bf16_t*)(ws + WS_QM) + (size_t)(b * S + qb * 256) * 768 + h * 96; a.qp = 768; a.qgs = 0;
                        a.K = (const GAS bf16_t*)(ws + WS_KM) + (size_t)b * S * 768 + h * 96; a.kp = 768; a.kgs = 0; a.V = (const GAS bf16_t*)(ws + WS_VM) + (size_t)b * S * 512 + h * 64; a.vp = 512;
                        a.O = (GAS bf16_t*)(ws + WS_Y) + (size_t)(b * S + qb * 256) * YP + C_MQ + h * 64; a.op = YP; a.q0 = qb * 256; a.jlo = 0; a.jhi = 4 * qb + 3; a.C = 0.10206207261596577f * LOG2E; a.sl2 = 0.f;
                        a.relb = nullptr; a.rope = (const GAS float*)(ws + WS_ROPE); a.lam = 0.f; a.osc = 0.f; a.subln = nullptr; a.cmax = nullptr;
                        att::Mla::unit(ldsl, a);
                    } else { const int c0 = 4 * qb;
                        GAS bf16_t* Yb = (GAS bf16_t*)(ws + WS_Y) + (size_t)b * S * YP;
                        att::Args a; a.Q = Yb + (size_t)(qb * 256) * YP + C_CQ + h * 64; a.qp = YP; a.qgs = 0; a.K = Yb + C_CK + h * 64; a.kp = YP; a.kgs = 0; a.V = Yb + C_CV + h * 64; a.vp = YP;
                        a.O = Yb + (size_t)(qb * 256) * YP + C_CQ + h * 64; a.op = YP; a.q0 = qb * 256; a.jlo = c0 - 8 < 0 ? 0 : c0 - 8; a.jhi = c0 + 3; a.C = 0.125f * LOG2E; a.sl2 = 0.f;
                        a.relb = INP(I_REL) + (size_t)(l * 8 + h) * 513; a.rope = nullptr; a.lam = 0.f; a.osc = 0.f; a.subln = nullptr; a.cmax = nullptr;
                        att::Band::unit(ldsl, a);
                    }
                    if (ltid() == 0) qslot[0] = nvb + (int)nxt;
                    asm volatile("s_waitcnt vmcnt(0) lgkmcnt(0)" ::: "memory"); __builtin_amdgcn_s_barrier(); asm volatile("" ::: "memory");
                    u = __builtin_amdgcn_readfirstlane(qslot[0]);
                    asm volatile("s_waitcnt lgkmcnt(0)" ::: "memory"); __builtin_amdgcn_s_barrier(); asm volatile("" ::: "memory");
                }
            }
        }
        if (IN(base + 3)) { } SEAM(base + 3);
        if (IN(base + 4)) { LP();
            if (p.heavy & HV_BRANCH) for (int rep = 0, nr = NREP(5); rep < nr; ++rep) { pg8::SchedBranch S{(const GAS char*)(ws + WS_Y), (const GAS char*)(ws + WS_WBR), nvb, vb}; pg8::EpiBranch E{(const GAS bf16_t*)(ws + WS_G), (GAS bf16_t*)(ws + WS_HB), (GAS unsigned*)(ws + WS_CTL) + CW_BRO + 64 * l};
                pg8::gemm_phase<pg8::EpiBranch, pg8::SchedBranch, true>(ldsl, 512, S, E); }
        }
        if (IN(base + 4)) { LP();
            if (p.heavy & HV_OUT) { pg8::SchedPlainDep S{(const GAS char*)(ws + WS_HB), (const GAS char*)(ws + WS_WOUT), D, D, 64, 4, nvb, vb, (const GAS unsigned*)(ws + WS_CTL) + CW_BRO + 64 * l, 4};
                pg8::EpiOut<(l > 0)> E{(GAS unsigned*)(ws + WS_CTL) + CW_OUT + 64 * l, l == 0 ? (const GAS void*)INP(I_X) : (const GAS void*)p.out, l == 0 ? (GAS bf16_t*)p.out : (GAS bf16_t*)(ws + WS_KM), (const GAS float*)(ws + WS_MOD) + (size_t)(l * 4) * 6144 + 2048};
                pg8::gemm_phase<pg8::EpiOut<(l > 0)>, pg8::SchedPlainDep, true>(ldsl, D, S, E); }
        }
        if (IN(base + 4)) { LP(); ph_router(p, ws, ldsl, vb, nvb, l, (const GAS unsigned*)(ws + WS_CTL) + CW_OUT + 64 * l); }
        if (IN(base + 5)) { } if (IN(base + 6)) { } SEAM(base + 6);
        if (IN(base + 7)) { LP();
            if (p.heavy & HV_GU) for (int rep = 0, nr = NREP(7); rep < nr; ++rep) { LAS int* tab = (LAS int*)(ldsl + 131072); moe_table(ws, tab, l);
                pg8::SchedMoe<true> S{(const GAS char*)(ws + WS_HB), (const GAS char*)(ws + WS_WGU), (const GAS int*)(ws + WS_LIST), tab, D, D, 4, nvb, vb, nullptr}; pg8::EpiGU E{(GAS bf16_t*)(ws + WS_HC), (GAS unsigned*)(ws + WS_CTL) + CW_GUD + 256 * l};
                pg8::gemm_phase<pg8::EpiGU, pg8::SchedMoe<true>, true>(ldsl, D, S, E); }
            if (p.heavy & HV_DOWN) for (int rep = 0, nr = NREP(8); rep < nr; ++rep) { LAS int* tab = (LAS int*)(ldsl + 131072); moe_table(ws, tab, l);
                pg8::SchedMoe<false> S{(const GAS char*)(ws + WS_HC), (const GAS char*)(ws + WS_WD), (const GAS int*)(ws + WS_LIST), tab, FF, FF, 4, nvb, vb, (GAS unsigned*)(ws + WS_CTL) + CW_GUD + 256 * l}; pg8::EpiDown E{(GAS bf16_t*)(ws + WS_OS), (const GAS int*)(ws + WS_LIST)};
                pg8::gemm_phase<pg8::EpiDown, pg8::SchedMoe<false>, true>(ldsl, FF, S, E); }
        }
        if (IN(base + 8)) { } SEAM(base + 8);
}
__global__ void __launch_bounds__(512, 2) mega(P p) {
    extern __shared__ __attribute__((aligned(16))) unsigned char lds[];
    const int tid = threadIdx.x;
    volatile LAS unsigned* misc = (volatile LAS unsigned*)((LAS unsigned char*)lds + MISC_OFF);
    if (tid < 4) misc[tid] = 0u;
    __syncthreads();
    XcdBarrier bar = xcd_barrier_post((unsigned*)(p.ws + WS_CTL) + CW_BAR, misc);
    const int vb0 = blockIdx.x, nvb0 = gridDim.x;
    const int lo = p.ph_lo, hi = p.ph_hi;
    if (IN(0)) { LP(); for (int rep = 0, nr = NREP(12); rep < nr; ++rep) { ph0(p, ws, ldsl, vb, nvb); __syncthreads(); } for (int rep = 0, nr = NREP(10); rep < nr; ++rep) { ph_convert_early(p, ws, ldsl, vb, nvb, 0); __syncthreads(); } } SEAM(0);
    layer_body<0>(p, lds, bar, vb0, nvb0, lo, hi);
    layer_body<1>(p, lds, bar, vb0, nvb0, lo, hi);
    if (IN(19)) { LP(); ph_norm1<2>(p, ws, ldsl, vb, nvb); }
#undef IN
#undef SEAM
}

struct RowPlain { int M; __device__ int rows() const { return M; } __device__ int src(int m) const { return m; } };
struct RowList { const unsigned* cnt; const int* list; __device__ int rows() const { return (int)*cnt; } __device__ int src(int m) const { return list[m] >> 1; } };
struct RowCompact { const unsigned* cnts; int e; __device__ int rows() const { return (int)cnts[e]; }
    __device__ int base() const { int b = 0; for (int i = 0; i < e; ++i) b += ((int)cnts[i] + 255) / 256 * 256; return b; }
    __device__ int src(int m) const { return base() + m; } };

template <class RowMap, class Epi>
__global__ __launch_bounds__(256) void naive_gemm(const bf16_t* A, int lda, RowMap rm, const float* W, int ldw, int K, int N, const float* kscale, Epi epi) {
    const int M = rm.rows();
    const int m0 = blockIdx.y * 64, n0 = blockIdx.x * 64;
    if (m0 >= M) return;
    __shared__ float As[16][65];
    __shared__ float Ws[16][64];
    const int tid = threadIdx.x, tx = tid & 15, ty = tid >> 4;
    float acc[4][4];
#pragma unroll
    for (int i = 0; i < 4; ++i)
#pragma unroll
        for (int j = 0; j < 4; ++j) acc[i][j] = 0.f;
    const int ar = tid >> 2, akq = (tid & 3) * 4;
    const int grow = m0 + ar;
    const int srow = grow < M ? rm.src(grow) : rm.src(0);
    const int wk = tid >> 4, wn = (tid & 15) * 4;
    for (int k0 = 0; k0 < K; k0 += 16) {
        const u32x2 a = *(const u32x2*)(A + (size_t)srow * lda + k0 + akq);
        float a0 = bflo(a.x), a1 = bfhi(a.x), a2 = bflo(a.y), a3 = bfhi(a.y);
        if (kscale) { a0 *= kscale[k0 + akq]; a1 *= kscale[k0 + akq + 1]; a2 *= kscale[k0 + akq + 2]; a3 *= kscale[k0 + akq + 3]; }
        As[akq][ar] = a0; As[akq + 1][ar] = a1; As[akq + 2][ar] = a2; As[akq + 3][ar] = a3;
        f32x4 w = {0.f, 0.f, 0.f, 0.f};
        if (n0 + wn < N) w = *(const f32x4*)(W + (size_t)(k0 + wk) * ldw + n0 + wn);
        *(f32x4*)&Ws[wk][wn] = w;
        __syncthreads();
#pragma unroll
        for (int kk = 0; kk < 16; ++kk) {
            float av[4], wv[4];
#pragma unroll
            for (int i = 0; i < 4; ++i) { av[i] = As[kk][ty * 4 + i]; wv[i] = Ws[kk][tx * 4 + i]; }
#pragma unroll
            for (int i = 0; i < 4; ++i)
#pragma unroll
                for (int j = 0; j < 4; ++j) acc[i][j] += av[i] * wv[j];
        }
        __syncthreads();
    }
#pragma unroll
    for (int i = 0; i < 4; ++i)
#pragma unroll
        for (int j = 0; j < 4; ++j) { const int row = m0 + ty * 4 + i, col = n0 + tx * 4 + j; if (row < M && col < N) epi(row, col, acc[i][j]); }
}

struct NEpiInproj { bf16_t* Y; __device__ void operator()(int row, int col, float v) const {
    const int yc = col < 3744 ? col : col + 96; if (col >= 3744) v = sigmoidf_(v); Y[(size_t)row * YP + yc] = (bf16_t)f2bf(v); } };
struct NEpiMlaQ { bf16_t* Qm; const float* ssq; __device__ void operator()(int row, int col, float v) const {
    float s = 0.f; for (int i = 0; i < 12; ++i) s += ssq[row * 24 + i];
    Qm[(size_t)row * 768 + col] = (bf16_t)f2bf(v * rsqrtf(s * (1.f / 384.f) + EPS)); } };
struct NEpiMlaKV { bf16_t* Km; bf16_t* Vm; const float* ssq; __device__ void operator()(int row, int col, float v) const {
    float s = 0.f; for (int i = 12; i < 20; ++i) s += ssq[row * 24 + i];
    v *= rsqrtf(s * (1.f / 256.f) + EPS); const int h = col >> 7, d = col & 127;
    if (d < 64) Km[(size_t)row * 768 + h * 96 + d] = (bf16_t)f2bf(v); else Vm[(size_t)row * 512 + h * 64 + d - 64] = (bf16_t)f2bf(v); } };
struct NEpiBranch { const bf16_t* Y; bf16_t* MG; int br; __device__ void operator()(int row, int col, float v) const {
    const float g = bf2f(Y[(size_t)row * YP + C_G + br * 1024 + col]); float m = g * v; if (br) m += bf2f(MG[(size_t)row * D + col]); MG[(size_t)row * D + col] = (bf16_t)f2bf(m); } };
struct NEpiOut { const float* xcur; float* xo; const float* mod; int layer; __device__ void operator()(int row, int col, float v) const {
    const int b = row >> 12; xo[(size_t)row * D + col] = xcur[(size_t)row * D + col] + mod[(size_t)(layer * 4 + b) * 6144 + 2048 + col] * v; } };
struct NEpiGate { bf16_t* HC; RowCompact rc; __device__ void operator()(int row, int col, float v) const {
    HC[(size_t)(rc.base() + row) * FF + col] = (bf16_t)f2bf(v / (1.f + __expf(-v))); } };
struct NEpiUp { bf16_t* HC; RowCompact rc; __device__ void operator()(int row, int col, float v) const {
    const size_t o = (size_t)(rc.base() + row) * FF + col; HC[o] = (bf16_t)f2bf(bf2f(HC[o]) * v); } };
struct NEpiDown { bf16_t* OS; const int* list; __device__ void operator()(int row, int col, float v) const {
    OS[(size_t)list[row] * D + col] = (bf16_t)f2bf(v); } };

__global__ __launch_bounds__(256) void naive_ssq(const bf16_t* Y, float* ssq) {
    const int row = blockIdx.x * 4 + (threadIdx.x >> 6), lane = threadIdx.x & 63;
    float sq = 0.f, sk = 0.f;
    for (int i = lane; i < 384; i += 64) { const float v = bf2f(Y[(size_t)row * YP + C_MQ + i]); sq += v * v; }
    for (int i = lane; i < 256; i += 64) { const float v = bf2f(Y[(size_t)row * YP + C_CKV + i]); sk += v * v; }
    sq = wave_sum(sq); sk = wave_sum(sk);
    if (lane < 24) ssq[row * 24 + lane] = lane == 0 ? sq : lane == 12 ? sk : 0.f;
}

template <int DQK, int DV, int MODE>
__device__ __forceinline__ void attn_row(const float* q, const bf16_t* Kb, int kp, const bf16_t* Vb, int vp, int klo, int khi, float scale,
                                         int qpos, float slope, const float* relt, float (&res)[DV / 64]) {
    const int lane = threadIdx.x & 63;
    float m = -1e30f, l = 0.f, o[DV];
#pragma unroll
    for (int d = 0; d < DV; ++d) o[d] = 0.f;
    for (int k = klo + lane; k < khi; k += 64) {
        const bf16_t* kr = Kb + (size_t)k * kp;
        float s = 0.f;
#pragma unroll
        for (int c = 0; c < DQK / 8; ++c) {
            const u32x4 w = *(const u32x4*)(kr + c * 8);
            s += q[c * 8 + 0] * bflo(w.x) + q[c * 8 + 1] * bfhi(w.x) + q[c * 8 + 2] * bflo(w.y) + q[c * 8 + 3] * bfhi(w.y)
               + q[c * 8 + 4] * bflo(w.z) + q[c * 8 + 5] * bfhi(w.z) + q[c * 8 + 6] * bflo(w.w) + q[c * 8 + 7] * bfhi(w.w);
        }
        s *= scale;
        if (MODE == 0) s -= slope * fabsf((float)(qpos - k));
        if (MODE == 1) { int rel = qpos - k; rel = rel < -256 ? -256 : rel > 256 ? 256 : rel; s += relt[rel + 256]; }
        const float mn = fmaxf(m, s), al = __expf(m - mn), pe = __expf(s - mn);
        m = mn; l = l * al + pe;
        const bf16_t* vr = Vb + (size_t)k * vp;
#pragma unroll
        for (int c = 0; c < DV / 8; ++c) {
            const u32x4 w = *(const u32x4*)(vr + c * 8);
            o[c * 8 + 0] = o[c * 8 + 0] * al + pe * bflo(w.x); o[c * 8 + 1] = o[c * 8 + 1] * al + pe * bfhi(w.x);
            o[c * 8 + 2] = o[c * 8 + 2] * al + pe * bflo(w.y); o[c * 8 + 3] = o[c * 8 + 3] * al + pe * bfhi(w.y);
            o[c * 8 + 4] = o[c * 8 + 4] * al + pe * bflo(w.z); o[c * 8 + 5] = o[c * 8 + 5] * al + pe * bfhi(w.z);
            o[c * 8 + 6] = o[c * 8 + 6] * al + pe * bflo(w.w); o[c * 8 + 7] = o[c * 8 + 7] * al + pe * bfhi(w.w);
        }
    }
    const float M = wave_max(m), f = __expf(m - M);
    const float L = wave_sum(l * f), inv = 1.f / L;
#pragma unroll
    for (int i = 0; i < DV / 64; ++i) res[i] = 0.f;
#pragma unroll
    for (int d = 0; d < DV; ++d) { const float v = wave_sum(o[d] * f) * inv; if ((d & 63) == lane) res[d >> 6] = v; }
}

__global__ __launch_bounds__(64) void naive_attn_diff(bf16_t* Y, const float* lamp, const float* subln, float lam_init) {
    const int t = blockIdx.x >> 2, h = blockIdx.x & 3, b = t >> 12, pos = t & (S - 1), lane = threadIdx.x;
    const float slope = exp2f(-2.f * (float)(h + 1));
    const int khi = ((pos >> 6) + 1) * 64;
    const bf16_t* Yb = Y + (size_t)b * S * YP;
    float r0[2], r1[2], q[64];
    for (int mp = 0; mp < 2; ++mp) {
#pragma unroll
        for (int d = 0; d < 64; ++d) q[d] = bf2f(Y[(size_t)t * YP + C_DQ + h * 128 + mp * 64 + d]);
        if (mp == 0) attn_row<64, 128, 0>(q, Yb + C_DK + h * 128, YP, Yb + C_DV + h * 128, YP, 0, khi, 0.125f, pos, slope, nullptr, r0);
        else attn_row<64, 128, 0>(q, Yb + C_DK + h * 128 + 64, YP, Yb + C_DV + h * 128, YP, 0, khi, 0.125f, pos, slope, nullptr, r1);
    }
    const float lam = *lamp;
    const float y0 = r0[0] - lam * r1[0], y1 = r0[1] - lam * r1[1];
    const float rstd = rsqrtf(wave_sum(y0 * y0 + y1 * y1) * (1.f / 128.f) + EPS);
    Y[(size_t)t * YP + C_DQ + h * 128 + lane] = (bf16_t)f2bf(y0 * rstd * subln[lane] * (1.f - lam_init));
    Y[(size_t)t * YP + C_DQ + h * 128 + 64 + lane] = (bf16_t)f2bf(y1 * rstd * subln[64 + lane] * (1.f - lam_init));
}
__global__ __launch_bounds__(64) void naive_attn_band(bf16_t* Y, const float* rel) {
    const int t = blockIdx.x >> 3, h = blockIdx.x & 7, b = t >> 12, pos = t & (S - 1), lane = threadIdx.x;
    const int ch = pos >> 6, klo = (ch - 8 < 0 ? 0 : ch - 8) * 64, khi = (ch + 1) * 64;
    const bf16_t* Yb = Y + (size_t)b * S * YP;
    float q[64], r[1];
#pragma unroll
    for (int d = 0; d < 64; ++d) q[d] = bf2f(Y[(size_t)t * YP + C_CQ + h * 64 + d]);
    attn_row<64, 64, 1>(q, Yb + C_CK + h * 64, YP, Yb + C_CV + h * 64, YP, klo, khi, 0.125f, pos, 0.f, rel + h * 513, r);
    Y[(size_t)t * YP + C_CQ + h * 64 + lane] = (bf16_t)f2bf(r[0]);
}
__global__ __launch_bounds__(64) void naive_attn_mla(const bf16_t* Qm, const bf16_t* Km, const bf16_t* Vm, const float* rope, bf16_t* Y) {
    const int t = blockIdx.x >> 3, h = blockIdx.x & 7, b = t >> 12, pos = t & (S - 1), lane = threadIdx.x;
    const int khi = ((pos >> 6) + 1) * 64;
    float q[96], r[1];
#pragma unroll
    for (int d = 0; d < 96; ++d) q[d] = bf2f(Qm[(size_t)t * 768 + h * 96 + d]);
#pragma unroll
    for (int f = 0; f < 16; ++f) { const float c = rope[(pos * 16 + f) * 2], s = rope[(pos * 16 + f) * 2 + 1]; const float x1 = q[64 + f], x2 = q[80 + f];
        q[64 + f] = bf2f(f2bf(x1 * c - x2 * s)); q[80 + f] = bf2f(f2bf(x1 * s + x2 * c)); }
    attn_row<96, 64, 2>(q, Km + (size_t)b * S * 768 + h * 96, 768, Vm + (size_t)b * S * 512 + h * 64, 512, 0, khi, 0.10206207261596577f, pos, 0.f, nullptr, r);
    Y[(size_t)t * YP + C_MQ + h * 64 + lane] = (bf16_t)f2bf(r[0]);
}

#ifndef REP_MASK
#define REP_MASK 0
#endif
#ifndef ONE_LAUNCH
#define ONE_LAUNCH 1
#endif
#ifndef HEAVY_MASK
#define HEAVY_MASK (HV_INPROJ | HV_MLAPROJ | HV_BRANCH | HV_OUT | HV_GU | HV_DOWN | HV_DIFF | HV_BAND | HV_MLAATT)
#endif
static void launch_mega(const P& base, int lo, int hi, int heavy, int grid, hipStream_t stream) {
    P a = base; a.ph_lo = lo; a.ph_hi = hi; a.heavy = heavy; a.pad = REP_MASK;
    hipLaunchKernelGGL(mega, dim3(grid), dim3(512), LDS_BYTES, stream, a);
}

extern "C" void kernel_launch(void* const* d_in, const int* in_sizes, int n_in, void* d_out, int out_size, void* d_ws, size_t ws_size, hipStream_t stream) {
    static int grid = 0;
    if (grid == 0) {
        if (n_in != 27 || out_size != T * D || ws_size < WS_END) { fprintf(stderr, "kernel_launch: bad shapes n_in %d out %d ws %zu (need %zu)\n", n_in, out_size, ws_size, (size_t)WS_END); grid = -1; return; }
        int dev = 0, cus = 0;
        hipGetDevice(&dev); hipDeviceGetAttribute(&cus, hipDeviceAttributeMultiprocessorCount, dev);
        if (hipFuncSetAttribute((const void*)mega, hipFuncAttributeMaxDynamicSharedMemorySize, LDS_BYTES) != hipSuccess) { fprintf(stderr, "hipFuncSetAttribute failed\n"); grid = -1; return; }
        grid = cus > 0 ? cus : 256;
    }
    if (grid < 0) return;
    hipMemsetAsync((char*)d_ws + WS_CTL, 0, CTL_BYTES, stream);
    P p{};
    for (int i = 0; i < 27; ++i) p.in[i] = (const float*)d_in[i];
    p.out = (float*)d_out; p.ws = (unsigned char*)d_ws;
    unsigned char* ws = (unsigned char*)d_ws;
    bf16_t* Y = (bf16_t*)(ws + WS_Y); bf16_t* HB = (bf16_t*)(ws + WS_HB); bf16_t* KM = (bf16_t*)(ws + WS_KM); bf16_t* VM = (bf16_t*)(ws + WS_VM);
    bf16_t* HC = (bf16_t*)(ws + WS_HC); bf16_t* OS = (bf16_t*)(ws + WS_OS);
    float* SSQ = (float*)(ws + WS_SSQ); const float* MOD = (const float*)(ws + WS_MOD); const float* ROPE = (const float*)(ws + WS_ROPE);
    const int* LIST = (const int*)(ws + WS_LIST);
    const int HM = HEAVY_MASK;
    constexpr int ALLHV = HV_INPROJ | HV_MLAPROJ | HV_BRANCH | HV_OUT | HV_GU | HV_DOWN | HV_DIFF | HV_BAND | HV_MLAATT;
    if (HM == ALLHV && ONE_LAUNCH) { launch_mega(p, 0, NPHASE, HM, grid, stream); return; }
    launch_mega(p, 0, 1, HM, grid, stream);
    for (int l = 0; l < NL; ++l) {
        const int base = 1 + 9 * l;
        launch_mega(p, base, base + 1, HM, grid, stream);
        if (HM & HV_INPROJ) launch_mega(p, base + 1, base + 2, HM, grid, stream);
        else {
            hipLaunchKernelGGL((naive_gemm<RowPlain, NEpiInproj>), dim3(107, 256), dim3(256), 0, stream, HB, D, RowPlain{T}, p.in[I_WIN] + (size_t)l * D * INW, INW, D, INW, (const float*)nullptr, NEpiInproj{Y});
            hipLaunchKernelGGL(naive_ssq, dim3(T / 4), dim3(256), 0, stream, Y, SSQ);
        }
        launch_mega(p, base + 2, base + 3, HM, grid, stream);
        if (!(HM & HV_MLAPROJ)) {
            hipLaunchKernelGGL((naive_gemm<RowPlain, NEpiMlaQ>), dim3(12, 256), dim3(256), 0, stream, Y + C_MQ, YP, RowPlain{T}, p.in[I_WQB] + (size_t)l * 384 * 768, 768, 384, 768, p.in[I_QNG] + l * 384, NEpiMlaQ{HB, SSQ});
            hipLaunchKernelGGL((naive_gemm<RowPlain, NEpiMlaKV>), dim3(16, 256), dim3(256), 0, stream, Y + C_CKV, YP, RowPlain{T}, p.in[I_WKVB] + (size_t)l * 256 * 1024, 1024, 256, 1024, p.in[I_KVNG] + l * 256, NEpiMlaKV{KM, VM, SSQ});
        }
        const float lam_init = 0.8f - 0.6f * expf(-0.3f * (float)l);
        if (!(HM & HV_DIFF)) hipLaunchKernelGGL(naive_attn_diff, dim3(T * 4), dim3(64), 0, stream, Y, (const float*)(ws + WS_CTL) + CW_LAM + l, p.in[I_SUBLN] + l * 128, lam_init);
        if (!(HM & HV_BAND)) hipLaunchKernelGGL(naive_attn_band, dim3(T * 8), dim3(64), 0, stream, Y, p.in[I_REL] + (size_t)l * 8 * 513);
        if (HM & HV_MLAATT) launch_mega(p, base + 3, base + 4, HM, grid, stream);
        else hipLaunchKernelGGL(naive_attn_mla, dim3(T * 8), dim3(64), 0, stream, HB, KM, VM, ROPE, Y);
        if (HM & HV_BRANCH) launch_mega(p, base + 4, base + 5, HM, grid, stream);
        else {
            const float* wbr[3] = {p.in[I_WBD], p.in[I_WBC], p.in[I_WBM]}; const int acol[3] = {C_DQ, C_CQ, C_MQ};
            for (int br = 0; br < 3; ++br)
                hipLaunchKernelGGL((naive_gemm<RowPlain, NEpiBranch>), dim3(16, 256), dim3(256), 0, stream, Y + acol[br], YP, RowPlain{T}, wbr[br] + (size_t)l * 512 * D, D, 512, D, (const float*)nullptr, NEpiBranch{Y, HB, br});
        }
        if (HM & HV_OUT) launch_mega(p, base + 5, base + 6, HM, grid, stream);
        else hipLaunchKernelGGL((naive_gemm<RowPlain, NEpiOut>), dim3(16, 256), dim3(256), 0, stream, HB, D, RowPlain{T}, p.in[I_WOUT] + (size_t)l * D * D, D, D, D, (const float*)nullptr,
                           NEpiOut{l == 0 ? p.in[I_X] : (const float*)p.out, p.out, MOD, l});
        launch_mega(p, base + 6, base + 7, HM, grid, stream);
        const unsigned* cnts = (const unsigned*)(ws + WS_CTL) + CW_CNT + 64 * l;
        if (HM & HV_GU) launch_mega(p, base + 7, base + 8, HM, grid, stream);
        else for (int e = 0; e < NE; ++e) {
            const size_t wo = ((size_t)l * NE + e) * D * FF;
            hipLaunchKernelGGL((naive_gemm<RowList, NEpiGate>), dim3(8, 256), dim3(256), 0, stream, HB, D, RowList{cnts + e, LIST + e * 16384}, p.in[I_WEG] + wo, FF, D, FF, (const float*)nullptr, NEpiGate{HC, RowCompact{cnts, e}});
            hipLaunchKernelGGL((naive_gemm<RowList, NEpiUp>), dim3(8, 256), dim3(256), 0, stream, HB, D, RowList{cnts + e, LIST + e * 16384}, p.in[I_WEU] + wo, FF, D, FF, (const float*)nullptr, NEpiUp{HC, RowCompact{cnts, e}});
        }
        if (HM & HV_DOWN) launch_mega(p, base + 8, base + 9, HM, grid, stream);
        else for (int e = 0; e < NE; ++e) {
            const size_t wo = ((size_t)l * NE + e) * D * FF;
            hipLaunchKernelGGL((naive_gemm<RowCompact, NEpiDown>), dim3(16, 256), dim3(256), 0, stream, HC, FF, RowCompact{cnts, e}, p.in[I_WED] + wo, D, FF, D, (const float*)nullptr, NEpiDown{OS, LIST + e * 16384});
        }
    }
    launch_mega(p, 19, 20, 0, grid, stream);
}
```

```cpp
#include <hip/hip_runtime.h>
#include <cstdio>
#include <cstdint>

constexpr int T = 16384, D = 1024, NB = 4, S = 4096, NL = 2;
constexpr int YP = 3840;
constexpr int C_DQ = 0, C_DK = 512, C_DV = 1024, C_CQ = 1536, C_CK = 2048, C_CV = 2560, C_MQ = 3072, C_CKV = 3456, C_KR = 3712, C_G = 3840;
constexpr int INW = 6816;
constexpr float EPS = 1e-6f;
constexpr int NE = 16, FF = 512;
constexpr int HC_ROWS = 36864;

constexpr size_t MiB = 1u << 20;
constexpr size_t WS_CTL = 0, CTL_BYTES = 128 * 1024;
constexpr size_t WS_MODP = 1 * MiB;
constexpr size_t WS_MOD = 4 * MiB;
constexpr size_t WS_SSQ = 4 * MiB + 512 * 1024;
constexpr size_t WS_TOKW = 6 * MiB;
constexpr size_t WS_ROPE = 6 * MiB + 512 * 1024;
constexpr size_t WS_LIST = 7 * MiB;
constexpr size_t WS_WIN = 8 * MiB;
constexpr size_t WS_WQ = 22 * MiB;
constexpr size_t WS_WKV = 23 * MiB;
constexpr size_t WS_WBR = 24 * MiB;
constexpr size_t WS_WOUT = 27 * MiB;
constexpr size_t WS_WGU = 30 * MiB;
constexpr size_t WS_WD = 62 * MiB;
constexpr size_t WS_HB = 78 * MiB;
constexpr size_t WS_KM = 110 * MiB;
constexpr size_t WS_VM = 134 * MiB;
constexpr size_t WS_Y = 150 * MiB;
constexpr size_t WS_G = 270 * MiB;
constexpr size_t WS_QM = 318 * MiB;
constexpr size_t WS_HC = 150 * MiB;
constexpr size_t WS_OS = 186 * MiB;
constexpr size_t WS_END = 366 * MiB;
constexpr int CW_CNT = 64;
constexpr int CW_LAM = 256;
constexpr int CW_CMAX = 16384;
constexpr int CW_MLAP = 1024;
constexpr int CW_Q = 512;
constexpr int CW_GUD = 2048;
constexpr int CW_BRO = 2560;
constexpr int CW_OUT = 2816;
constexpr int CW_INQ = 3072;
constexpr int CW_BAR = 4096;

typedef unsigned short bf16_t;
typedef float f32x4 __attribute__((ext_vector_type(4)));
typedef float f32x2 __attribute__((ext_vector_type(2)));
typedef unsigned u32x4 __attribute__((ext_vector_type(4)));
typedef unsigned u32x2 __attribute__((ext_vector_type(2)));
#define LAS __attribute__((address_space(3)))
#define GAS __attribute__((address_space(1)))
typedef GAS unsigned char* gptr;
#define INP(i) ((const GAS float*)p.in[i])

__device__ __forceinline__ unsigned f2bf(float f) { unsigned u = __builtin_bit_cast(unsigned, f); return (u + 0x7fffu + ((u >> 16) & 1u)) >> 16; }
__device__ __forceinline__ float bf2f(unsigned h) { return __builtin_bit_cast(float, (h & 0xffffu) << 16); }
__device__ __forceinline__ float bflo(unsigned w) { return __builtin_bit_cast(float, w << 16); }
__device__ __forceinline__ float bfhi(unsigned w) { return __builtin_bit_cast(float, w & 0xffff0000u); }
__device__ __forceinline__ unsigned pk2(float lo, float hi) { return f2bf(lo) | (f2bf(hi) << 16); }
typedef _Float16 h16x2 __attribute__((ext_vector_type(2)));
__device__ __forceinline__ unsigned pkh(float lo, float hi) { h16x2 h; h.x = (_Float16)lo; h.y = (_Float16)hi; return __builtin_bit_cast(unsigned, h); }
__device__ __forceinline__ float hlo(unsigned w) { return (float)__builtin_bit_cast(h16x2, w).x; }
__device__ __forceinline__ float hhi(unsigned w) { return (float)__builtin_bit_cast(h16x2, w).y; }
__device__ __forceinline__ float wave_sum(float v) {
#pragma unroll
    for (int o = 1; o < 64; o <<= 1) v += __shfl_xor(v, o);
    return v;
}
__device__ __forceinline__ float wave_max(float v) {
#pragma unroll
    for (int o = 1; o < 64; o <<= 1) v = fmaxf(v, __shfl_xor(v, o));
    return v;
}
__device__ __forceinline__ float sigmoidf_(float x) { return 1.f / (1.f + __expf(-x)); }

__device__ __forceinline__ int ltid() { int t = threadIdx.x; asm volatile("" : "+v"(t)); return t; }
__device__ __forceinline__ int lsg(int v) { asm volatile("" : "+s"(v)); return v; }
struct P {
    const float* in[27];
    float* out;
    unsigned char* ws;
    int ph_lo, ph_hi, heavy, pad;
};
enum { I_X = 0, I_C, I_WMOD, I_BMOD, I_GMIX, I_GFFN, I_WIN, I_LQ1, I_LK1, I_LQ2, I_LK2, I_SUBLN, I_REL, I_QNG, I_WQB, I_KVNG, I_WKVB, I_WBD, I_WBC, I_WBM, I_WOUT, I_WR, I_RB, I_WEG, I_WEU, I_WED, I_GF };

__device__ __forceinline__ void ph0(const P& p, gptr ws, LAS unsigned char* lds, int vb, int nvb) {
    const int tid = ltid(), lane = tid & 63, wave = tid >> 6;
    LAS float* cact = (LAS float*)lds;
    for (int i = tid; i < 4096; i += 512) { const float c = INP(I_C)[i]; cact[i] = c / (1.f + expf(-c)); }
    __syncthreads();
    GAS float* modp = (GAS float*)(ws + WS_MODP);
    const int gw = vb * 8 + wave, NGW = nvb * 8;
    for (int task = gw; task < 1536; task += NGW) {
        const int l = task / 768, r = task % 768, kc = r / 48, jg = r % 48;
        const GAS float* w = INP(I_WMOD) + (size_t)l * 1024 * 6144 + (size_t)(kc * 64) * 6144 + jg * 128 + lane * 2;
        f32x2 acc[4] = {{0.f, 0.f}, {0.f, 0.f}, {0.f, 0.f}, {0.f, 0.f}};
#pragma unroll 32
        for (int k = 0; k < 64; ++k) {
            const f32x2 v = *(const GAS f32x2*)(w + (size_t)k * 6144);
#pragma unroll
            for (int b = 0; b < 4; ++b) { const float c = cact[b * 1024 + kc * 64 + k]; acc[b] += c * v; }
        }
#pragma unroll
        for (int b = 0; b < 4; ++b) *(GAS f32x2*)(modp + ((size_t)((kc * 2 + l) * 4 + b)) * 6144 + jg * 128 + lane * 2) = acc[b];
    }
    GAS float* rope = (GAS float*)(ws + WS_ROPE);
    for (int i = vb * 512 + tid; i < S * 16; i += nvb * 512) {
        const int pos = i >> 4, f = i & 15;
        const float invf = exp2f(-(float)f * (13.287712379549449f / 16.f));
        const float ang = (float)pos * invf;
        const float n = rintf(ang * 0.15915494309189535f);
        float r = fmaf(-n, 6.2831854820251465f, ang); r = fmaf(-n, -1.7484555e-7f, r);
        rope[2 * i] = cosf(r); rope[2 * i + 1] = sinf(r);
    }
    if (vb == 0 && wave == 0) {
        for (int l = 0; l < NL; ++l) {
            const float a = wave_sum(INP(I_LQ1)[l * 64 + lane] * INP(I_LK1)[l * 64 + lane]);
            const float b = wave_sum(INP(I_LQ2)[l * 64 + lane] * INP(I_LK2)[l * 64 + lane]);
            const float lam_init = 0.8f - 0.6f * expf(-0.3f * (float)l);
            if (lane == 0) ((GAS float*)(ws + WS_CTL))[CW_LAM + l] = expf(a) - expf(b) + lam_init;
        }
    }
}

template <int layer>
__device__ __forceinline__ void ph_norm1(const P& p, gptr ws, LAS unsigned char* lds, int vb, int nvb) {
    const int tid = ltid(), lane = tid & 63, wave = tid >> 6;
    LAS float* vec = (LAS float*)lds;
    const GAS float* modp = (const GAS float*)(ws + WS_MODP);
    GAS float* mod = (GAS float*)(ws + WS_MOD);
    const GAS float* tokw = (const GAS float*)(ws + WS_TOKW);
    const GAS bf16_t* os = (const GAS bf16_t*)(ws + WS_OS);
    GAS bf16_t* hb = (GAS bf16_t*)(ws + WS_HB);
    constexpr int RB = (layer == 0) ? 4 : 2;
    for (int ci = vb; ci < 256; ci += nvb) {
        const int b = ci >> 6;
        __syncthreads();
        for (int j = tid; j < 1024; j += 512) {
            if (layer < 2) {
                float sc, sh;
                if (layer == 0) {
                    sc = INP(I_BMOD)[1024 + j]; sh = INP(I_BMOD)[j];
                    for (int kc = 0; kc < 16; ++kc) { const GAS float* q = modp + ((size_t)((kc * 2 + 0) * 4 + b)) * 6144; sc += q[1024 + j]; sh += q[j]; }
                } else { sc = mod[(size_t)(4 + b) * 6144 + 1024 + j]; sh = mod[(size_t)(4 + b) * 6144 + j]; }
                vec[j] = INP(I_GMIX)[(layer < 2 ? layer : 0) * 1024 + j] * (1.f + sc); vec[1024 + j] = sh;
            } else { vec[j] = INP(I_GF)[j]; vec[1024 + j] = 0.f; }
            if (layer > 0) vec[2048 + j] = mod[(size_t)((layer > 0 ? layer - 1 : 0) * 4 + b) * 6144 + 5120 + j];
        }
        __syncthreads();
        for (int rr0 = 0; rr0 < 8; rr0 += RB) {
            f32x4 v[RB][4]; u32x2 oa[RB][4], oc[RB][4]; float w0[RB], w1[RB];
#pragma unroll
            for (int q = 0; q < RB; ++q) { const int row = ci * 64 + wave * 8 + rr0 + q;
                if (layer == 0) { const GAS float* xr = INP(I_X) + (size_t)row * D;
#pragma unroll
                    for (int j = 0; j < 4; ++j) v[q][j] = *(const GAS f32x4*)(xr + 4 * lane + 256 * j);
                } else { const GAS bf16_t* xr = (layer == 1 ? (const GAS bf16_t*)p.out : (const GAS bf16_t*)(ws + WS_KM)) + (size_t)row * D;
#pragma unroll
                    for (int j = 0; j < 4; ++j) { const u32x2 w = *(const GAS u32x2*)(xr + 4 * lane + 256 * j); v[q][j] = (f32x4){hlo(w.x), hhi(w.x), hlo(w.y), hhi(w.y)}; } }
                if (layer > 0) { w0[q] = tokw[row * 2]; w1[q] = tokw[row * 2 + 1];
#pragma unroll
                    for (int j = 0; j < 4; ++j) { oa[q][j] = *(const GAS u32x2*)(os + (size_t)(row * 2) * D + 4 * lane + 256 * j); oc[q][j] = *(const GAS u32x2*)(os + (size_t)(row * 2 + 1) * D + 4 * lane + 256 * j); } } }
#pragma unroll
            for (int q = 0; q < RB; ++q) { const int row = ci * 64 + wave * 8 + rr0 + q;
                if (layer > 0) {
#pragma unroll
                    for (int j = 0; j < 4; ++j) { const u32x2 a = oa[q][j], c = oc[q][j];
                        const f32x4 g = *(const LAS f32x4*)(vec + 2048 + 4 * lane + 256 * j);
                        v[q][j].x += g.x * (w0[q] * bflo(a.x) + w1[q] * bflo(c.x)); v[q][j].y += g.y * (w0[q] * bfhi(a.x) + w1[q] * bfhi(c.x));
                        v[q][j].z += g.z * (w0[q] * bflo(a.y) + w1[q] * bflo(c.y)); v[q][j].w += g.w * (w0[q] * bfhi(a.y) + w1[q] * bfhi(c.y)); }
                    if (layer < 2) {
#pragma unroll
                        for (int j = 0; j < 4; ++j) { u32x2 o; o.x = pkh(v[q][j].x, v[q][j].y); o.y = pkh(v[q][j].z, v[q][j].w); *(GAS u32x2*)(((GAS bf16_t*)p.out) + (size_t)row * D + 4 * lane + 256 * j) = o;
                            v[q][j] = (f32x4){hlo(o.x), hhi(o.x), hlo(o.y), hhi(o.y)}; }
                    }
                }
                float s = 0.f;
#pragma unroll
                for (int j = 0; j < 4; ++j) s += (v[q][j].x * v[q][j].x + v[q][j].y * v[q][j].y) + (v[q][j].z * v[q][j].z + v[q][j].w * v[q][j].w);
                const float rstd = rsqrtf(wave_sum(s) * (1.f / D) + EPS);
#pragma unroll
                for (int j = 0; j < 4; ++j) {
                    const f32x4 g = *(const LAS f32x4*)(vec + 4 * lane + 256 * j), sh = *(const LAS f32x4*)(vec + 1024 + 4 * lane + 256 * j);
                    const f32x4 y = v[q][j] * rstd * g + sh;
                    if (layer < 2) { u32x2 o; o.x = pk2(y.x, y.y); o.y = pk2(y.z, y.w); *(GAS u32x2*)(hb + (size_t)row * D + 4 * lane + 256 * j) = o; }
                    else *(GAS f32x4*)(((GAS float*)p.out) + (size_t)row * D + 4 * lane + 256 * j) = y;
                }
            }
        }
    }
    if (layer == 0) {
        for (int o = vb * 512 + tid; o < NL * 4 * 6144; o += nvb * 512) {
            const int l = o / (4 * 6144), r = o % (4 * 6144), b = r / 6144, j = r % 6144;
            float s = INP(I_BMOD)[l * 6144 + j];
            for (int kc = 0; kc < 16; ++kc) s += modp[((size_t)((kc * 2 + l) * 4 + b)) * 6144 + j];
            mod[o] = s;
        }
    }
}

__device__ __forceinline__ void ph_krope(const P& p, gptr ws, int vb, int nvb) {
    const GAS bf16_t* Y = (const GAS bf16_t*)(ws + WS_Y);
    GAS bf16_t* Km = (GAS bf16_t*)(ws + WS_KM);
    const GAS float* rope = (const GAS float*)(ws + WS_ROPE);
    const int tid = ltid();
    for (int i = vb * 512 + tid; i < T * 16; i += nvb * 512) {
        const int t = i >> 4, f = i & 15, pos = t & (S - 1);
        const float x1 = bf2f(Y[(size_t)t * YP + C_KR + f]), x2 = bf2f(Y[(size_t)t * YP + C_KR + 16 + f]);
        const float c = rope[(pos * 16 + f) * 2], s = rope[(pos * 16 + f) * 2 + 1];
        const bf16_t o1 = (bf16_t)f2bf(x1 * c - x2 * s), o2 = (bf16_t)f2bf(x1 * s + x2 * c);
#pragma unroll
        for (int h = 0; h < 8; ++h) { Km[(size_t)t * 768 + h * 96 + 64 + f] = o1; Km[(size_t)t * 768 + h * 96 + 80 + f] = o2; }
    }
}

__device__ __forceinline__ void ph_router(const P& p, gptr ws, LAS unsigned char* lds, int vb, int nvb, int layer, const GAS unsigned* dep) {
    const int tid = ltid(), lane = tid & 63, wave = tid >> 6;
    LAS float* wsw = (LAS float*)lds;
    LAS float* vec = (LAS float*)(lds + 65536);
    LAS int* lcnt = (LAS int*)(lds + 65536 + 8192);
    LAS int* rinfo = (LAS int*)(lds + 65536 + 8192 + 128);
    LAS float* rstd_l = (LAS float*)(lds + 65536 + 8192 + 2048);
    LAS float* lg = (LAS float*)(lds + 65536 + 8192 + 4096);
    const GAS float* mod = (const GAS float*)(ws + WS_MOD);
    GAS bf16_t* hb = (GAS bf16_t*)(ws + WS_HB);
    GAS float* tokw = (GAS float*)(ws + WS_TOKW);
    GAS int* list = (GAS int*)(ws + WS_LIST);
    GAS unsigned* cnt = (GAS unsigned*)(ws + WS_CTL) + CW_CNT + 64 * layer;
    const GAS bf16_t* xres = layer == 0 ? (const GAS bf16_t*)p.out : (const GAS bf16_t*)(ws + WS_KM);
    for (int i = tid; i < 16384; i += 512) { const int k = i >> 4, e = i & 15; wsw[((k >> 4) * 4 + ((k >> 2) & 3)) * 64 + e * 4 + (k & 3)] = INP(I_WR)[i]; }
    float rb[16];
#pragma unroll
    for (int e = 0; e < 16; ++e) rb[e] = INP(I_RB)[e];
    for (int ci = vb; ci < 256; ci += nvb) {
        const int b = ci >> 6;
        if (tid < 64) {
            if (tid == 0) { unsigned sp = 0; while (__hip_atomic_load((GAS unsigned*)dep + (ci >> 2), __ATOMIC_RELAXED, __HIP_MEMORY_SCOPE_AGENT) < 4u) { __builtin_amdgcn_s_sleep(2); if (++sp > (1u << 22)) break; } }
            __builtin_amdgcn_fence(__ATOMIC_ACQUIRE, "agent"); asm volatile("s_waitcnt vmcnt(0)" ::: "memory");
        }
        __syncthreads();
        for (int j = tid; j < 1024; j += 512) {
            vec[j] = INP(I_GFFN)[layer * 1024 + j] * (1.f + mod[(size_t)(layer * 4 + b) * 6144 + 4096 + j]);
            vec[1024 + j] = mod[(size_t)(layer * 4 + b) * 6144 + 3072 + j];
        }
        if (tid < 16) lcnt[tid] = 0;
#pragma unroll
        for (int r0 = 0; r0 < 8; r0 += 4) { f32x4 v[4][4];
#pragma unroll
            for (int q = 0; q < 4; ++q) { const GAS bf16_t* xr = xres + (size_t)(ci * 64 + wave * 8 + r0 + q) * D;
#pragma unroll
                for (int j = 0; j < 4; ++j) { const u32x2 w = *(const GAS u32x2*)(xr + 4 * lane + 256 * j); v[q][j] = (f32x4){hlo(w.x), hhi(w.x), hlo(w.y), hhi(w.y)}; } }
#pragma unroll
            for (int q = 0; q < 4; ++q) { float s = 0.f;
#pragma unroll
                for (int j = 0; j < 4; ++j) s += (v[q][j].x * v[q][j].x + v[q][j].y * v[q][j].y) + (v[q][j].z * v[q][j].z + v[q][j].w * v[q][j].w);
                s = wave_sum(s); if (lane == 0) rstd_l[wave * 8 + r0 + q] = rsqrtf(s * (1.f / D) + EPS); } }
        __syncthreads();
        { const int gI = wave & 3, hI = wave >> 2, r = lane & 15, kq = lane >> 4, row = ci * 64 + gI * 16 + r;
          const float rs = rstd_l[gI * 16 + r];
          const GAS bf16_t* xr = xres + (size_t)row * D + 4 * kq;
          GAS bf16_t* hr = hb + (size_t)row * D + 4 * kq;
          f32x4 acc = {0.f, 0.f, 0.f, 0.f};
#pragma unroll 8
          for (int jj = 0; jj < 32; ++jj) { const int j = hI * 32 + jj;
              const u32x2 xw = *(const GAS u32x2*)(xr + 16 * j); const f32x4 x4 = {hlo(xw.x), hhi(xw.x), hlo(xw.y), hhi(xw.y)};
              const f32x4 gv = *(const LAS f32x4*)(vec + 16 * j + 4 * kq), sv = *(const LAS f32x4*)(vec + 1024 + 16 * j + 4 * kq);
              const f32x4 w4 = *(const LAS f32x4*)(wsw + (j * 4 + kq) * 64 + r * 4);
              const f32x4 y = x4 * rs * gv + sv;
              u32x2 o; o.x = pk2(y.x, y.y); o.y = pk2(y.z, y.w); *(GAS u32x2*)(hr + 16 * j) = o;
              acc = __builtin_amdgcn_mfma_f32_16x16x4f32(y.x, w4.x, acc, 0, 0, 0); acc = __builtin_amdgcn_mfma_f32_16x16x4f32(y.y, w4.y, acc, 0, 0, 0);
              acc = __builtin_amdgcn_mfma_f32_16x16x4f32(y.z, w4.z, acc, 0, 0, 0); acc = __builtin_amdgcn_mfma_f32_16x16x4f32(y.w, w4.w, acc, 0, 0, 0); }
#pragma unroll
          for (int g = 0; g < 4; ++g) lg[((gI * 2 + hI) * 16 + 4 * kq + g) * 16 + r] = acc[g]; }
        __syncthreads();
        if (wave == 0) {
            const int lr = lane, gI = lr >> 4, r = lr & 15, row = ci * 64 + lr;
            float sc[16], sel[16];
#pragma unroll
            for (int e4 = 0; e4 < 4; ++e4) { const f32x4 a0 = *(const LAS f32x4*)(lg + ((gI * 2 + 0) * 16 + r) * 16 + 4 * e4), a1 = *(const LAS f32x4*)(lg + ((gI * 2 + 1) * 16 + r) * 16 + 4 * e4);
#pragma unroll
                for (int i = 0; i < 4; ++i) { const float lgt = a0[i] + a1[i]; sc[4 * e4 + i] = 1.f / (1.f + expf(-lgt)); sel[4 * e4 + i] = sc[4 * e4 + i] + rb[4 * e4 + i]; } }
            float gs[4];
#pragma unroll
            for (int g = 0; g < 4; ++g) {
                const float a = sel[4 * g], bq = sel[4 * g + 1], c = sel[4 * g + 2], d = sel[4 * g + 3];
                const float m1 = fmaxf(fmaxf(a, bq), fmaxf(c, d));
                const float m2 = fmaxf(fmaxf(fminf(a, bq), fminf(c, d)), fminf(fmaxf(a, bq), fmaxf(c, d)));
                gs[g] = m1 + m2;
            }
            int bg = 0; float bgs = gs[0];
#pragma unroll
            for (int g = 1; g < 4; ++g) if (gs[g] > bgs) { bgs = gs[g]; bg = g; }
            float s4[4], c4[4];
#pragma unroll
            for (int i = 0; i < 4; ++i) { s4[i] = bg == 0 ? sel[i] : bg == 1 ? sel[4 + i] : bg == 2 ? sel[8 + i] : sel[12 + i]; c4[i] = bg == 0 ? sc[i] : bg == 1 ? sc[4 + i] : bg == 2 ? sc[8 + i] : sc[12 + i]; }
            int i0 = 0; float b0 = s4[0];
#pragma unroll
            for (int i = 1; i < 4; ++i) if (s4[i] > b0) { b0 = s4[i]; i0 = i; }
            int i1 = -1; float b1 = -INFINITY;
#pragma unroll
            for (int i = 0; i < 4; ++i) if (i != i0 && s4[i] > b1) { b1 = s4[i]; i1 = i; }
            const float w0 = i0 == 0 ? c4[0] : i0 == 1 ? c4[1] : i0 == 2 ? c4[2] : c4[3];
            const float w1 = i1 == 0 ? c4[0] : i1 == 1 ? c4[1] : i1 == 2 ? c4[2] : c4[3];
            const float inv = 1.f / (w0 + w1);
            const int e0 = bg * 4 + i0, e1 = bg * 4 + i1;
            const int p0 = __hip_atomic_fetch_add(&lcnt[e0], 1, __ATOMIC_RELAXED, __HIP_MEMORY_SCOPE_WORKGROUP), p1 = __hip_atomic_fetch_add(&lcnt[e1], 1, __ATOMIC_RELAXED, __HIP_MEMORY_SCOPE_WORKGROUP);
            rinfo[lr * 4 + 0] = e0; rinfo[lr * 4 + 1] = e1; rinfo[lr * 4 + 2] = p0; rinfo[lr * 4 + 3] = p1;
            *(GAS f32x2*)(tokw + row * 2) = (f32x2){w0 * inv, w1 * inv};
        }
        __syncthreads();
        if (tid < 16) lcnt[16 + tid] = (int)__hip_atomic_fetch_add(cnt + tid, (unsigned)lcnt[tid], __ATOMIC_RELAXED, __HIP_MEMORY_SCOPE_AGENT);
        __syncthreads();
        if (tid < 128) {
            const int lr = tid >> 1, sl = tid & 1, e = rinfo[lr * 4 + sl], pos = rinfo[lr * 4 + 2 + sl];
            list[e * 16384 + lcnt[16 + e] + pos] = (ci * 64 + lr) * 2 + sl;
        }
    }
}


namespace pg8 {
typedef short bf16x8 __attribute__((ext_vector_type(8)));
constexpr int BM = 256, BK = 64, HALF = 128, HTB = HALF * BK * 2, STAGE_BYTES = 8 * HTB, NXCD = 8, WGM = 8;
__host__ __device__ __forceinline__ int lds_byte(int r, int c) { const int st = (r >> 4) * 2 + (c >> 5), rr = r & 15, cc = c & 31, ob = rr * 64 + cc * 2; return st * 1024 + (ob ^ (((ob >> 9) & 1) << 5)); }
__host__ __device__ __forceinline__ void stage_rc(int b, int& R, int& C) { const int st = b / 1024, sb = b % 1024, swz = sb ^ (((sb >> 9) & 1) << 5); R = (st >> 1) * 16 + swz / 64; C = (st & 1) * 32 + (swz % 64) / 2; }
__host__ __device__ __forceinline__ int perm32(int rho) { const int n = rho >> 4, i = rho & 15; return 8 * (i >> 2) + 4 * n + (i & 3); }
struct Unit { int pm, pn, x0, x1, x2; };
__device__ __forceinline__ void tile_of(int L, int nM, int nN, int& pm, int& pn) {
    const int nwg = nM * nN; int wgid = L;
    { const int q = nwg / NXCD, r = nwg % NXCD, xcd = wgid % NXCD, off = wgid / NXCD; wgid = (xcd < r ? xcd * (q + 1) : r * (q + 1) + (xcd - r) * q) + off; }
    const int nig = WGM * nN, gid = wgid / nig, fm = gid * WGM, gsz = (nM - fm) < WGM ? (nM - fm) : WGM;
    pm = fm + ((wgid % nig) % gsz); pn = (wgid % nig) / gsz;
}
__device__ __forceinline__ unsigned cvt_pk_bf16(float lo, float hi) { unsigned r; asm volatile("v_cvt_pk_bf16_f32 %0, %1, %2" : "=v"(r) : "v"(lo), "v"(hi)); return r; }

template <class Epi, class Sched, bool ALIGN_EPI>
__device__ __forceinline__ void gemm_phase(LAS unsigned char* lds, const int Kc, const Sched& S, const Epi& E) {
    const int K = lsg(Kc);
    constexpr bool GA = Sched::GATHER;
    const int tid = ltid(), wid = __builtin_amdgcn_readfirstlane(tid >> 6), lane = tid & 63, wr = wid >> 2, wc = wid & 3, fr = lane & 15, fq = lane >> 4;
    const int nt = K / BK;
    unsigned voffB[2], voffA[2];
#pragma unroll
    for (int i = 0; i < 2; ++i) { int R, C; stage_rc(tid * 16 + i * 8192, R, C); const int Rb = Epi::PERM ? ((R & ~31) + perm32(R & 31)) : R; voffB[i] = (unsigned)(Rb * K + C) * 2u; voffA[i] = S.a_lane(R, C); }
    const size_t kstep = (size_t)(BK * 2);
    const size_t hstepB = (size_t)HALF * K * 2;
    const unsigned ldsw = (unsigned)wid * 1024u;
    const int aoff = lds_byte(wr * 64 + fr, fq * 8), boff = lds_byte(wc * 32 + fr, fq * 8);
#define PG8_SA(b, h) (((b) * 2 + (h)) * HTB)
#define PG8_SB(b, h) ((4 + (b) * 2 + (h)) * HTB)
#define PG8_STAGE(bufoff, gbase, voff) do { _Pragma("unroll") for (int _i = 0; _i < 2; ++_i) \
        __builtin_amdgcn_global_load_lds((const GAS unsigned*)((const GAS char*)(gbase) + (voff)[_i]), (LAS unsigned*)(lds + (bufoff) + ldsw + _i * 8192), 16, 0, 0); } while (0)
#define PG8_LDA(dst, b, h) do { _Pragma("unroll") for (int m = 0; m < 4; ++m) _Pragma("unroll") for (int k = 0; k < 2; ++k) dst[m][k] = *(const LAS bf16x8*)(lds + PG8_SA(b, h) + aoff + m * 2048 + k * 1024); } while (0)
#define PG8_LDB(dst, b, h) do { _Pragma("unroll") for (int n = 0; n < 2; ++n) _Pragma("unroll") for (int k = 0; k < 2; ++k) dst[n][k] = *(const LAS bf16x8*)(lds + PG8_SB(b, h) + boff + n * 2048 + k * 1024); } while (0)
#define PG8_MMA(ai, bj, At, Bt) do { __builtin_amdgcn_s_setprio(1); _Pragma("unroll") for (int m = 0; m < 4; ++m) _Pragma("unroll") for (int n = 0; n < 2; ++n) _Pragma("unroll") for (int k = 0; k < 2; ++k) \
        acc[ai][bj][m][n] = __builtin_amdgcn_mfma_f32_16x16x32_bf16(Bt[n][k], At[m][k], acc[ai][bj][m][n], 0, 0, 0); __builtin_amdgcn_s_setprio(0); } while (0)
#define PG8_WAIT_V(n) asm volatile("s_waitcnt vmcnt(" #n ")" ::: "memory")
#define PG8_WAIT_L(n) asm volatile("s_waitcnt lgkmcnt(" #n ")" ::: "memory")
#define PG8_BAR __builtin_amdgcn_s_barrier()
#define PG8_SCHED __builtin_amdgcn_sched_barrier(0)
    Unit cur, nxt; int ui = 0;
    if (!S.next(0, cur)) return;
    f32x4 acc[2][2][4][2];
#pragma unroll
    for (int a = 0; a < 2; ++a)
#pragma unroll
        for (int b = 0; b < 2; ++b)
#pragma unroll
            for (int m = 0; m < 4; ++m)
#pragma unroll
                for (int n = 0; n < 2; ++n) { asm volatile("v_mov_b32 %0, 0" : "=v"(acc[a][b][m][n][0])); asm volatile("v_mov_b32 %0, 0" : "=v"(acc[a][b][m][n][1])); asm volatile("v_mov_b32 %0, 0" : "=v"(acc[a][b][m][n][2])); asm volatile("v_mov_b32 %0, 0" : "=v"(acc[a][b][m][n][3])); }
    bf16x8 At[4][2], B0[2][2], B1[2][2];
    const GAS char* cA0 = S.a_base(cur, 0); const GAS char* cA1 = S.a_base(cur, 1); const GAS char* cB = S.b_base(cur);
    unsigned cO[2][2];
    if constexpr (GA) S.a_offs(cur, cO); else { cO[0][0] = voffA[0]; cO[0][1] = voffA[1]; cO[1][0] = voffA[0]; cO[1][1] = voffA[1]; }
    if constexpr (Sched::DEPS) S.wait_ready(cur, true);
    PG8_STAGE(PG8_SB(0, 0), cB, voffB); PG8_STAGE(PG8_SB(0, 1), cB + hstepB, voffB); PG8_STAGE(PG8_SA(0, 0), cA0, cO[0]); PG8_STAGE(PG8_SA(0, 1), cA1, cO[1]);
    if (wr == 1) PG8_BAR;
    PG8_WAIT_V(2); PG8_BAR;
    PG8_STAGE(PG8_SB(1, 0), cB + kstep, voffB); PG8_STAGE(PG8_SA(1, 0), cA0 + kstep, cO[0]); PG8_STAGE(PG8_SB(1, 1), cB + hstepB + kstep, voffB);
    PG8_WAIT_V(6); PG8_BAR;
    for (;;) {
        const bool has_next = S.next(ui + 1, nxt);
        if constexpr (Sched::DEPS) { if (has_next) S.wait_ready(nxt, false); }
        const GAS char* nA0 = has_next ? S.a_base(nxt, 0) : cA0; const GAS char* nA1 = has_next ? S.a_base(nxt, 1) : cA1; const GAS char* nB = has_next ? S.b_base(nxt) : cB;
        unsigned nO[2][2];
        if constexpr (GA) { if (has_next) S.a_offs(nxt, nO); else { nO[0][0] = cO[0][0]; nO[0][1] = cO[0][1]; nO[1][0] = cO[1][0]; nO[1][1] = cO[1][1]; } }
        for (int t = 0; t < nt; t += 2) {
            const bool last = (t == nt - 2);
            const GAS char* a1 = cA1 + (size_t)(t + 1) * kstep;
            const GAS char* a20 = last ? nA0 : cA0 + (size_t)(t + 2) * kstep; const GAS char* a21 = last ? nA1 : cA1 + (size_t)(t + 2) * kstep; const GAS char* b2 = last ? nB : cB + (size_t)(t + 2) * kstep;
            const GAS char* a30 = a20 + kstep; const GAS char* b3 = b2 + kstep;
            unsigned o2[2][2];
            if constexpr (GA) { o2[0][0] = last ? nO[0][0] : cO[0][0]; o2[0][1] = last ? nO[0][1] : cO[0][1]; o2[1][0] = last ? nO[1][0] : cO[1][0]; o2[1][1] = last ? nO[1][1] : cO[1][1]; }
            else { o2[0][0] = voffA[0]; o2[0][1] = voffA[1]; o2[1][0] = voffA[0]; o2[1][1] = voffA[1]; }
            PG8_LDB(B0, 0, 0); PG8_LDB(B1, 0, 1); PG8_SCHED; PG8_LDA(At, 0, 0); PG8_STAGE(PG8_SA(1, 1), a1, cO[1]);
            PG8_WAIT_V(8); PG8_WAIT_L(0); PG8_BAR; PG8_MMA(0, 0, At, B0); PG8_MMA(0, 1, At, B1); PG8_BAR; PG8_SCHED;
            PG8_LDA(At, 0, 1); PG8_STAGE(PG8_SB(0, 0), b2, voffB); PG8_STAGE(PG8_SB(0, 1), b2 + hstepB, voffB); PG8_STAGE(PG8_SA(0, 0), a20, o2[0]);
            PG8_WAIT_V(8); PG8_WAIT_L(0); PG8_BAR; PG8_MMA(1, 0, At, B0); PG8_MMA(1, 1, At, B1); PG8_BAR; PG8_SCHED;
            PG8_LDB(B0, 1, 0); PG8_LDB(B1, 1, 1); PG8_SCHED; PG8_LDA(At, 1, 0); PG8_STAGE(PG8_SA(0, 1), a21, o2[1]);
            PG8_WAIT_V(8); PG8_WAIT_L(0); PG8_BAR; PG8_MMA(0, 0, At, B0); PG8_MMA(0, 1, At, B1); PG8_BAR; PG8_SCHED;
            PG8_LDA(At, 1, 1); PG8_STAGE(PG8_SB(1, 0), b3, voffB); PG8_STAGE(PG8_SB(1, 1), b3 + hstepB, voffB); PG8_STAGE(PG8_SA(1, 0), a30, o2[0]);
            PG8_WAIT_V(8); PG8_WAIT_L(0); PG8_BAR; PG8_MMA(1, 0, At, B0); PG8_MMA(1, 1, At, B1); PG8_BAR; PG8_SCHED;
        }
        if constexpr (ALIGN_EPI) { if (wr == 0) PG8_BAR; }
        E(acc, cur, wr, wc, fr, fq);
        if constexpr (Epi::PUBLISH) { if (E.pub(cur)) { asm volatile("s_waitcnt vmcnt(0)" ::: "memory"); PG8_BAR; asm volatile("" ::: "memory"); E.publish(cur, tid); } }
        if (!has_next) break;
        if (!E.keep(cur))
#pragma unroll
        for (int a = 0; a < 2; ++a)
#pragma unroll
            for (int b = 0; b < 2; ++b)
#pragma unroll
                for (int m = 0; m < 4; ++m)
#pragma unroll
                    for (int n = 0; n < 2; ++n) { asm volatile("v_mov_b32 %0, 0" : "=v"(acc[a][b][m][n][0])); asm volatile("v_mov_b32 %0, 0" : "=v"(acc[a][b][m][n][1])); asm volatile("v_mov_b32 %0, 0" : "=v"(acc[a][b][m][n][2])); asm volatile("v_mov_b32 %0, 0" : "=v"(acc[a][b][m][n][3])); }
        cur = nxt; cA0 = nA0; cA1 = nA1; cB = nB; ++ui;
        if constexpr (GA) { cO[0][0] = nO[0][0]; cO[0][1] = nO[0][1]; cO[1][0] = nO[1][0]; cO[1][1] = nO[1][1]; }
        if constexpr (ALIGN_EPI) { if (wr == 1) PG8_BAR; }
    }
    PG8_WAIT_V(0);
    if constexpr (!ALIGN_EPI) { if (wr == 0) PG8_BAR; }
    PG8_BAR;
#undef PG8_SA
#undef PG8_SB
#undef PG8_STAGE
#undef PG8_LDA
#undef PG8_LDB
#undef PG8_MMA
#undef PG8_WAIT_V
#undef PG8_WAIT_L
#undef PG8_BAR
#undef PG8_SCHED
}

struct SchedPlain {
    static constexpr bool GATHER = false, DEPS = false;
    const GAS char* A; const GAS char* Bt; int lda, K, nM, nN, G, c;
    __device__ __forceinline__ bool next(int i, Unit& u) const { const int L = i * G + c; if (L >= nM * nN) return false; tile_of(L, nM, nN, u.pm, u.pn); u.x0 = 0; u.x1 = 0; u.x2 = 0; return true; }
    __device__ __forceinline__ unsigned a_lane(int R, int C) const { return (unsigned)(R * lda + C) * 2u; }
    __device__ __forceinline__ const GAS char* a_base(const Unit& u, int h) const { return A + (size_t)(u.pm * 256 + h * 128) * lda * 2; }
    __device__ __forceinline__ void a_offs(const Unit&, unsigned (&)[2][2]) const {}
    __device__ __forceinline__ const GAS char* b_base(const Unit& u) const { return Bt + (size_t)u.pn * 256 * K * 2; }
};

struct EpiInproj {
    __device__ __forceinline__ bool keep(const Unit&) const { return false; }
    static constexpr bool PERM = true, PUBLISH = true;
    __device__ __forceinline__ bool pub(const Unit& u) const { return u.pn == 12 || u.pn == 13; }
    __device__ __forceinline__ void publish(const Unit& u, int tid) const { if (tid == 0) __hip_atomic_fetch_add(dep + u.pm, 1u, __ATOMIC_RELAXED, __HIP_MEMORY_SCOPE_AGENT); }
    GAS unsigned* dep;
    GAS bf16_t* Y; GAS float* ssq; GAS unsigned* cmax; GAS bf16_t* G;
    __device__ __forceinline__ void operator()(const f32x4 (&acc)[2][2][4][2], const Unit& u, int wr, int wc, int fr, int fq) const {
        const int row0 = u.pm * BM + wr * 64 + fr, col0 = u.pn * BM + wc * 32 + 8 * fq;
        const bool sg = u.pn >= 15, sq = (u.pn >= 12 && u.pn <= 14), wt = (u.pn == 12 || u.pn == 13);
        if (u.pn == 2 || u.pn == 3) {
#pragma unroll
            for (int bj = 0; bj < 2; ++bj) { float cm[8];
#pragma unroll
                for (int e = 0; e < 8; ++e) { float m_ = 0.f;
#pragma unroll
                    for (int ai = 0; ai < 2; ++ai)
#pragma unroll
                        for (int m = 0; m < 4; ++m) m_ = fmaxf(m_, fabsf(acc[ai][bj][m][e >> 2][e & 3]));
#pragma unroll
                    for (int sh = 1; sh < 16; sh <<= 1) m_ = fmaxf(m_, __shfl_xor(m_, sh));
                    cm[e] = m_; }
                if (fr == 0) {
#pragma unroll
                    for (int e = 0; e < 8; ++e) __hip_atomic_fetch_max(cmax + (u.pm >> 4) * 512 + (col0 + bj * HALF - 512) + e, __float_as_uint(cm[e]), __ATOMIC_RELAXED, __HIP_MEMORY_SCOPE_AGENT); } }
        }
#pragma unroll
        for (int ai = 0; ai < 2; ++ai)
#pragma unroll
            for (int m = 0; m < 4; ++m) { const int row = row0 + ai * HALF + m * 16; GAS bf16_t* rowp = Y + (size_t)row * YP + col0;
#pragma unroll
                for (int bj = 0; bj < 2; ++bj) { f32x4 v0 = acc[ai][bj][m][0], v1 = acc[ai][bj][m][1];
                    if (sg) {
#pragma unroll
                        for (int e = 0; e < 4; ++e) { v0[e] = __builtin_amdgcn_rcpf(1.f + __builtin_amdgcn_exp2f(-1.4426950408889634f * v0[e])); v1[e] = __builtin_amdgcn_rcpf(1.f + __builtin_amdgcn_exp2f(-1.4426950408889634f * v1[e])); }
                    }
                    u32x4 w; w.x = cvt_pk_bf16(v0[0], v0[1]); w.y = cvt_pk_bf16(v0[2], v0[3]); w.z = cvt_pk_bf16(v1[0], v1[1]); w.w = cvt_pk_bf16(v1[2], v1[3]);
                    if (sg) {
                        u32x2 q2 = {0u, 0u};
#pragma unroll
                        for (int e = 0; e < 4; ++e) { q2.x = __builtin_amdgcn_cvt_pk_u8_f32(v0[e] * 255.f, e, q2.x); q2.y = __builtin_amdgcn_cvt_pk_u8_f32(v1[e] * 255.f, e, q2.y); }
                        __builtin_nontemporal_store(q2, (GAS u32x2*)((GAS unsigned char*)G + ((size_t)(u.pm * 12 + (u.pn - 15)) * 16 + (ai * 4 + m) * 2 + bj) * 4096 + ((wr * 4 + wc) * 64 + fq * 16 + fr) * 8)); }
                    else if (wt) asm volatile("global_store_dwordx4 %0, %1, off sc1\n\ts_nop 1" :: "v"(rowp + bj * HALF), "v"(w) : "memory");
                    else __builtin_nontemporal_store(w, (GAS u32x4*)(rowp + bj * HALF));
                    if (sq) { float s = (v0[0] * v0[0] + v0[1] * v0[1]) + (v0[2] * v0[2] + v0[3] * v0[3]) + (v1[0] * v1[0] + v1[1] * v1[1]) + (v1[2] * v1[2] + v1[3] * v1[3]);
                        s += __shfl_xor(s, 16); s += __shfl_xor(s, 32);
                        if (fq == 0) { if (wt) __hip_atomic_store(ssq + (size_t)row * 24 + (u.pn - 12) * 8 + bj * 4 + wc, s, __ATOMIC_RELAXED, __HIP_MEMORY_SCOPE_AGENT); else ssq[(size_t)row * 24 + (u.pn - 12) * 8 + bj * 4 + wc] = s; } } } }
    }
};

__device__ __forceinline__ void store16_wt(GAS void* p, u32x4 v) { *(GAS u32x4*)p = v; }
struct EpiMlaQ {
    __device__ __forceinline__ bool keep(const Unit&) const { return false; }
    static constexpr bool PERM = true, PUBLISH = false;
    GAS bf16_t* Qm; const GAS float* ssq;
    __device__ __forceinline__ void operator()(const f32x4 (&acc)[2][2][4][2], const Unit& u, int wr, int wc, int fr, int fq) const {
        const int row0 = u.pm * BM + wr * 64 + fr, col0 = u.pn * BM + wc * 32 + 8 * fq;
        float rs[2][4];
#pragma unroll
        for (int ai = 0; ai < 2; ++ai)
#pragma unroll
            for (int m = 0; m < 4; ++m) { const int row = row0 + ai * HALF + m * 16;
                const f32x4 s0 = *(const GAS f32x4*)(ssq + (size_t)row * 24), s1 = *(const GAS f32x4*)(ssq + (size_t)row * 24 + 4), s2 = *(const GAS f32x4*)(ssq + (size_t)row * 24 + 8);
                const float s = ((s0[0] + s0[1]) + (s0[2] + s0[3])) + ((s1[0] + s1[1]) + (s1[2] + s1[3])) + ((s2[0] + s2[1]) + (s2[2] + s2[3]));
                rs[ai][m] = rsqrtf(s * (1.f / 384.f) + EPS); }
#pragma unroll
        for (int ai = 0; ai < 2; ++ai)
#pragma unroll
            for (int m = 0; m < 4; ++m) { const int row = row0 + ai * HALF + m * 16;
#pragma unroll
                for (int bj = 0; bj < 2; ++bj) { const f32x4 v0 = acc[ai][bj][m][0] * rs[ai][m], v1 = acc[ai][bj][m][1] * rs[ai][m];
                    u32x4 w; w.x = cvt_pk_bf16(v0[0], v0[1]); w.y = cvt_pk_bf16(v0[2], v0[3]); w.z = cvt_pk_bf16(v1[0], v1[1]); w.w = cvt_pk_bf16(v1[2], v1[3]);
                    store16_wt(Qm + (size_t)row * 768 + col0 + bj * HALF, w); } }
    }
};
struct EpiMlaKV {
    __device__ __forceinline__ bool keep(const Unit&) const { return false; }
    static constexpr bool PERM = true, PUBLISH = false;
    GAS bf16_t* Km; GAS bf16_t* Vm; const GAS float* ssq;
    __device__ __forceinline__ void operator()(const f32x4 (&acc)[2][2][4][2], const Unit& u, int wr, int wc, int fr, int fq) const {
        const int row0 = u.pm * BM + wr * 64 + fr, col0 = u.pn * BM + wc * 32 + 8 * fq;
        float rs[2][4];
#pragma unroll
        for (int ai = 0; ai < 2; ++ai)
#pragma unroll
            for (int m = 0; m < 4; ++m) { const int row = row0 + ai * HALF + m * 16;
                const f32x4 s0 = *(const GAS f32x4*)(ssq + (size_t)row * 24 + 12), s1 = *(const GAS f32x4*)(ssq + (size_t)row * 24 + 16);
                const float s = ((s0[0] + s0[1]) + (s0[2] + s0[3])) + ((s1[0] + s1[1]) + (s1[2] + s1[3]));
                rs[ai][m] = rsqrtf(s * (1.f / 256.f) + EPS); }
#pragma unroll
        for (int ai = 0; ai < 2; ++ai)
#pragma unroll
            for (int m = 0; m < 4; ++m) { const int row = row0 + ai * HALF + m * 16;
#pragma unroll
                for (int bj = 0; bj < 2; ++bj) { const f32x4 v0 = acc[ai][bj][m][0] * rs[ai][m], v1 = acc[ai][bj][m][1] * rs[ai][m];
                    u32x4 w; w.x = cvt_pk_bf16(v0[0], v0[1]); w.y = cvt_pk_bf16(v0[2], v0[3]); w.z = cvt_pk_bf16(v1[0], v1[1]); w.w = cvt_pk_bf16(v1[2], v1[3]);
                    const int n = col0 + bj * HALF;
                    GAS bf16_t* dst = n < 512 ? Km + (size_t)row * 768 + (n >> 6) * 96 + (n & 63) : Vm + (size_t)row * 512 + (n - 512);
                    store16_wt(dst, w); } }
    }
};
struct SchedPlainDep {
    static constexpr bool GATHER = false, DEPS = true;
    const GAS char* A; const GAS char* Bt; int lda, K, nM, nN, G, c; const GAS unsigned* dep; int need;
    __device__ __forceinline__ bool next(int i, Unit& u) const { const int L = i * G + c; if (L >= nM * nN) return false; tile_of(L, nM, nN, u.pm, u.pn); u.x0 = 0; u.x1 = 0; u.x2 = 0; return true; }
    __device__ __forceinline__ void wait_ready(const Unit& u, bool first) const {
        const int t = ltid();
        if ((t >> 6) == 0) {
            if (t == 0) { unsigned sp = 0; while (__hip_atomic_load((GAS unsigned*)dep + u.pm, __ATOMIC_RELAXED, __HIP_MEMORY_SCOPE_AGENT) < (unsigned)need) { __builtin_amdgcn_s_sleep(2); if (++sp > (1u << 22)) break; } }
            __builtin_amdgcn_fence(__ATOMIC_ACQUIRE, "agent"); asm volatile("s_waitcnt vmcnt(0)" ::: "memory");
        }
        if (first) { asm volatile("s_waitcnt vmcnt(0) lgkmcnt(0)" ::: "memory"); __builtin_amdgcn_s_barrier(); asm volatile("" ::: "memory"); }
    }
    __device__ __forceinline__ unsigned a_lane(int R, int C) const { return (unsigned)(R * lda + C) * 2u; }
    __device__ __forceinline__ const GAS char* a_base(const Unit& u, int h) const { return A + (size_t)(u.pm * 256 + h * 128) * lda * 2; }
    __device__ __forceinline__ void a_offs(const Unit&, unsigned (&)[2][2]) const {}
    __device__ __forceinline__ const GAS char* b_base(const Unit& u) const { return Bt + (size_t)u.pn * 256 * K * 2; }
};
struct SchedBranch {
    static constexpr bool GATHER = false, DEPS = false;
    const GAS char* Y; const GAS char* WBR; int G, c;
    __device__ __forceinline__ bool next(int i, Unit& u) const { const int rnd = i / 3, br = i - rnd * 3; const int L = rnd * G + c; if (L >= 256) return false; tile_of(L, 64, 4, u.pm, u.pn); u.x0 = br; u.x1 = 0; u.x2 = 0; return true; }
    __device__ __forceinline__ unsigned a_lane(int R, int C) const { return (unsigned)(R * YP + C) * 2u; }
    __device__ __forceinline__ const GAS char* a_base(const Unit& u, int h) const { return Y + (u.x0 == 0 ? C_DQ : u.x0 == 1 ? C_CQ : C_MQ) * 2 + (size_t)(u.pm * 256 + h * 128) * YP * 2; }
    __device__ __forceinline__ void a_offs(const Unit&, unsigned (&)[2][2]) const {}
    __device__ __forceinline__ const GAS char* b_base(const Unit& u) const { return WBR + ((size_t)u.x0 * 1024 + (size_t)u.pn * 256) * 512 * 2; }
};
struct EpiBranch {
    static constexpr bool PERM = true, PUBLISH = true;
    const GAS bf16_t* Y; GAS bf16_t* MG; GAS unsigned* dep;
    __device__ __forceinline__ bool keep(const Unit& u) const { return u.x0 < 2; }
    __device__ __forceinline__ bool pub(const Unit& u) const { return u.x0 == 2; }
    __device__ __forceinline__ void publish(const Unit& u, int tid) const { if (tid == 0) __hip_atomic_fetch_add(dep + u.pm, 1u, __ATOMIC_RELAXED, __HIP_MEMORY_SCOPE_AGENT); }
    __device__ __forceinline__ void operator()(f32x4 (&acc)[2][2][4][2], const Unit& u, int wr, int wc, int fr, int fq) const {
        const int row0 = u.pm * BM + wr * 64 + fr, col0 = u.pn * BM + wc * 32 + 8 * fq, br = u.x0;
#pragma unroll
        for (int ai = 0; ai < 2; ++ai) {
            u32x2 g[4][2], gn[4][2];
#pragma unroll
            for (int m = 0; m < 4; ++m)
#pragma unroll
                for (int bj = 0; bj < 2; ++bj) { const int row = row0 + ai * HALF + m * 16, col = col0 + bj * HALF;
                    const size_t go = ((size_t)(u.pm * 12 + br * 4 + u.pn) * 16 + (ai * 4 + m) * 2 + bj) * 4096 + ((wr * 4 + wc) * 64 + fq * 16 + fr) * 8;
                    g[m][bj] = *(const GAS u32x2*)((const GAS unsigned char*)Y + go);
                    if (br < 2) gn[m][bj] = *(const GAS u32x2*)((const GAS unsigned char*)Y + go + (size_t)4 * 16 * 4096); else gn[m][bj] = (u32x2){0x01010101u, 0x01010101u}; }
#pragma unroll
            for (int m = 0; m < 4; ++m)
#pragma unroll
                for (int bj = 0; bj < 2; ++bj) { const int row = row0 + ai * HALF + m * 16, col = col0 + bj * HALF;
                    const u32x2 gg = g[m][bj], nn = gn[m][bj];
                    float s[8];
#pragma unroll
                    for (int e = 0; e < 8; ++e) { const float gq = (float)((gg[e >> 2] >> (8 * (e & 3))) & 255u), nq = (float)((nn[e >> 2] >> (8 * (e & 3))) & 255u);
                        s[e] = (br < 2) ? gq * __builtin_amdgcn_rcpf(fmaxf(nq, 1.f)) : gq * (1.f / 255.f); }
                    f32x4 v0 = acc[ai][bj][m][0], v1 = acc[ai][bj][m][1];
                    v0[0] *= s[0]; v0[1] *= s[1]; v0[2] *= s[2]; v0[3] *= s[3]; v1[0] *= s[4]; v1[1] *= s[5]; v1[2] *= s[6]; v1[3] *= s[7];
                    if (br < 2) { acc[ai][bj][m][0] = v0; acc[ai][bj][m][1] = v1; }
                    else { u32x4 w; w.x = cvt_pk_bf16(v0[0], v0[1]); w.y = cvt_pk_bf16(v0[2], v0[3]); w.z = cvt_pk_bf16(v1[0], v1[1]); w.w = cvt_pk_bf16(v1[2], v1[3]);
                        asm volatile("global_store_dwordx4 %0, %1, off sc1\n\ts_nop 1" :: "v"(MG + (size_t)row * D + col), "v"(w) : "memory"); } }
        }
    }
};
template <bool XBF>
struct EpiOut {
    __device__ __forceinline__ bool keep(const Unit&) const { return false; }
    static constexpr bool PERM = true, PUBLISH = true;
    __device__ __forceinline__ bool pub(const Unit&) const { return true; }
    __device__ __forceinline__ void publish(const Unit& u, int tid) const { if (tid == 0) __hip_atomic_fetch_add(dep + u.pm, 1u, __ATOMIC_RELAXED, __HIP_MEMORY_SCOPE_AGENT); }
    GAS unsigned* dep;
    const GAS void* xcur; GAS bf16_t* xo; const GAS float* gt;
    __device__ __forceinline__ void operator()(const f32x4 (&acc)[2][2][4][2], const Unit& u, int wr, int wc, int fr, int fq) const {
        const int row0 = u.pm * BM + wr * 64 + fr, col0 = u.pn * BM + wc * 32 + 8 * fq;
        const GAS float* g = gt + (size_t)(u.pm >> 4) * 6144;
#pragma unroll
        for (int bj = 0; bj < 2; ++bj) { const int col = col0 + bj * HALF; const f32x4 g0 = *(const GAS f32x4*)(g + col), g1 = *(const GAS f32x4*)(g + col + 4);
            if constexpr (XBF) {
                u32x4 xb[2][4];
#pragma unroll
                for (int ai = 0; ai < 2; ++ai)
#pragma unroll
                    for (int m = 0; m < 4; ++m) xb[ai][m] = *(const GAS u32x4*)((const GAS bf16_t*)xcur + (size_t)(row0 + ai * HALF + m * 16) * D + col);
#pragma unroll
                for (int ai = 0; ai < 2; ++ai)
#pragma unroll
                    for (int m = 0; m < 4; ++m) { const u32x4 x = xb[ai][m]; const f32x4 a0 = acc[ai][bj][m][0], a1 = acc[ai][bj][m][1];
                        u32x4 w; w.x = pkh(hlo(x.x) + g0.x * a0.x, hhi(x.x) + g0.y * a0.y); w.y = pkh(hlo(x.y) + g0.z * a0.z, hhi(x.y) + g0.w * a0.w);
                        w.z = pkh(hlo(x.z) + g1.x * a1.x, hhi(x.z) + g1.y * a1.y); w.w = pkh(hlo(x.w) + g1.z * a1.z, hhi(x.w) + g1.w * a1.w);
                        asm volatile("global_store_dwordx4 %0, %1, off sc1\n\ts_nop 1" :: "v"(xo + (size_t)(row0 + ai * HALF + m * 16) * D + col), "v"(w) : "memory"); }
            } else {
#pragma unroll
                for (int ai = 0; ai < 2; ++ai) { f32x4 xa[4][2];
#pragma unroll
                    for (int m = 0; m < 4; ++m) { const GAS float* xr = (const GAS float*)xcur + (size_t)(row0 + ai * HALF + m * 16) * D + col; xa[m][0] = *(const GAS f32x4*)xr; xa[m][1] = *(const GAS f32x4*)(xr + 4); }
#pragma unroll
                    for (int m = 0; m < 4; ++m) { const f32x4 v0 = xa[m][0] + g0 * acc[ai][bj][m][0], v1 = xa[m][1] + g1 * acc[ai][bj][m][1];
                        u32x4 w; w.x = pkh(v0[0], v0[1]); w.y = pkh(v0[2], v0[3]); w.z = pkh(v1[0], v1[1]); w.w = pkh(v1[2], v1[3]);
                        asm volatile("global_store_dwordx4 %0, %1, off sc1\n\ts_nop 1" :: "v"(xo + (size_t)(row0 + ai * HALF + m * 16) * D + col), "v"(w) : "memory"); } }
            } }
    }
};
template <bool GA_> struct SchedMoe {
    static constexpr bool GATHER = GA_, DEPS = !GA_;
    const GAS char* A; const GAS char* Bt; const GAS int* list; const LAS int* tab; int lda, K, nN, G, c; GAS unsigned* dep;
    __device__ __forceinline__ void wait_ready(const Unit& u, bool first) const {
        const int t = ltid();
        if ((t >> 6) == 0) {
            if (t == 0) { unsigned sp = 0; while (__hip_atomic_load(dep + u.pm, __ATOMIC_RELAXED, __HIP_MEMORY_SCOPE_AGENT) < (unsigned)nN) { __builtin_amdgcn_s_sleep(2); if (++sp > (1u << 22)) break; } }
            __builtin_amdgcn_fence(__ATOMIC_ACQUIRE, "agent"); asm volatile("s_waitcnt vmcnt(0)" ::: "memory");
        }
        if (first) { asm volatile("s_waitcnt vmcnt(0) lgkmcnt(0)" ::: "memory"); __builtin_amdgcn_s_barrier(); asm volatile("" ::: "memory"); }
    }
    __device__ __forceinline__ bool next(int i, Unit& u) const {
        const int total = __builtin_amdgcn_readfirstlane(tab[16]) * nN; int L = i * G + c;
        const int d = total - 2 * G;
        if (G == 256 && d > 0 && d <= 48) {
            const int ca = 3 * d, cb = G - 5 * d, cc = 2 * d;
            if constexpr (GA_) { if (i == 0) L = c; else if (i == 1) { if (c >= ca + cb) return false; L = G + c; } else if (i == 2) { if (c >= ca) return false; L = G + ca + cb + c; } else return false; }
            else { if (c < ca) { if (i > 0) return false; L = 4 * cc + 2 * cb + c; }
                   else if (c < ca + cb) { if (i > 1) return false; L = 4 * cc + (c - ca) + cb * i; }
                   else { if (i > 3) return false; L = (c - ca - cb) + cc * i; } }
        } else if constexpr (!GA_) {
            const int ra = total % G, v = c >= ra ? c - ra : c + G - ra, nl = G - ra;
            L = v < nl ? (i == 0 ? v : nl + (i - 1) * G + v) : nl + i * G + v;
        }
        if (L >= total) return false;
        const int mt = L / nN, pn = L - mt * nN; int e = 0;
#pragma unroll
        for (int j = 1; j < 16; ++j) e += (mt >= __builtin_amdgcn_readfirstlane(tab[j])) ? 1 : 0;
        const int lt = mt - __builtin_amdgcn_readfirstlane(tab[e]); const int rem = __builtin_amdgcn_readfirstlane(tab[32 + e]) - lt * 256;
        u.pm = mt; u.pn = pn; u.x0 = e; u.x1 = lt * 256; u.x2 = rem < 256 ? rem : 256; return true;
    }
    __device__ __forceinline__ unsigned a_lane(int R, int C) const { return (unsigned)(R * lda + C) * 2u; }
    __device__ __forceinline__ const GAS char* a_base(const Unit& u, int h) const { return GA_ ? A : A + (size_t)(u.pm * 256 + h * 128) * lda * 2; }
    __device__ __forceinline__ void a_offs(const Unit& u, unsigned (&o)[2][2]) const {
        const int t2 = ltid();
#pragma unroll
        for (int h = 0; h < 2; ++h)
#pragma unroll
            for (int i = 0; i < 2; ++i) { int R, C; stage_rc(t2 * 16 + i * 8192, R, C); const int rl = h * 128 + R; int tok = 0; if (rl < u.x2) tok = list[u.x0 * 16384 + u.x1 + rl] >> 1; o[h][i] = (unsigned)(tok * lda + C) * 2u; }
    }
    __device__ __forceinline__ const GAS char* b_base(const Unit& u) const { return Bt + ((size_t)u.x0 * 1024 + (size_t)u.pn * 256) * K * 2; }
};
struct EpiGU {
    __device__ __forceinline__ bool keep(const Unit&) const { return false; }
    static constexpr bool PERM = true, PUBLISH = true;
    GAS bf16_t* HC; GAS unsigned* dep;
    __device__ __forceinline__ void operator()(const f32x4 (&acc)[2][2][4][2], const Unit& u, int wr, int wc, int fr, int fq) const {
        const int row0 = u.pm * BM + wr * 64 + fr, col0 = u.pn * 128 + wc * 32 + 8 * fq;
#pragma unroll
        for (int ai = 0; ai < 2; ++ai)
#pragma unroll
            for (int m = 0; m < 4; ++m) { const int row = row0 + ai * HALF + m * 16;
                f32x4 h0, h1;
#pragma unroll
                for (int e = 0; e < 4; ++e) { const float g0 = acc[ai][0][m][0][e], g1 = acc[ai][0][m][1][e];
                    h0[e] = g0 * __builtin_amdgcn_rcpf(1.f + __builtin_amdgcn_exp2f(-1.4426950408889634f * g0)) * acc[ai][1][m][0][e];
                    h1[e] = g1 * __builtin_amdgcn_rcpf(1.f + __builtin_amdgcn_exp2f(-1.4426950408889634f * g1)) * acc[ai][1][m][1][e]; }
                u32x4 w; w.x = cvt_pk_bf16(h0[0], h0[1]); w.y = cvt_pk_bf16(h0[2], h0[3]); w.z = cvt_pk_bf16(h1[0], h1[1]); w.w = cvt_pk_bf16(h1[2], h1[3]);
                asm volatile("global_store_dwordx4 %0, %1, off sc1\n\ts_nop 1" :: "v"(HC + (size_t)row * FF + col0), "v"(w) : "memory"); }
    }
    __device__ __forceinline__ bool pub(const Unit&) const { return true; }
    __device__ __forceinline__ void publish(const Unit& u, int tid) const { if (tid == 0) __hip_atomic_fetch_add(dep + u.pm, 1u, __ATOMIC_RELAXED, __HIP_MEMORY_SCOPE_AGENT); }
};
struct EpiDown {
    __device__ __forceinline__ bool keep(const Unit&) const { return false; }
    static constexpr bool PERM = true, PUBLISH = false;
    GAS bf16_t* OS; const GAS int* list;
    __device__ __forceinline__ void operator()(const f32x4 (&acc)[2][2][4][2], const Unit& u, int wr, int wc, int fr, int fq) const {
        const int col0 = u.pn * BM + wc * 32 + 8 * fq;
        int ts[2][4];
#pragma unroll
        for (int ai = 0; ai < 2; ++ai)
#pragma unroll
            for (int m = 0; m < 4; ++m) { const int rl = ai * HALF + wr * 64 + m * 16 + fr; ts[ai][m] = rl < u.x2 ? list[u.x0 * 16384 + u.x1 + rl] : -1; }
#pragma unroll
        for (int ai = 0; ai < 2; ++ai)
#pragma unroll
            for (int m = 0; m < 4; ++m) {
                if (ts[ai][m] >= 0) {
#pragma unroll
                    for (int bj = 0; bj < 2; ++bj) { const f32x4 v0 = acc[ai][bj][m][0], v1 = acc[ai][bj][m][1];
                        u32x4 w; w.x = cvt_pk_bf16(v0[0], v0[1]); w.y = cvt_pk_bf16(v0[2], v0[3]); w.z = cvt_pk_bf16(v1[0], v1[1]); w.w = cvt_pk_bf16(v1[2], v1[3]);
                        *(GAS u32x4*)(OS + (size_t)ts[ai][m] * D + col0 + bj * HALF) = w; } } }
    }
};
}


namespace att {
typedef short bf16x8 __attribute__((ext_vector_type(8)));
typedef short s16x4 __attribute__((ext_vector_type(4)));
typedef float f32x16 __attribute__((ext_vector_type(16)));
#define ASBAR() __builtin_amdgcn_sched_barrier(0)
template <bool B> struct BoolC { static constexpr bool value = B; };
__device__ __forceinline__ int crow(int r, int hi) { return (r & 3) + 8 * (r >> 2) + 4 * hi; }
__device__ __forceinline__ unsigned cvtpk(float lo, float hi) { unsigned r; asm volatile("v_cvt_pk_bf16_f32 %0, %1, %2" : "=v"(r) : "v"(lo), "v"(hi)); return r; }
template <int OFF> __device__ __forceinline__ s16x4 tr_read(int vb) { s16x4 r; asm volatile("ds_read_b64_tr_b16 %0, %1 offset:%2" : "=&v"(r) : "v"(vb), "i"(OFF) : "memory"); return r; }
__device__ __forceinline__ int v_rd_base(int lane) { return ((lane & 3) << 3) | (((lane >> 2) & 3) << 6) | (((lane >> 4) & 1) << 5) | (((lane >> 5) & 1) << 8); }

struct Args {
    const GAS bf16_t* Q; int qp, qgs;
    const GAS bf16_t* K; int kp, kgs;
    const GAS bf16_t* V; int vp;
    GAS bf16_t* O; int op;
    int q0;
    int jlo, jhi;
    float C;
    float sl2;
    const GAS float* relb;
    const GAS float* rope;
    float lam, osc; const GAS float* subln;
    const GAS unsigned* cmax;
};

template <int DQK, int DV, int NG, int MODE>
struct Body {
    static constexpr int KROWB = (DQK == 64) ? 128 : 256, KTILE = 64 * KROWB, VTILE = 64 * DV * 2, NSLOT = 4, KA = NSLOT - 1, VA = NSLOT - 2;
    static constexpr int OFF_K = 0, OFF_V = NSLOT * NG * KTILE, OFF_WS = OFF_V + NSLOT * VTILE, OFF_TB = OFF_WS + 8 * 64 * 4, LDS_END = OFF_TB + 2304;
    static constexpr int ND0 = DQK / 16, NDV = DV / 32, KCPR = DQK / 8;
    static constexpr int NKD = NG * KTILE / 1024 / 8, NVD = VTILE / 1024 / 8;
    static constexpr int WPG = 8 / NG;
    static constexpr float THR2 = 11.5f, SKIP2 = 40.f;
    static __device__ __forceinline__ int kswz(int row, int ch) { return row * KROWB + ((ch ^ (KROWB == 128 ? ((row >> 1) & 7) : (row & 15))) << 4); }
    static constexpr int v_rd_off(int d0, int ks, int half) { return d0 * 512 + ks * (2 * NDV * 512) + half * (NDV * 512); }

    template <int D0> static __device__ __forceinline__ void pv_one(f32x16& od, int vb, bf16x8 pa0, bf16x8 pa1, bf16x8 pa2, bf16x8 pa3) {
        const s16x4 l0 = tr_read<v_rd_off(D0, 0, 0)>(vb), h0 = tr_read<v_rd_off(D0, 0, 1)>(vb), l1 = tr_read<v_rd_off(D0, 1, 0)>(vb), h1 = tr_read<v_rd_off(D0, 1, 1)>(vb);
        const s16x4 l2 = tr_read<v_rd_off(D0, 2, 0)>(vb), h2 = tr_read<v_rd_off(D0, 2, 1)>(vb), l3 = tr_read<v_rd_off(D0, 3, 0)>(vb), h3 = tr_read<v_rd_off(D0, 3, 1)>(vb);
        asm volatile("s_waitcnt lgkmcnt(0)" ::: "memory"); ASBAR();
#define APK(L, H) (bf16x8){L[0], L[1], L[2], L[3], H[0], H[1], H[2], H[3]}
        od = __builtin_amdgcn_mfma_f32_32x32x16_bf16(pa0, APK(l0, h0), od, 0, 0, 0);
        od = __builtin_amdgcn_mfma_f32_32x32x16_bf16(pa1, APK(l1, h1), od, 0, 0, 0);
        od = __builtin_amdgcn_mfma_f32_32x32x16_bf16(pa2, APK(l2, h2), od, 0, 0, 0);
        od = __builtin_amdgcn_mfma_f32_32x32x16_bf16(pa3, APK(l3, h3), od, 0, 0, 0);
#undef APK
    }
    static __device__ __forceinline__ void pv_ld0(int vb, s16x4 (&f)[8]) {
        f[0] = tr_read<v_rd_off(0, 0, 0)>(vb); f[1] = tr_read<v_rd_off(0, 0, 1)>(vb); f[2] = tr_read<v_rd_off(0, 1, 0)>(vb); f[3] = tr_read<v_rd_off(0, 1, 1)>(vb);
        f[4] = tr_read<v_rd_off(0, 2, 0)>(vb); f[5] = tr_read<v_rd_off(0, 2, 1)>(vb); f[6] = tr_read<v_rd_off(0, 3, 0)>(vb); f[7] = tr_read<v_rd_off(0, 3, 1)>(vb);
    }
    static __device__ __forceinline__ void pv_mm0(f32x16& od, const s16x4 (&f)[8], bf16x8 pa0, bf16x8 pa1, bf16x8 pa2, bf16x8 pa3) {
        asm volatile("s_waitcnt lgkmcnt(0)" ::: "memory"); ASBAR();
#define APK(L, H) (bf16x8){L[0], L[1], L[2], L[3], H[0], H[1], H[2], H[3]}
        od = __builtin_amdgcn_mfma_f32_32x32x16_bf16(pa0, APK(f[0], f[1]), od, 0, 0, 0);
        od = __builtin_amdgcn_mfma_f32_32x32x16_bf16(pa1, APK(f[2], f[3]), od, 0, 0, 0);
        od = __builtin_amdgcn_mfma_f32_32x32x16_bf16(pa2, APK(f[4], f[5]), od, 0, 0, 0);
        od = __builtin_amdgcn_mfma_f32_32x32x16_bf16(pa3, APK(f[6], f[7]), od, 0, 0, 0);
#undef APK
    }
    static __device__ __forceinline__ void pv_all(f32x16 (&o)[NDV], int vb, bf16x8 pa0, bf16x8 pa1, bf16x8 pa2, bf16x8 pa3) {
        pv_one<0>(o[0], vb, pa0, pa1, pa2, pa3); pv_one<1>(o[1], vb, pa0, pa1, pa2, pa3);
        if constexpr (NDV == 4) { pv_one<2>(o[2], vb, pa0, pa1, pa2, pa3); pv_one<3>(o[3], vb, pa0, pa1, pa2, pa3); }
    }
    static __device__ __forceinline__ void qkt(f32x16& p0, f32x16& p1, const LAS unsigned char* Ks, const bf16x8 (&qr)[ND0], const f32x16& c0, float c1off, int r32, int hi) {
        constexpr int KAH = (MODE == 0) ? 0 : 2, KW = KAH + 1;
        bf16x8 f0[KW], f1[KW];
#pragma unroll
        for (int d0 = 0; d0 < KAH; ++d0) { f0[d0] = *(const LAS bf16x8*)(Ks + kswz(r32, d0 * 2 + hi)); f1[d0] = *(const LAS bf16x8*)(Ks + kswz(32 + r32, d0 * 2 + hi)); }
#pragma unroll
        for (int d0 = 0; d0 < ND0; ++d0) {
            if (d0 + KAH < ND0) { f0[(d0 + KAH) % KW] = *(const LAS bf16x8*)(Ks + kswz(r32, (d0 + KAH) * 2 + hi)); f1[(d0 + KAH) % KW] = *(const LAS bf16x8*)(Ks + kswz(32 + r32, (d0 + KAH) * 2 + hi)); }
            const bf16x8 b0 = f0[d0 % KW], b1 = f1[d0 % KW];
            if (d0 == 0) { p0 = __builtin_amdgcn_mfma_f32_32x32x16_bf16(b0, qr[0], c0, 0, 0, 0);
                if constexpr (MODE == 0) { f32x16 t;
#pragma unroll
                    for (int r = 0; r < 16; ++r) t[r] = c0[r] + c1off;
                    p1 = __builtin_amdgcn_mfma_f32_32x32x16_bf16(b1, qr[0], t, 0, 0, 0); }
                else p1 = __builtin_amdgcn_mfma_f32_32x32x16_bf16(b1, qr[0], c0, 0, 0, 0); }
            else { p0 = __builtin_amdgcn_mfma_f32_32x32x16_bf16(b0, qr[d0], p0, 0, 0, 0); p1 = __builtin_amdgcn_mfma_f32_32x32x16_bf16(b1, qr[d0], p1, 0, 0, 0); }
        }
    }
    static __device__ __forceinline__ void finishSM(f32x16& p0, f32x16& p1, float alpha, float& l_reg, bf16x8& pa0, bf16x8& pa1, bf16x8& pa2, bf16x8& pa3) {
        if constexpr (MODE != 0) {
#pragma unroll
            for (int r = 0; r < 16; ++r) p1[r] = __builtin_amdgcn_exp2f(p1[r]); }
        float ps = 0.f;
#pragma unroll
        for (int r = 0; r < 16; ++r) ps += p0[r];
#pragma unroll
        for (int r = 0; r < 16; ++r) ps += p1[r];
        { auto rr = __builtin_amdgcn_permlane32_swap(__float_as_uint(ps), __float_as_uint(ps), false, false); ps = __uint_as_float(rr[0]) + __uint_as_float(rr[1]); }
        l_reg = l_reg * alpha + ps;
#define APK4(P, BASE, OUT) do { unsigned a0 = cvtpk(P[BASE + 0], P[BASE + 1]), a1 = cvtpk(P[BASE + 2], P[BASE + 3]); \
        unsigned b0 = cvtpk(P[BASE + 4], P[BASE + 5]), b1 = cvtpk(P[BASE + 6], P[BASE + 7]); \
        auto r0 = __builtin_amdgcn_permlane32_swap(a0, b0, false, false); auto r1 = __builtin_amdgcn_permlane32_swap(a1, b1, false, false); \
        u32x4 w = {r0[0], r1[0], r0[1], r1[1]}; OUT = __builtin_bit_cast(bf16x8, w); } while (0)
        APK4(p0, 0, pa0); APK4(p0, 8, pa1); APK4(p1, 0, pa2); APK4(p1, 8, pa3);
#undef APK4
    }

    static __device__ __forceinline__ void unit(LAS unsigned char* lds, const Args& a) {
        const int tid = ltid(), wid = __builtin_amdgcn_readfirstlane(tid >> 6), lane = tid & 63, r32 = lane & 31, hi = lane >> 5;
        const int grp = wid / WPG, wg = wid % WPG;
        const int qrow = wg * 32 + r32, qpos = a.q0 + qrow, q0w = a.q0 + wg * 32, cw = q0w >> 6;
        const int wlo = (MODE == 1) ? cw - 8 : 0, whi = cw;
        LAS float* wsf = (LAS float*)(lds + OFF_WS) + wid * 64; LAS float* li_l = wsf; LAS float* al_l = wsf + 32;
        unsigned koff[NKD], voff[NVD]; int kdst[NKD], vdst[NVD];
#pragma unroll
        for (int c = 0; c < NKD; ++c) { const int pi = wid + 8 * c, g = pi / (KTILE / 1024), lp = pi % (KTILE / 1024), si = lp * 64 + lane;
            int row, ch; if (KROWB == 128) { row = si >> 3; ch = (si & 7) ^ ((row >> 1) & 7); } else { row = si >> 4; ch = (si & 15) ^ (row & 15); if (ch >= KCPR) ch = 0; }
            koff[c] = (unsigned)(g * a.kgs + row * a.kp + ch * 8) * 2u; kdst[c] = OFF_K + g * KTILE + lp * 1024; }
#pragma unroll
        for (int c = 0; c < NVD; ++c) { const int pi = wid + 8 * c, si = pi * 64 + lane, blk = si >> 5, kkh = blk / NDV, cblk = blk % NDV, within = si & 31, kk = kkh * 8 + (within >> 2);
            const int k = (kk & ~0xC) | ((kk & 4) << 1) | ((kk & 8) >> 1), cc = cblk * 32 + (within & 3) * 8;
            voff[c] = (unsigned)(k * a.vp + cc) * 2u; vdst[c] = OFF_V + pi * 1024; }
        const int NT = a.jhi - a.jlo + 1;
#define DMA_K(i) do { const GAS char* kb_ = (const GAS char*)a.K + (size_t)(a.jhi - (i)) * 64 * a.kp * 2; const int so_ = ((i) % NSLOT) * NG * KTILE; \
        _Pragma("unroll") for (int c = 0; c < NKD; ++c) __builtin_amdgcn_global_load_lds((const GAS unsigned*)(kb_ + koff[c]), (LAS unsigned*)(lds + so_ + kdst[c]), 16, 0, 0); } while (0)
#define DMA_V(i) do { const GAS char* vb_ = (const GAS char*)a.V + (size_t)(a.jhi - (i)) * 64 * a.vp * 2; const int so_ = ((i) % NSLOT) * VTILE; \
        _Pragma("unroll") for (int c = 0; c < NVD; ++c) __builtin_amdgcn_global_load_lds((const GAS unsigned*)(vb_ + voff[c]), (LAS unsigned*)(lds + so_ + vdst[c]), 16, 0, 0); } while (0)
#define WAITBAR(i) do { if ((i) + KA < NT) asm volatile("s_waitcnt vmcnt(%0)" :: "n"((KA - 1) * (NKD + NVD)) : "memory"); else asm volatile("s_waitcnt vmcnt(0)" ::: "memory"); \
        asm volatile("s_waitcnt lgkmcnt(0)" ::: "memory"); __builtin_amdgcn_s_barrier(); asm volatile("" ::: "memory"); } while (0)
        asm volatile("s_waitcnt vmcnt(0) lgkmcnt(0)" ::: "memory"); __builtin_amdgcn_s_barrier(); asm volatile("" ::: "memory");
        _Pragma("unroll") for (int t = 0; t < KA; ++t) { if (t < NT) DMA_K(t); if (t >= 1 && t - 1 < NT) DMA_V(t - 1); }
        LAS float* tb = (LAS float*)(lds + OFF_TB);
        if constexpr (MODE == 1) { for (int i = tid; i < 513; i += 512) tb[i] = a.relb[i] * 1.4426950408889634f; }
        bf16x8 qr[ND0];
        { const GAS bf16_t* Qw = a.Q + (size_t)qrow * a.qp + grp * a.qgs + hi * 8;
          u32x4 qraw[ND0];
#pragma unroll
          for (int d0 = 0; d0 < ND0; ++d0) qraw[d0] = *(const GAS u32x4*)(Qw + d0 * 16);
          if constexpr (MODE == 2) {
              const GAS float* rp = a.rope + ((size_t)qpos * 16 + hi * 8) * 2;
              const u32x4 w1 = qraw[4], w2 = qraw[5]; u32x4 o1, o2;
#pragma unroll
              for (int e = 0; e < 4; ++e) {
                  const f32x4 cs = *(const GAS f32x4*)(rp + e * 4);
                  const float x1a = bflo(w1[e]), x1b = bfhi(w1[e]), x2a = bflo(w2[e]), x2b = bfhi(w2[e]);
                  o1[e] = cvtpk((x1a * cs[0] - x2a * cs[1]) * a.C, (x1b * cs[2] - x2b * cs[3]) * a.C);
                  o2[e] = cvtpk((x1a * cs[1] + x2a * cs[0]) * a.C, (x1b * cs[3] + x2b * cs[2]) * a.C);
              }
              qr[4] = __builtin_bit_cast(bf16x8, o1); qr[5] = __builtin_bit_cast(bf16x8, o2);
          }
#pragma unroll
          for (int d0 = 0; d0 < ((MODE == 2) ? 4 : ND0); ++d0) { u32x4 w;
#pragma unroll
              for (int e = 0; e < 4; ++e) w[e] = cvtpk(bflo(qraw[d0][e]) * a.C, bfhi(qraw[d0][e]) * a.C);
              qr[d0] = __builtin_bit_cast(bf16x8, w); }
        }
        float bq = 0.f;
        if constexpr (MODE == 0) {
#pragma unroll
            for (int d0 = 0; d0 < ND0; ++d0) { const u32x4 cma = *(const GAS u32x4*)(a.cmax + grp * 64 + d0 * 16 + hi * 8), cmb = *(const GAS u32x4*)(a.cmax + grp * 64 + d0 * 16 + hi * 8 + 4);
                const u32x4 qw = __builtin_bit_cast(u32x4, qr[d0]);
                bq += fabsf(bflo(qw[0])) * __uint_as_float(cma[0]) + fabsf(bfhi(qw[0])) * __uint_as_float(cma[1]) + fabsf(bflo(qw[1])) * __uint_as_float(cma[2]) + fabsf(bfhi(qw[1])) * __uint_as_float(cma[3])
                    + fabsf(bflo(qw[2])) * __uint_as_float(cmb[0]) + fabsf(bfhi(qw[2])) * __uint_as_float(cmb[1]) + fabsf(bflo(qw[3])) * __uint_as_float(cmb[2]) + fabsf(bfhi(qw[3])) * __uint_as_float(cmb[3]); }
            { auto rr = __builtin_amdgcn_permlane32_swap(__float_as_uint(bq), __float_as_uint(bq), false, false); bq = (__uint_as_float(rr[0]) + __uint_as_float(rr[1])) * 1.01f; }
        }
        LAS int* flg = (LAS int*)(lds + OFF_TB);
        if constexpr (MODE == 0) { if (tid < 16) flg[tid] = 0; }
        float m_reg = 0.f, l_reg = 0.f; f32x16 o[NDV];
#pragma unroll
        for (int d = 0; d < NDV; ++d) o[d] = f32x16{};
        f32x16 cin0;
        const float c1off_ = (MODE == 0) ? a.sl2 * 32.f : 0.f;
#pragma unroll
        for (int r = 0; r < 16; ++r) { const float kr = (float)crow(r, hi); cin0[r] = (MODE == 0) ? a.sl2 * kr : 0.f; }
        const int vb0 = (int)(uintptr_t)(lds + OFF_V) + v_rd_base(lane);
        f32x16 pA0, pA1, pB0, pB1; float alA = 1.f, alB = 1.f; bool liveA = false, liveB = false; bf16x8 pa0, pa1, pa2, pa3;
        asm volatile("s_waitcnt vmcnt(0) lgkmcnt(0)" ::: "memory"); __builtin_amdgcn_s_barrier(); asm volatile("" ::: "memory");
#define ISSUE(i) do { if ((i) + KA < NT) DMA_K((i) + KA); if ((i) + VA < NT) DMA_V((i) + VA); } while (0)
#define RESC(al) do { if (__any((al) < 1.f)) { if (hi == 0) al_l[r32] = (al); asm volatile("s_waitcnt lgkmcnt(0)" ::: "memory"); \
        _Pragma("unroll") for (int d = 0; d < NDV; ++d) _Pragma("unroll") for (int r = 0; r < 16; ++r) o[d][r] *= al_l[crow(r, hi)]; } } while (0)
        auto head_first = [&](f32x16& p0, f32x16& p1, int j) __attribute__((always_inline)) {
            float tj = 0.f;
            if constexpr (MODE == 0) {
                tj = -a.sl2 * (float)(qpos - j * 64);
                const int dk = j * 64 + 4 * hi - qpos;
#pragma unroll
                for (int r = 0; r < 16; ++r) { const int d0_ = dk + (r & 3) + 8 * (r >> 2); if (d0_ > 0) p0[r] -= 2.f * a.sl2 * (float)d0_; if (d0_ + 32 > 0) p1[r] -= 2.f * a.sl2 * (float)(d0_ + 32); }
            } else if constexpr (MODE == 1) {
                const int dq = qpos - j * 64 - 4 * hi + 256;
#pragma unroll
                for (int r = 0; r < 16; ++r) { const int c0 = (r & 3) + 8 * (r >> 2); int i0 = dq - c0, i1 = dq - c0 - 32; i0 = i0 < 0 ? 0 : i0 > 512 ? 512 : i0; i1 = i1 < 0 ? 0 : i1 > 512 ? 512 : i1;
                    p0[r] += tb[i0]; p1[r] += tb[i1]; }
            }
            float pm = fmaxf(fmaxf(p0[0], p0[1]), p1[0]);
#pragma unroll
            for (int r = 2; r < 16; r += 2) pm = fmaxf(fmaxf(pm, p0[r]), p0[r + 1]);
#pragma unroll
            for (int r = 1; r < 15; r += 2) pm = fmaxf(fmaxf(pm, p1[r]), p1[r + 1]);
            pm = fmaxf(pm, p1[15]);
            { auto rr = __builtin_amdgcn_permlane32_swap(__float_as_uint(pm), __float_as_uint(pm), false, false); pm = fmaxf(__uint_as_float(rr[0]), __uint_as_float(rr[1])); }
            const float dl = pm + tj; m_reg += dl; tj -= dl;
#pragma unroll
            for (int r = 0; r < 16; ++r) { cin0[r] -= dl; p0[r] += tj; p1[r] += tj; }
#pragma unroll
            for (int r = 0; r < 16; ++r) p0[r] = __builtin_amdgcn_exp2f(p0[r]);
            if constexpr (MODE == 0) {
#pragma unroll
                for (int r = 0; r < 16; ++r) p1[r] = __builtin_amdgcn_exp2f(p1[r]); }
        };
        auto head = [&](f32x16& p0, f32x16& p1, float& alpha, bool& live, int j, auto doexp_c) __attribute__((always_inline)) { constexpr bool DOEXP = decltype(doexp_c)::value;
            float tj = 0.f;
            if constexpr (MODE == 0) tj = -a.sl2 * (float)(qpos - j * 64);
            else if constexpr (MODE == 1) {
                if (j <= cw - 5) tj = tb[512];
                else { const int dq = qpos - j * 64 - 4 * hi + 256;
#pragma unroll
                    for (int r = 0; r < 16; ++r) { const int c0 = (r & 3) + 8 * (r >> 2); int i0 = dq - c0, i1 = dq - c0 - 32; i0 = i0 < 0 ? 0 : i0 > 512 ? 512 : i0; i1 = i1 < 0 ? 0 : i1 > 512 ? 512 : i1;
                        p0[r] += tb[i0]; p1[r] += tb[i1]; } }
            }
            float pm = fmaxf(fmaxf(p0[0], p0[1]), p1[0]);
#pragma unroll
            for (int r = 2; r < 16; r += 2) pm = fmaxf(fmaxf(pm, p0[r]), p0[r + 1]);
#pragma unroll
            for (int r = 1; r < 15; r += 2) pm = fmaxf(fmaxf(pm, p1[r]), p1[r + 1]);
            pm = fmaxf(pm, p1[15]);
            { auto rr = __builtin_amdgcn_permlane32_swap(__float_as_uint(pm), __float_as_uint(pm), false, false); pm = fmaxf(__uint_as_float(rr[0]), __uint_as_float(rr[1])); }
            pm += tj;
            alpha = 1.f; live = true;
            if constexpr (MODE == 0) { if (__all(pm < -SKIP2)) { live = false; return; } }
            if (__builtin_expect(!__all(pm <= THR2), 0)) {
                const float dl = fmaxf(pm, 0.f);
                alpha = __builtin_amdgcn_exp2f(-dl); m_reg += dl; tj -= dl;
#pragma unroll
                for (int r = 0; r < 16; ++r) { cin0[r] -= dl; }
            }
            if (MODE != 2) {
#pragma unroll
                for (int r = 0; r < 16; ++r) { p0[r] += tj; p1[r] += tj; }
            } else if (tj != 0.f) {
#pragma unroll
                for (int r = 0; r < 16; ++r) { p0[r] += tj; p1[r] += tj; }
            }
            if constexpr (DOEXP) {
#pragma unroll
                for (int r = 0; r < 16; ++r) p0[r] = __builtin_amdgcn_exp2f(p0[r]); }
        };
#define KSLOT(i) (lds + OFF_K + (((i) % NSLOT) * NG + grp) * KTILE)
#define VSLOT(i) (vb0 + ((i) % NSLOT) * VTILE)
#define SSTEP(X0, X1, ALX, LIVEX, Y0, Y1, ALY, LIVEY, i) do { \
        ISSUE(i); \
        if constexpr (MODE != 0) { ASBAR(); qkt(X0, X1, KSLOT(i), qr, cin0, c1off_, r32, hi); } \
        if constexpr (MODE != 0) { s16x4 vf_[8]; pv_ld0(VSLOT((i) + NSLOT - 1), vf_); finishSM(Y0, Y1, ALY, l_reg, pa0, pa1, pa2, pa3); ASBAR(); \
              \
            head(X0, X1, ALX, LIVEX, a.jhi - (i), BoolC<false>{}); ASBAR(); \
            pv_mm0(o[0], vf_, pa0, pa1, pa2, pa3); \
            _Pragma("unroll") for (int r_ = 0; r_ < 8; ++r_) { X0[r_] = __builtin_amdgcn_exp2f(X0[r_]); asm volatile("" : "+v"(X0[r_])); }   \
            pv_one<1>(o[1], VSLOT((i) + NSLOT - 1), pa0, pa1, pa2, pa3); \
            _Pragma("unroll") for (int r_ = 8; r_ < 16; ++r_) { X0[r_] = __builtin_amdgcn_exp2f(X0[r_]); asm volatile("" : "+v"(X0[r_])); } ASBAR(); } \
        else if (LIVEY) {   \
            ASBAR(); qkt(X0, X1, KSLOT(i), qr, cin0, c1off_, r32, hi); finishSM(Y0, Y1, ALY, l_reg, pa0, pa1, pa2, pa3); ASBAR(); \
            head(X0, X1, ALX, LIVEX, a.jhi - (i), BoolC<false>{}); ASBAR(); \
            pv_one<0>(o[0], VSLOT((i) + NSLOT - 1), pa0, pa1, pa2, pa3); \
            _Pragma("unroll") for (int r_ = 0; r_ < 4; ++r_) { X0[r_] = __builtin_amdgcn_exp2f(X0[r_]); asm volatile("" : "+v"(X0[r_])); X1[r_] = __builtin_amdgcn_exp2f(X1[r_]); asm volatile("" : "+v"(X1[r_])); } \
            pv_one<1>(o[1], VSLOT((i) + NSLOT - 1), pa0, pa1, pa2, pa3); \
            _Pragma("unroll") for (int r_ = 4; r_ < 8; ++r_) { X0[r_] = __builtin_amdgcn_exp2f(X0[r_]); asm volatile("" : "+v"(X0[r_])); X1[r_] = __builtin_amdgcn_exp2f(X1[r_]); asm volatile("" : "+v"(X1[r_])); } \
            pv_one<NDV == 4 ? 2 : 0>(o[NDV == 4 ? 2 : 0], VSLOT((i) + NSLOT - 1), pa0, pa1, pa2, pa3); \
            _Pragma("unroll") for (int r_ = 8; r_ < 12; ++r_) { X0[r_] = __builtin_amdgcn_exp2f(X0[r_]); asm volatile("" : "+v"(X0[r_])); X1[r_] = __builtin_amdgcn_exp2f(X1[r_]); asm volatile("" : "+v"(X1[r_])); } \
            pv_one<NDV == 4 ? 3 : 1>(o[NDV == 4 ? 3 : 1], VSLOT((i) + NSLOT - 1), pa0, pa1, pa2, pa3); \
            _Pragma("unroll") for (int r_ = 12; r_ < 16; ++r_) { X0[r_] = __builtin_amdgcn_exp2f(X0[r_]); asm volatile("" : "+v"(X0[r_])); X1[r_] = __builtin_amdgcn_exp2f(X1[r_]); asm volatile("" : "+v"(X1[r_])); } ASBAR(); } \
        else { ASBAR(); qkt(X0, X1, KSLOT(i), qr, cin0, c1off_, r32, hi); ASBAR(); head(X0, X1, ALX, LIVEX, a.jhi - (i), BoolC<true>{}); \
            _Pragma("unroll") for (int r_ = 0; r_ < 16; ++r_) X1[r_] = __builtin_amdgcn_exp2f(X1[r_]); } \
        if constexpr (MODE == 0) { const int jn_ = a.jhi - (i);   \
            const bool fin_ = __all(bq - a.sl2 * (float)(qpos - 64 * jn_ + 1) - m_reg < -SKIP2); if (lane == 0) flg[((i) & 1) * 8 + wid] = fin_ ? 1 : 0; } \
        WAITBAR(i); \
        if constexpr (MODE == 0) { const u32x4 f0_ = *(const LAS u32x4*)(flg + ((i) & 1) * 8), f1_ = *(const LAS u32x4*)(flg + ((i) & 1) * 8 + 4); \
            stop = __builtin_amdgcn_readfirstlane((int)(f0_.x & f0_.y & f0_.z & f0_.w & f1_.x & f1_.y & f1_.z & f1_.w)) != 0; } \
        if (MODE != 0 || LIVEX) RESC(ALX); } while (0)
        const int jmin_ = wlo > a.jlo ? wlo : a.jlo;
        const int ia = a.jhi - whi, ib = a.jhi - jmin_;
        bool stop = false, lastB = false;
        int i = 0;
        for (; i < ia; ++i) { ISSUE(i); if constexpr (MODE == 0) { if (lane == 0) flg[(i & 1) * 8 + wid] = 0; } WAITBAR(i); }
        { ISSUE(i); ASBAR(); qkt(pA0, pA1, KSLOT(i), qr, cin0, c1off_, r32, hi); head_first(pA0, pA1, a.jhi - i); liveA = true; alA = 1.f;
          if constexpr (MODE == 0) { if (lane == 0) flg[(i & 1) * 8 + wid] = 0; }
          WAITBAR(i); ++i; }
        for (; i + 1 <= ib; i += 2) {
            SSTEP(pB0, pB1, alB, liveB, pA0, pA1, alA, liveA, i); if (MODE == 0 && stop) { lastB = true; ++i; break; }
            SSTEP(pA0, pA1, alA, liveA, pB0, pB1, alB, liveB, i + 1); if (MODE == 0 && stop) { lastB = false; i += 2; break; }
        }
        if (!stop && i <= ib) { SSTEP(pB0, pB1, alB, liveB, pA0, pA1, alA, liveA, i); ++i; lastB = true; }
        if (lastB) { if (MODE != 0 || liveB) { finishSM(pB0, pB1, alB, l_reg, pa0, pa1, pa2, pa3); ASBAR(); pv_all(o, VSLOT(i + NSLOT - 1), pa0, pa1, pa2, pa3); } }
        else if (MODE != 0 || liveA) { finishSM(pA0, pA1, alA, l_reg, pa0, pa1, pa2, pa3); ASBAR(); pv_all(o, VSLOT(i + NSLOT - 1), pa0, pa1, pa2, pa3); }
        if (!stop) { for (; i < NT; ++i) { ISSUE(i); WAITBAR(i); } }
        asm volatile("s_waitcnt vmcnt(0)" ::: "memory");
#undef ISSUE
#undef SSTEP
#undef KSLOT
#undef VSLOT
        int r32e = r32, hie = hi; asm volatile("" : "+v"(r32e), "+v"(hie));
        if (hi == 0) li_l[r32] = l_reg; asm volatile("s_waitcnt lgkmcnt(0)" ::: "memory");
        float rli[16];
#pragma unroll
        for (int r = 0; r < 16; ++r) rli[r] = __builtin_amdgcn_rcpf(li_l[crow(r, hi)]);
        if constexpr (MODE != 0) {
            GAS bf16_t* Ow = a.O + (size_t)(wg * 32) * a.op;
#pragma unroll
            for (int r = 0; r < 16; ++r) { const int orow = crow(r, hie);
#pragma unroll
                for (int d0 = 0; d0 < NDV; ++d0) Ow[(size_t)orow * a.op + d0 * 32 + r32e] = (bf16_t)f2bf(o[d0][r] * rli[r]); }
        } else {
            asm volatile("s_waitcnt lgkmcnt(0)" ::: "memory"); __builtin_amdgcn_s_barrier(); asm volatile("" ::: "memory");
            LAS float* xs = (LAS float*)lds + wg * 4096;
            if (grp == 1) {
#pragma unroll
                for (int d0 = 0; d0 < NDV; ++d0)
#pragma unroll
                    for (int r = 0; r < 16; ++r) xs[(d0 * 16 + r) * 64 + lane] = o[d0][r] * rli[r];
            }
            asm volatile("s_waitcnt lgkmcnt(0)" ::: "memory"); __builtin_amdgcn_s_barrier(); asm volatile("" ::: "memory");
            if (grp == 0) {
                float ss[16];
#pragma unroll
                for (int r = 0; r < 16; ++r) { float s = 0.f;
#pragma unroll
                    for (int d0 = 0; d0 < NDV; ++d0) { const float y = o[d0][r] * rli[r] - a.lam * xs[(d0 * 16 + r) * 64 + lane]; o[d0][r] = y; s += y * y; }
                    ss[r] = s; }
#pragma unroll
                for (int r = 0; r < 16; ++r) { float s = ss[r];
#pragma unroll
                    for (int sh = 1; sh < 32; sh <<= 1) s += __shfl_xor(s, sh);
                    ss[r] = rsqrtf(s * (1.f / 128.f) + EPS) * a.osc; }
                GAS bf16_t* Ow = a.O + (size_t)(wg * 32) * a.op;
#pragma unroll
                for (int d0 = 0; d0 < NDV; ++d0) { const float g = a.subln[d0 * 32 + r32e];
#pragma unroll
                    for (int r = 0; r < 16; ++r) Ow[(size_t)crow(r, hie) * a.op + d0 * 32 + r32e] = (bf16_t)f2bf(o[d0][r] * ss[r] * g); }
            }
        }
#undef DMA_K
#undef DMA_V
#undef WAITBAR
#undef RESC
    }
};
typedef Body<64, 128, 2, 0> Diff;
typedef Body<64, 64, 1, 1> Band;
typedef Body<96, 64, 1, 2> Mla;
#undef ASBAR
}

struct TrItem { const GAS float* src; const GAS float* ksc; GAS bf16_t* dst; int ldw, Kd; };
__device__ __forceinline__ void tr_load(const TrItem& t, float (&v)[32], int lane) {
#pragma unroll
    for (int i = 0; i < 32; ++i) v[i] = __builtin_nontemporal_load(t.src + (size_t)(2 * i) * t.ldw);
}
__device__ __forceinline__ void tr_store(const TrItem& t, float (&v)[32], LAS float* scr, int lane) {
    if (t.ksc) {
#pragma unroll
        for (int i = 0; i < 32; ++i) v[i] *= t.ksc[2 * i + (lane >> 5)];
    }
#pragma unroll
    for (int i = 0; i < 32; ++i) scr[(2 * i + (lane >> 5)) * 33 + (lane & 31)] = v[i];
    asm volatile("s_waitcnt lgkmcnt(0)" ::: "memory");
    const int c = lane & 7;
#pragma unroll
    for (int j = 0; j < 4; ++j) { const int n = (lane >> 3) + 8 * j; const LAS float* s = scr + (8 * c) * 33 + n;
        u32x4 o; o.x = pk2(s[0 * 33], s[1 * 33]); o.y = pk2(s[2 * 33], s[3 * 33]); o.z = pk2(s[4 * 33], s[5 * 33]); o.w = pk2(s[6 * 33], s[7 * 33]);
        *(GAS u32x4*)(t.dst + (size_t)n * t.Kd + 8 * c) = o; }
    asm volatile("s_waitcnt lgkmcnt(0)" ::: "memory");
}
__device__ __forceinline__ TrItem tr_decode(const P& p, gptr ws, int l, int it, int lane) {
    GAS bf16_t* WIN = (GAS bf16_t*)(ws + WS_WIN); GAS bf16_t* WQ = (GAS bf16_t*)(ws + WS_WQ); GAS bf16_t* WKV = (GAS bf16_t*)(ws + WS_WKV); GAS bf16_t* WBR = (GAS bf16_t*)(ws + WS_WBR);
    GAS bf16_t* WOUT = (GAS bf16_t*)(ws + WS_WOUT); GAS bf16_t* WGU = (GAS bf16_t*)(ws + WS_WGU); GAS bf16_t* WD = (GAS bf16_t*)(ws + WS_WD);
    constexpr int I_IN = 16 * 213, I_Q = 6 * 24, I_KV = 4 * 32, I_BR = 3 * 8 * 32, I_O = 16 * 32, I_G = 16 * 16 * 16;
    const GAS float* W; const GAS float* ks = nullptr; GAS bf16_t* WT; int ldw, Kd, k0, n0, dst0;
    int r = it;
    if (r < I_IN) { const int kb = r / 213, nb = r % 213; W = INP(I_WIN) + (size_t)l * D * INW; ldw = INW; k0 = kb * 64; n0 = nb * 32; WT = WIN; Kd = D; dst0 = n0 < 3744 ? n0 : n0 + 96; }
    else if ((r -= I_IN) < I_Q) { const int kb = r / 24, nb = r % 24; W = INP(I_WQB) + (size_t)l * 384 * 768; ldw = 768; k0 = kb * 64; n0 = nb * 32; WT = WQ; Kd = 384; dst0 = n0; ks = INP(I_QNG) + l * 384; }
    else if ((r -= I_Q) < I_KV) { const int kb = r / 32, nb = r % 32; n0 = nb * 32; const int h = n0 >> 7, d = n0 & 127; W = INP(I_WKVB) + (size_t)l * 256 * 1024; ldw = 1024; k0 = kb * 64; WT = WKV; Kd = 256; dst0 = d < 64 ? h * 64 + d : 512 + h * 64 + d - 64; ks = INP(I_KVNG) + l * 256; }
    else if ((r -= I_KV) < I_BR) { const int br = r / 256, q = r % 256, kb = q / 32, nb = q % 32; W = (br == 0 ? INP(I_WBD) : br == 1 ? INP(I_WBC) : INP(I_WBM)) + (size_t)l * 512 * D; ldw = D; k0 = kb * 64; n0 = nb * 32; WT = WBR + (size_t)br * D * 512; Kd = 512; dst0 = n0; }
    else if ((r -= I_BR) < I_O) { const int kb = r / 32, nb = r % 32; W = INP(I_WOUT) + (size_t)l * D * D; ldw = D; k0 = kb * 64; n0 = nb * 32; WT = WOUT; Kd = D; dst0 = n0; }
    else if ((r -= I_O) < 2 * I_G) { const int up = r / I_G, q = r % I_G, e = q / 256, q2 = q % 256, kb = q2 / 16, nb = q2 % 16; n0 = nb * 32;
        W = (up ? INP(I_WEU) : INP(I_WEG)) + ((size_t)l * NE + e) * D * FF; ldw = FF; k0 = kb * 64; WT = WGU + (size_t)e * D * D; Kd = D; dst0 = (n0 >> 7) * 256 + up * 128 + (n0 & 127); }
    else { r -= 2 * I_G; const int e = r / 256, q2 = r % 256, kb = q2 / 32, nb = q2 % 32; W = INP(I_WED) + ((size_t)l * NE + e) * FF * D; ldw = D; k0 = kb * 64; n0 = nb * 32; WT = WD + (size_t)e * D * FF; Kd = FF; dst0 = n0; }
    TrItem t; t.src = W + (size_t)(k0 + (lane >> 5)) * ldw + n0 + (lane & 31); t.ksc = ks ? ks + k0 : nullptr; t.dst = WT + (size_t)dst0 * Kd + k0; t.ldw = ldw; t.Kd = Kd; return t;
}
constexpr int CV_EARLY = 16 * 213 + 6 * 24 + 4 * 32, CV_NIT = CV_EARLY + 3 * 8 * 32 + 16 * 32 + 2 * 16 * 16 * 16 + 16 * 8 * 32, CV_UNITS = (CV_NIT - CV_EARLY) / 64;
static_assert((CV_NIT - CV_EARLY) % 64 == 0, "late items per unit");
__device__ __forceinline__ void ph_convert(const P& p, gptr ws, LAS unsigned char* lds, int l, int gw, int NGW, int NIT) {
    const int tid = ltid(), lane = tid & 63, wave = tid >> 6;
    LAS float* scr = (LAS float*)(lds + wave * 16384);
    float va[32], vb_[32];
    int it = gw;
    TrItem ta, tb; if (it < NIT) { ta = tr_decode(p, ws, l, it, lane); tr_load(ta, va, lane); }
    while (it < NIT) {
        const int it1 = it + NGW;
        if (it1 < NIT) { tb = tr_decode(p, ws, l, it1, lane); tr_load(tb, vb_, lane); }
        tr_store(ta, va, scr, lane);
        const int it2 = it1 + NGW;
        if (it1 >= NIT) break;
        if (it2 < NIT) { ta = tr_decode(p, ws, l, it2, lane); tr_load(ta, va, lane); }
        tr_store(tb, vb_, scr, lane);
        it = it2;
    }
}
__device__ __forceinline__ void ph_convert_early(const P& p, gptr ws, LAS unsigned char* lds, int vb, int nvb, int l) {
    const int tid = ltid();
    ph_convert(p, ws, lds, l, vb * 8 + (tid >> 6), nvb * 8, CV_EARLY);
    GAS bf16_t* WIN = (GAS bf16_t*)(ws + WS_WIN);
    for (int i = vb * 512 + tid; i < 96 * D / 8; i += nvb * 512) *(GAS u32x4*)(WIN + (size_t)3744 * D + (size_t)i * 8) = (u32x4){0u, 0u, 0u, 0u};
}


__device__ __forceinline__ void moe_table(gptr ws, LAS int* tab, int layer) {
    const int tid = ltid();
    __syncthreads();
    if (tid < 16) tab[32 + tid] = (int)__hip_atomic_load((GAS unsigned*)(ws + WS_CTL) + CW_CNT + 64 * layer + tid, __ATOMIC_RELAXED, __HIP_MEMORY_SCOPE_AGENT);
    __syncthreads();
    if (tid == 0) { int s = 0; tab[0] = 0; for (int e = 0; e < 16; ++e) { s += (tab[32 + e] + 255) >> 8; tab[e + 1] = s; } }
    __syncthreads();
}

#define XB_TMO      128
#define XB_XCNT(j)  (256  + 64 * (j))
#define XB_XSUB(j)  (1280 + 64 * (j))
#define XB_XGEN(j)  (2304 + 64 * (j))
#define XB_TOP      3328
#define XB_TOPGEN   3392
#define XCD_BAR_WORDS 3456
#define XB_SPIN_CAP (1u << 18)
__device__ __forceinline__ unsigned xb_ld(unsigned* p)              { return __hip_atomic_load(p, __ATOMIC_RELAXED, __HIP_MEMORY_SCOPE_AGENT); }
__device__ __forceinline__ unsigned xb_add(unsigned* p, unsigned v) { return __hip_atomic_fetch_add(p, v, __ATOMIC_RELAXED, __HIP_MEMORY_SCOPE_AGENT); }
__device__ __forceinline__ unsigned xb_xcc_id() { return (unsigned)__builtin_amdgcn_s_getreg((3 << 11) | 20) & 0xFu; }
#define XB_SPIN(cond, bar) do { unsigned _sp = 0; while (cond) { __builtin_amdgcn_s_sleep(1); \
    if ((++_sp & 255u) == 0u) { if (xb_ld(&(bar)[XB_TMO])) break; if (_sp > XB_SPIN_CAP) { atomicAdd(&(bar)[XB_TMO], 1u); break; } } } } while (0)
struct XcdBarrier { unsigned* bar; unsigned x; volatile LAS unsigned* st; };
__device__ __forceinline__ XcdBarrier xcd_barrier_post(unsigned* bar, volatile LAS unsigned* st) {
    XcdBarrier b; b.bar = bar; b.x = xb_xcc_id(); b.st = st;
    if (threadIdx.x == 0) (void)xb_add(&bar[XB_XCNT(b.x)], 1u);
    return b;
}
__device__ __forceinline__ void xcd_barrier_complete(unsigned* bar, unsigned x, unsigned& nloc, unsigned& nx) {
    const unsigned G = gridDim.x * gridDim.y * gridDim.z;
    unsigned sum, cnt, mine, sp = 0u;
    for (;;) {
        sum = 0u; cnt = 0u; mine = 0u;
#pragma unroll
        for (unsigned j = 0; j < 16; ++j) { const unsigned c = xb_ld(&bar[XB_XCNT(j)]); sum += c; cnt += (c > 0u) ? 1u : 0u; mine = (j == x) ? c : mine; }
        if (sum == G) break;
        __builtin_amdgcn_s_sleep(1);
        if ((++sp & 255u) == 0u) { if (xb_ld(&bar[XB_TMO])) break; if (sp > XB_SPIN_CAP) { atomicAdd(&bar[XB_TMO], 1u); break; } }
    }
    nloc = mine > 0u ? mine : 1u; nx = cnt > 0u ? cnt : 1u;
}
__device__ __forceinline__ void xcd_barrier(const XcdBarrier& b) {
    asm volatile("s_waitcnt vmcnt(0)" ::: "memory");
    __syncthreads();
    if (threadIdx.x == 0) {
        unsigned* bar = b.bar;
        __builtin_amdgcn_s_waitcnt(0);
        unsigned nloc = b.st[0], nx = b.st[1];
        if (nloc == 0u) { xcd_barrier_complete(bar, b.x, nloc, nx); b.st[0] = nloc; b.st[1] = nx; }
        const unsigned old = xb_add(&bar[XB_XSUB(b.x)], 1u);
        const unsigned gen = old / nloc;
        if (old + 1u == (gen + 1u) * nloc) {
            __builtin_amdgcn_fence(__ATOMIC_RELEASE, "agent");
            asm volatile("s_waitcnt vmcnt(0)" ::: "memory");
            const unsigned og = xb_add(&bar[XB_TOP], 1u);
            const unsigned tg = og / nx;
            if (og + 1u == (tg + 1u) * nx) xb_add(&bar[XB_TOPGEN], 1u);
            else XB_SPIN(xb_ld(&bar[XB_TOPGEN]) == tg, bar);
            __builtin_amdgcn_fence(__ATOMIC_ACQUIRE, "agent");
            xb_add(&bar[XB_XGEN(b.x)], 1u);
            asm volatile("s_waitcnt vmcnt(0)" ::: "memory");
        } else {
            XB_SPIN(xb_ld(&bar[XB_XGEN(b.x)]) == gen, bar);
            __builtin_amdgcn_fence(__ATOMIC_ACQUIRE, "agent");
            asm volatile("s_waitcnt vmcnt(0)" ::: "memory");
        }
    }
    __syncthreads();
}

constexpr int LDS_BYTES = 147456;
constexpr int MISC_OFF = 131072 + 8192;
constexpr int NPHASE = 20;
enum { HV_INPROJ = 1, HV_MLAPROJ = 2, HV_DIFF = 4, HV_BAND = 8, HV_MLAATT = 16, HV_BRANCH = 32, HV_OUT = 64, HV_GU = 128, HV_DOWN = 256 };

__device__ const unsigned short ATT_ORDER[1536] = {223,1247,2271,3295,222,1246,2270,3294,159,1183,2207,3231,221,1245,2269,3293,158,1182,2206,3230,220,1244,2268,3292,157,1181,2205,3229,219,1243,2267,3291,156,1180,2204,3228,218,1242,2266,3290,155,1179,2203,3227,217,1241,2265,3289,154,1178,2202,3226,216,1240,2264,3288,153,1177,2201,3225,215,1239,2263,3287,152,1176,2200,3224,214,1238,2262,3286,151,1175,2199,3223,95,1119,2143,3167,213,1237,2261,3285,150,1174,2198,3222,94,1118,2142,3166,212,1236,2260,3284,93,1117,2141,3165,149,1173,2197,3221,92,1116,2140,3164,211,1235,2259,3283,148,1172,2196,3220,91,1115,2139,3163,210,1234,2258,3282,147,1171,2195,3219,90,1114,2138,3162,89,1113,2137,3161,146,1170,2194,3218,209,1233,2257,3281,88,1112,2136,3160,145,1169,2193,3217,208,1232,2256,3280,87,1111,2135,3159,144,1168,2192,3216,86,1110,2134,3158,207,1231,2255,3279,31,1055,2079,3103,30,1054,2078,3102,85,1109,2133,3157,143,1167,2191,3215,206,1230,2254,3278,29,1053,2077,3101,84,1108,2132,3156,28,1052,2076,3100,142,1166,2190,3214,205,1229,2253,3277,27,1051,2075,3099,83,1107,2131,3155,4111,4175,4239,4303,4367,4431,4495,4559,5135,5199,5263,5327,5391,5455,5519,5583,6159,6223,6287,6351,6415,6479,6543,6607,7183,7247,7311,7375,7439,7503,7567,7631,4110,4174,4238,4302,4366,4430,4494,4558,5134,5198,5262,5326,5390,5454,5518,5582,6158,6222,6286,6350,6414,6478,6542,6606,7182,7246,7310,7374,7438,7502,7566,7630,4109,4173,4237,4301,4365,4429,4493,4557,5133,5197,5261,5325,5389,5453,5517,5581,6157,6221,6285,6349,6413,6477,6541,6605,7181,7245,7309,7373,7437,7501,7565,7629,4108,4172,4236,4300,4364,4428,4492,4556,5132,5196,5260,5324,5388,5452,5516,5580,6156,6220,6284,6348,6412,6476,6540,6604,7180,7244,7308,7372,7436,7500,7564,7628,4107,4171,4235,4299,4363,4427,4491,4555,5131,5195,5259,5323,5387,5451,5515,5579,6155,6219,6283,6347,6411,6475,6539,6603,7179,7243,7307,7371,7435,7499,7563,7627,4106,4170,4234,4298,4362,4426,4490,4554,5130,5194,5258,5322,5386,5450,5514,5578,6154,6218,6282,6346,6410,6474,6538,6602,7178,7242,7306,7370,7434,7498,7562,7626,4105,4169,4233,4297,4361,4425,4489,4553,5129,5193,5257,5321,5385,5449,5513,5577,6153,6217,6281,6345,6409,6473,6537,6601,7177,7241,7305,7369,7433,7497,7561,7625,4104,4168,4232,4296,4360,4424,4488,4552,5128,5192,5256,5320,5384,5448,5512,5576,6152,6216,6280,6344,6408,6472,6536,6600,7176,7240,7304,7368,7432,7496,7560,7624,26,1050,2074,3098,141,1165,2189,3213,82,1106,2130,3154,204,1228,2252,3276,25,1049,2073,3097,81,1105,2129,3153,24,1048,2072,3096,140,1164,2188,3212,4103,4167,4231,4295,4359,4423,4487,4551,5127,5191,5255,5319,5383,5447,5511,5575,6151,6215,6279,6343,6407,6471,6535,6599,7175,7239,7303,7367,7431,7495,7559,7623,203,1227,2251,3275,23,1047,2071,3095,80,1104,2128,3152,22,1046,2070,3094,139,1163,2187,3211,79,1103,2127,3151,202,1226,2250,3274,21,1045,2069,3093,4102,4166,4230,4294,4358,4422,4486,4550,5126,5190,5254,5318,5382,5446,5510,5574,6150,6214,6278,6342,6406,6470,6534,6598,7174,7238,7302,7366,7430,7494,7558,7622,20,1044,2068,3092,78,1102,2126,3150,138,1162,2186,3210,201,1225,2249,3273,19,1043,2067,3091,77,1101,2125,3149,18,1042,2066,3090,137,1161,2185,3209,4101,4165,4229,4293,4357,4421,4485,4549,5125,5189,5253,5317,5381,5445,5509,5573,6149,6213,6277,6341,6405,6469,6533,6597,7173,7237,7301,7365,7429,7493,7557,7621,76,1100,2124,3148,200,1224,2248,3272,17,1041,2065,3089,136,1160,2184,3208,16,1040,2064,3088,75,1099,2123,3147,199,1223,2247,3271,15,1039,2063,3087,74,1098,2122,3146,4100,4164,4228,4292,4356,4420,4484,4548,5124,5188,5252,5316,5380,5444,5508,5572,6148,6212,6276,6340,6404,6468,6532,6596,7172,7236,7300,7364,7428,7492,7556,7620,135,1159,2183,3207,14,1038,2062,3086,198,1222,2246,3270,13,1037,2061,3085,73,1097,2121,3145,134,1158,2182,3206,12,1036,2060,3084,72,1096,2120,3144,4099,4163,4227,4291,4355,4419,4483,4547,5123,5187,5251,5315,5379,5443,5507,5571,6147,6211,6275,6339,6403,6467,6531,6595,7171,7235,7299,7363,7427,7491,7555,7619,197,1221,2245,3269,11,1035,2059,3083,133,1157,2181,3205,71,1095,2119,3143,10,1034,2058,3082,196,1220,2244,3268,9,1033,2057,3081,70,1094,2118,3142,132,1156,2180,3204,4098,4162,4226,4290,4354,4418,4482,4546,5122,5186,5250,5314,5378,5442,5506,5570,6146,6210,6274,6338,6402,6466,6530,6594,7170,7234,7298,7362,7426,7490,7554,7618,8,1032,2056,3080,69,1093,2117,3141,195,1219,2243,3267,7,1031,2055,3079,131,1155,2179,3203,6,1030,2054,3078,68,1092,2116,3140,8194,8258,8322,8386,8450,8514,8578,8642,9218,9282,9346,9410,9474,9538,9602,9666,10242,10306,10370,10434,10498,10562,10626,10690,11266,11330,11394,11458,11522,11586,11650,11714,8195,8259,8323,8387,8451,8515,8579,8643,9219,9283,9347,9411,9475,9539,9603,9667,10243,10307,10371,10435,10499,10563,10627,10691,11267,11331,11395,11459,11523,11587,11651,11715,8196,8260,8324,8388,8452,8516,8580,8644,9220,9284,9348,9412,9476,9540,9604,9668,10244,10308,10372,10436,10500,10564,10628,10692,11268,11332,11396,11460,11524,11588,11652,11716,8197,8261,8325,8389,8453,8517,8581,8645,9221,9285,9349,9413,9477,9541,9605,9669,10245,10309,10373,10437,10501,10565,10629,10693,11269,11333,11397,11461,11525,11589,11653,11717,8198,8262,8326,8390,8454,8518,8582,8646,9222,9286,9350,9414,9478,9542,9606,9670,10246,10310,10374,10438,10502,10566,10630,10694,11270,11334,11398,11462,11526,11590,11654,11718,8199,8263,8327,8391,8455,8519,8583,8647,9223,9287,9351,9415,9479,9543,9607,9671,10247,10311,10375,10439,10503,10567,10631,10695,11271,11335,11399,11463,11527,11591,11655,11719,8200,8264,8328,8392,8456,8520,8584,8648,9224,9288,9352,9416,9480,9544,9608,9672,10248,10312,10376,10440,10504,10568,10632,10696,11272,11336,11400,11464,11528,11592,11656,11720,8201,8265,8329,8393,8457,8521,8585,8649,9225,9289,9353,9417,9481,9545,9609,9673,10249,10313,10377,10441,10505,10569,10633,10697,11273,11337,11401,11465,11529,11593,11657,11721,8202,8266,8330,8394,8458,8522,8586,8650,9226,9290,9354,9418,9482,9546,9610,9674,10250,10314,10378,10442,10506,10570,10634,10698,11274,11338,11402,11466,11530,11594,11658,11722,8203,8267,8331,8395,8459,8523,8587,8651,9227,9291,9355,9419,9483,9547,9611,9675,10251,10315,10379,10443,10507,10571,10635,10699,11275,11339,11403,11467,11531,11595,11659,11723,8204,8268,8332,8396,8460,8524,8588,8652,9228,9292,9356,9420,9484,9548,9612,9676,10252,10316,10380,10444,10508,10572,10636,10700,11276,11340,11404,11468,11532,11596,11660,11724,8205,8269,8333,8397,8461,8525,8589,8653,9229,9293,9357,9421,9485,9549,9613,9677,10253,10317,10381,10445,10509,10573,10637,10701,11277,11341,11405,11469,11533,11597,11661,11725,8206,8270,8334,8398,8462,8526,8590,8654,9230,9294,9358,9422,9486,9550,9614,9678,10254,10318,10382,10446,10510,10574,10638,10702,11278,11342,11406,11470,11534,11598,11662,11726,8207,8271,8335,8399,8463,8527,8591,8655,9231,9295,9359,9423,9487,9551,9615,9679,10255,10319,10383,10447,10511,10575,10639,10703,11279,11343,11407,11471,11535,11599,11663,11727,4097,4161,4225,4289,4353,4417,4481,4545,5121,5185,5249,5313,5377,5441,5505,5569,6145,6209,6273,6337,6401,6465,6529,6593,7169,7233,7297,7361,7425,7489,7553,7617,194,1218,2242,3266,5,1029,2053,3077,130,1154,2178,3202,67,1091,2115,3139,4,1028,2052,3076,66,1090,2114,3138,8193,8257,8321,8385,8449,8513,8577,8641,9217,9281,9345,9409,9473,9537,9601,9665,10241,10305,10369,10433,10497,10561,10625,10689,11265,11329,11393,11457,11521,11585,11649,11713,193,1217,2241,3265,3,1027,2051,3075,129,1153,2177,3201,4096,4160,4224,4288,4352,4416,4480,4544,5120,5184,5248,5312,5376,5440,5504,5568,6144,6208,6272,6336,6400,6464,6528,6592,7168,7232,7296,7360,7424,7488,7552,7616,2,1026,2050,3074,65,1089,2113,3137,8192,8256,8320,8384,8448,8512,8576,8640,9216,9280,9344,9408,9472,9536,9600,9664,10240,10304,10368,10432,10496,10560,10624,10688,11264,11328,11392,11456,11520,11584,11648,11712,192,1216,2240,3264,1,1025,2049,3073,128,1152,2176,3200,64,1088,2112,3136,0,1024,2048,3072};
#define IN(k) (lo <= (k) && (k) < hi)
#define LP() unsigned char* ws_ = p.ws; asm volatile("" : "+s"(ws_)); gptr ws = (gptr)ws_; LAS unsigned char* ldsl = (LAS unsigned char*)lds; asm volatile("" : "+s"(ldsl)); const int vb = lsg(vb0), nvb = lsg(nvb0); (void)ws; (void)vb; (void)nvb; (void)ldsl
#define SEAM(k) do { if (IN(k) && IN((k) + 1)) { XcdBarrier b2 = bar; asm volatile("" : "+s"(b2.bar), "+s"(b2.x)); xcd_barrier(b2); } } while (0)
#define NREP(bit) (1 + ((p.pad >> (bit)) & 1))
template <int l>
__device__ __forceinline__ void layer_body(const P& p, unsigned char* lds, const XcdBarrier& bar, int vb0, int nvb0, int lo, int hi) {
        const int base = 1 + 9 * l;
        if (IN(base + 0)) { LP(); if (l > 0) { for (int rep = 0, nr = NREP(10); rep < nr; ++rep) { ph_convert_early(p, ws, ldsl, vb, nvb, l); __syncthreads(); } } for (int rep = 0, nr = (l == 0 ? NREP(11) : 1); rep < nr; ++rep) { ph_norm1<l>(p, ws, ldsl, vb, nvb); __syncthreads(); } } SEAM(base + 0);
        if (IN(base + 1)) { LP();
            if (p.heavy & HV_INPROJ) for (int rep = 0, nr = NREP(0); rep < nr; ++rep) { pg8::SchedPlain S{(const GAS char*)(ws + WS_HB), (const GAS char*)(ws + WS_WIN), D, D, 64, 27, nvb, vb}; pg8::EpiInproj E{(GAS unsigned*)(ws + WS_CTL) + CW_INQ + 64 * l, (GAS bf16_t*)(ws + WS_Y), (GAS float*)(ws + WS_SSQ), (GAS unsigned*)(ws + WS_CTL) + CW_CMAX + 2048 * l, (GAS bf16_t*)(ws + WS_G)};
                pg8::gemm_phase<pg8::EpiInproj, pg8::SchedPlain, true>(ldsl, D, S, E); }
            if ((p.heavy & HV_MLAPROJ) && nvb == 256 && vb >= 192) {
                pg8::SchedPlainDep S{(const GAS char*)(ws + WS_Y) + C_MQ * 2, (const GAS char*)(ws + WS_WQ), YP, 384, 64, 3, 64, vb - 192, (const GAS unsigned*)(ws + WS_CTL) + CW_INQ + 64 * l, 2};
                pg8::EpiMlaQ E{(GAS bf16_t*)(ws + WS_QM), (const GAS float*)(ws + WS_SSQ)};
                pg8::gemm_phase<pg8::EpiMlaQ, pg8::SchedPlainDep, true>(ldsl, 384, S, E); }
        } SEAM(base + 1);
        if (IN(base + 2)) { LP();
            constexpr float LOG2E = 1.4426950408889634f;
            ph_krope(p, ws, vb, nvb);
            if (p.heavy & HV_MLAPROJ) for (int rep = 0, nr = NREP(1); rep < nr; ++rep) {
                if (nvb != 256) { pg8::SchedPlain S{(const GAS char*)(ws + WS_Y) + C_MQ * 2, (const GAS char*)(ws + WS_WQ), YP, 384, 64, 3, nvb, vb}; pg8::EpiMlaQ E{(GAS bf16_t*)(ws + WS_QM), (const GAS float*)(ws + WS_SSQ)};
                  pg8::gemm_phase<pg8::EpiMlaQ, pg8::SchedPlain, true>(ldsl, 384, S, E); }
                { pg8::SchedPlain S{(const GAS char*)(ws + WS_Y) + C_CKV * 2, (const GAS char*)(ws + WS_WKV), YP, 256, 64, 4, nvb, vb}; pg8::EpiMlaKV E{(GAS bf16_t*)(ws + WS_KM), (GAS bf16_t*)(ws + WS_VM), (const GAS float*)(ws + WS_SSQ)};
                  pg8::gemm_phase<pg8::EpiMlaKV, pg8::SchedPlain, true>(ldsl, 256, S, E); }
            }
            { const int tid_ = ltid();
              asm volatile("s_waitcnt vmcnt(0)" ::: "memory"); __builtin_amdgcn_s_barrier(); asm volatile("" ::: "memory");
              if (tid_ == 0) { __builtin_amdgcn_fence(__ATOMIC_RELEASE, "agent"); asm volatile("s_waitcnt vmcnt(0)" ::: "memory"); }
              if (tid_ == 0) __hip_atomic_fetch_add((GAS unsigned*)(ws + WS_CTL) + CW_MLAP + 64 * l, 1u, __ATOMIC_RELAXED, __HIP_MEMORY_SCOPE_AGENT); }
            {
                const float lam = ((const GAS float*)(ws + WS_CTL))[CW_LAM + l];
                GAS unsigned* qctr = (GAS unsigned*)(ws + WS_CTL) + CW_Q + 64 * l;
                GAS unsigned* mlap = (GAS unsigned*)(ws + WS_CTL) + CW_MLAP + 64 * l;
                LAS int* qslot = (LAS int*)(ldsl + 143360 + 64);
                const int tid_ = ltid();
                bool mla_ready = false;
                int u = vb;
                while (u < 1536 + CV_UNITS) {
                    unsigned nxt = 0u;
                    if (tid_ == 0) nxt = __hip_atomic_fetch_add(qctr, 1u, __ATOMIC_RELAXED, __HIP_MEMORY_SCOPE_AGENT);
                    const bool cvu = (u & 7) == 7 && (u >> 3) < CV_UNITS;
                    const int ncb = ((u + 1) >> 3) < CV_UNITS ? ((u + 1) >> 3) : CV_UNITS, ai_ = cvu ? 0 : u - ncb;
                    const int code = cvu ? (3 << 12) : __builtin_amdgcn_readfirstlane((int)ATT_ORDER[ai_]), ty = code >> 12, b = (code >> 10) & 3, h = (code >> 6) & 15, qb = code & 63;
                    if (ty == 3) { const int i0 = CV_EARLY + (u >> 3) * 64; ph_convert(p, ws, ldsl, l, i0 + (ltid() >> 6), 8, i0 + 64); }
                    else if (ty == 0) {
                        GAS bf16_t* Yb = (GAS bf16_t*)(ws + WS_Y) + (size_t)b * S * YP;
                        att::Args a; a.Q = Yb + (size_t)(qb * 128) * YP + C_DQ + h * 128; a.qp = YP; a.qgs = 64; a.K = Yb + C_DK + h * 128; a.kp = YP; a.kgs = 64; a.V = Yb + C_DV + h * 128; a.vp = YP;
                        a.O = Yb + (size_t)(qb * 128) * YP + C_DQ + h * 128; a.op = YP; a.q0 = qb * 128; a.jlo = 0; a.jhi = 2 * qb + 1; a.C = 0.125f * LOG2E; a.sl2 = exp2f(-2.f * (float)(h + 1)) * LOG2E;
                        a.relb = nullptr; a.rope = nullptr; a.lam = lam; a.osc = (l == 0) ? 0.8f : 0.64449093f; a.subln = INP(I_SUBLN) + l * 128;
                        a.cmax = (const GAS unsigned*)(ws + WS_CTL) + CW_CMAX + 2048 * l + b * 512 + h * 128;
                        att::Diff::unit(ldsl, a);
                    } else if (ty == 1) {
                        if (!mla_ready) {
                            if (tid_ == 0) { unsigned sp = 0; while (__hip_atomic_load(mlap, __ATOMIC_RELAXED, __HIP_MEMORY_SCOPE_AGENT) < (unsigned)nvb) { __builtin_amdgcn_s_sleep(2); if (++sp > (1u << 22)) break; } }
                            asm volatile("s_waitcnt vmcnt(0) lgkmcnt(0)" ::: "memory"); __builtin_amdgcn_s_barrier(); asm volatile("" ::: "memory");
                            __builtin_amdgcn_fence(__ATOMIC_ACQUIRE, "agent"); asm volatile("s_waitcnt vmcnt(0)" ::: "memory");
                            mla_ready = true;
                        }
                        att::Args a; a.Q = (const GAS bf16_t*)(ws + WS_QM) + (size_t)(b * S + qb * 256) * 768 + h * 96; a.qp = 768; a.qgs = 0;
                        a.K = (const GAS bf16_t*)(ws + WS_KM) + (size_t)b * S * 768 + h * 96; a.kp = 768; a.kgs = 0; a.V = (const GAS bf16_t*)(ws + WS_VM) + (size_t)b * S * 512 + h * 64; a.vp = 512;
                        a.O = (GAS bf16_t*)(ws + WS_Y) + (size_t)(b * S + qb * 256) * YP + C_MQ + h * 64; a.op = YP; a.q0 = qb * 256; a.jlo = 0; a.jhi = 4 * qb + 3; a.C = 0.10206207261596577f * LOG2E; a.sl2 = 0.f;
                        a.relb = nullptr; a.rope = (const GAS float*)(ws + WS_ROPE); a.lam = 0.f; a.osc = 0.f; a.subln = nullptr; a.cmax = nullptr;
                        att::Mla::unit(ldsl, a);
                    } else { const int c0 = 4 * qb;
                        GAS bf16_t* Yb = (GAS bf16_t*)(ws + WS_Y) + (size_t)b * S * YP;
                        att::Args a; a.Q = Yb + (size_t)(qb * 256) * YP + C_CQ + h * 64; a.qp = YP; a.qgs = 0; a.K = Yb + C_CK + h * 64; a.kp = YP; a.kgs = 0; a.V = Yb + C_CV + h * 64; a.vp = YP;
                        a.O = Yb + (size_t)(qb * 256) * YP + C_CQ + h * 64; a.op = YP; a.q0 = qb * 256; a.jlo = c0 - 8 < 0 ? 0 : c0 - 8; a.jhi = c0 + 3; a.C = 0.125f * LOG2E; a.sl2 = 0.f;
                        a.relb = INP(I_REL) + (size_t)(l * 8 + h) * 513; a.rope = nullptr; a.lam = 0.f; a.osc = 0.f; a.subln = nullptr; a.cmax = nullptr;
                        att::Band::unit(ldsl, a);
                    }
                    if (ltid() == 0) qslot[0] = nvb + (int)nxt;
                    asm volatile("s_waitcnt vmcnt(0) lgkmcnt(0)" ::: "memory"); __builtin_amdgcn_s_barrier(); asm volatile("" ::: "memory");
                    u = __builtin_amdgcn_readfirstlane(qslot[0]);
                    asm volatile("s_waitcnt lgkmcnt(0)" ::: "memory"); __builtin_amdgcn_s_barrier(); asm volatile("" ::: "memory");
                }
            }
        }
        if (IN(base + 3)) { } SEAM(base + 3);
        if (IN(base + 4)) { LP();
            if (p.heavy & HV_BRANCH) for (int rep = 0, nr = NREP(5); rep < nr; ++rep) { pg8::SchedBranch S{(const GAS char*)(ws + WS_Y), (const GAS char*)(ws + WS_WBR), nvb, vb}; pg8::EpiBranch E{(const GAS bf16_t*)(ws + WS_G), (GAS bf16_t*)(ws + WS_HB), (GAS unsigned*)(ws + WS_CTL) + CW_BRO + 64 * l};
                pg8::gemm_phase<pg8::EpiBranch, pg8::SchedBranch, true>(ldsl, 512, S, E); }
        }
        if (IN(base + 4)) { LP();
            if (p.heavy & HV_OUT) { pg8::SchedPlainDep S{(const GAS char*)(ws + WS_HB), (const GAS char*)(ws + WS_WOUT), D, D, 64, 4, nvb, vb, (const GAS unsigned*)(ws + WS_CTL) + CW_BRO + 64 * l, 4};
                pg8::EpiOut<(l > 0)> E{(GAS unsigned*)(ws + WS_CTL) + CW_OUT + 64 * l, l == 0 ? (const GAS void*)INP(I_X) : (const GAS void*)p.out, l == 0 ? (GAS bf16_t*)p.out : (GAS bf16_t*)(ws + WS_KM), (const GAS float*)(ws + WS_MOD) + (size_t)(l * 4) * 6144 + 2048};
                pg8::gemm_phase<pg8::EpiOut<(l > 0)>, pg8::SchedPlainDep, true>(ldsl, D, S, E); }
        }
        if (IN(base + 4)) { LP(); ph_router(p, ws, ldsl, vb, nvb, l, (const GAS unsigned*)(ws + WS_CTL) + CW_OUT + 64 * l); }
        if (IN(base + 5)) { } if (IN(base + 6)) { } SEAM(base + 6);
        if (IN(base + 7)) { LP();
            if (p.heavy & HV_GU) for (int rep = 0, nr = NREP(7); rep < nr; ++rep) { LAS int* tab = (LAS int*)(ldsl + 131072); moe_table(ws, tab, l);
                pg8::SchedMoe<true> S{(const GAS char*)(ws + WS_HB), (const GAS char*)(ws + WS_WGU), (const GAS int*)(ws + WS_LIST), tab, D, D, 4, nvb, vb, nullptr}; pg8::EpiGU E{(GAS bf16_t*)(ws + WS_HC), (GAS unsigned*)(ws + WS_CTL) + CW_GUD + 256 * l};
                pg8::gemm_phase<pg8::EpiGU, pg8::SchedMoe<true>, true>(ldsl, D, S, E); }
            if (p.heavy & HV_DOWN) for (int rep = 0, nr = NREP(8); rep < nr; ++rep) { LAS int* tab = (LAS int*)(ldsl + 131072); moe_table(ws, tab, l);
                pg8::SchedMoe<false> S{(const GAS char*)(ws + WS_HC), (const GAS char*)(ws + WS_WD), (const GAS int*)(ws + WS_LIST), tab, FF, FF, 4, nvb, vb, (GAS unsigned*)(ws + WS_CTL) + CW_GUD + 256 * l}; pg8::EpiDown E{(GAS bf16_t*)(ws + WS_OS), (const GAS int*)(ws + WS_LIST)};
                pg8::gemm_phase<pg8::EpiDown, pg8::SchedMoe<false>, true>(ldsl, FF, S, E); }
        }
        if (IN(base + 8)) { } SEAM(base + 8);
}
__global__ void __launch_bounds__(512, 2) mega(P p) {
    extern __shared__ __attribute__((aligned(16))) unsigned char lds[];
    const int tid = threadIdx.x;
    volatile LAS unsigned* misc = (volatile LAS unsigned*)((LAS unsigned char*)lds + MISC_OFF);
    if (tid < 4) misc[tid] = 0u;
    __syncthreads();
    XcdBarrier bar = xcd_barrier_post((unsigned*)(p.ws + WS_CTL) + CW_BAR, misc);
    const int vb0 = blockIdx.x, nvb0 = gridDim.x;
    const int lo = p.ph_lo, hi = p.ph_hi;
    if (IN(0)) { LP(); for (int rep = 0, nr = NREP(12); rep < nr; ++rep) { ph0(p, ws, ldsl, vb, nvb); __syncthreads(); } for (int rep = 0, nr = NREP(10); rep < nr; ++rep) { ph_convert_early(p, ws, ldsl, vb, nvb, 0); __syncthreads(); } } SEAM(0);
    layer_body<0>(p, lds, bar, vb0, nvb0, lo, hi);
    layer_body<1>(p, lds, bar, vb0, nvb0, lo, hi);
    if (IN(19)) { LP(); ph_norm1<2>(p, ws, ldsl, vb, nvb); }
#undef IN
#undef SEAM
}

struct RowPlain { int M; __device__ int rows() const { return M; } __device__ int src(int m) const { return m; } };
struct RowList { const unsigned* cnt; const int* list; __device__ int rows() const { return (int)*cnt; } __device__ int src(int m) const { return list[m] >> 1; } };
struct RowCompact { const unsigned* cnts; int e; __device__ int rows() const { return (int)cnts[e]; }
    __device__ int base() const { int b = 0; for (int i = 0; i < e; ++i) b += ((int)cnts[i] + 255) / 256 * 256; return b; }
    __device__ int src(int m) const { return base() + m; } };

template <class RowMap, class Epi>
__global__ __launch_bounds__(256) void naive_gemm(const bf16_t* A, int lda, RowMap rm, const float* W, int ldw, int K, int N, const float* kscale, Epi epi) {
    const int M = rm.rows();
    const int m0 = blockIdx.y * 64, n0 = blockIdx.x * 64;
    if (m0 >= M) return;
    __shared__ float As[16][65];
    __shared__ float Ws[16][64];
    const int tid = threadIdx.x, tx = tid & 15, ty = tid >> 4;
    float acc[4][4];
#pragma unroll
    for (int i = 0; i < 4; ++i)
#pragma unroll
        for (int j = 0; j < 4; ++j) acc[i][j] = 0.f;
    const int ar = tid >> 2, akq = (tid & 3) * 4;
    const int grow = m0 + ar;
    const int srow = grow < M ? rm.src(grow) : rm.src(0);
    const int wk = tid >> 4, wn = (tid & 15) * 4;
    for (int k0 = 0; k0 < K; k0 += 16) {
        const u32x2 a = *(const u32x2*)(A + (size_t)srow * lda + k0 + akq);
        float a0 = bflo(a.x), a1 = bfhi(a.x), a2 = bflo(a.y), a3 = bfhi(a.y);
        if (kscale) { a0 *= kscale[k0 + akq]; a1 *= kscale[k0 + akq + 1]; a2 *= kscale[k0 + akq + 2]; a3 *= kscale[k0 + akq + 3]; }
        As[akq][ar] = a0; As[akq + 1][ar] = a1; As[akq + 2][ar] = a2; As[akq + 3][ar] = a3;
        f32x4 w = {0.f, 0.f, 0.f, 0.f};
        if (n0 + wn < N) w = *(const f32x4*)(W + (size_t)(k0 + wk) * ldw + n0 + wn);
        *(f32x4*)&Ws[wk][wn] = w;
        __syncthreads();
#pragma unroll
        for (int kk = 0; kk < 16; ++kk) {
            float av[4], wv[4];
#pragma unroll
            for (int i = 0; i < 4; ++i) { av[i] = As[kk][ty * 4 + i]; wv[i] = Ws[kk][tx * 4 + i]; }
#pragma unroll
            for (int i = 0; i < 4; ++i)
#pragma unroll
                for (int j = 0; j < 4; ++j) acc[i][j] += av[i] * wv[j];
        }
        __syncthreads();
    }
#pragma unroll
    for (int i = 0; i < 4; ++i)
#pragma unroll
        for (int j = 0; j < 4; ++j) { const int row = m0 + ty * 4 + i, col = n0 + tx * 4 + j; if (row < M && col < N) epi(row, col, acc[i][j]); }
}

struct NEpiInproj { bf16_t* Y; __device__ void operator()(int row, int col, float v) const {
    const int yc = col < 3744 ? col : col + 96; if (col >= 3744) v = sigmoidf_(v); Y[(size_t)row * YP + yc] = (bf16_t)f2bf(v); } };
struct NEpiMlaQ { bf16_t* Qm; const float* ssq; __device__ void operator()(int row, int col, float v) const {
    float s = 0.f; for (int i = 0; i < 12; ++i) s += ssq[row * 24 + i];
    Qm[(size_t)row * 768 + col] = (bf16_t)f2bf(v * rsqrtf(s * (1.f / 384.f) + EPS)); } };
struct NEpiMlaKV { bf16_t* Km; bf16_t* Vm; const float* ssq; __device__ void operator()(int row, int col, float v) const {
    float s = 0.f; for (int i = 12; i < 20; ++i) s += ssq[row * 24 + i];
    v *= rsqrtf(s * (1.f / 256.f) + EPS); const int h = col >> 7, d = col & 127;
    if (d < 64) Km[(size_t)row * 768 + h * 96 + d] = (bf16_t)f2bf(v); else Vm[(size_t)row * 512 + h * 64 + d - 64] = (bf16_t)f2bf(v); } };
struct NEpiBranch { const bf16_t* Y; bf16_t* MG; int br; __device__ void operator()(int row, int col, float v) const {
    const float g = bf2f(Y[(size_t)row * YP + C_G + br * 1024 + col]); float m = g * v; if (br) m += bf2f(MG[(size_t)row * D + col]); MG[(size_t)row * D + col] = (bf16_t)f2bf(m); } };
struct NEpiOut { const float* xcur; float* xo; const float* mod; int layer; __device__ void operator()(int row, int col, float v) const {
    const int b = row >> 12; xo[(size_t)row * D + col] = xcur[(size_t)row * D + col] + mod[(size_t)(layer * 4 + b) * 6144 + 2048 + col] * v; } };
struct NEpiGate { bf16_t* HC; RowCompact rc; __device__ void operator()(int row, int col, float v) const {
    HC[(size_t)(rc.base() + row) * FF + col] = (bf16_t)f2bf(v / (1.f + __expf(-v))); } };
struct NEpiUp { bf16_t* HC; RowCompact rc; __device__ void operator()(int row, int col, float v) const {
    const size_t o = (size_t)(rc.base() + row) * FF + col; HC[o] = (bf16_t)f2bf(bf2f(HC[o]) * v); } };
struct NEpiDown { bf16_t* OS; const int* list; __device__ void operator()(int row, int col, float v) const {
    OS[(size_t)list[row] * D + col] = (bf16_t)f2bf(v); } };

__global__ __launch_bounds__(256) void naive_ssq(const bf16_t* Y, float* ssq) {
    const int row = blockIdx.x * 4 + (threadIdx.x >> 6), lane = threadIdx.x & 63;
    float sq = 0.f, sk = 0.f;
    for (int i = lane; i < 384; i += 64) { const float v = bf2f(Y[(size_t)row * YP + C_MQ + i]); sq += v * v; }
    for (int i = lane; i < 256; i += 64) { const float v = bf2f(Y[(size_t)row * YP + C_CKV + i]); sk += v * v; }
    sq = wave_sum(sq); sk = wave_sum(sk);
    if (lane < 24) ssq[row * 24 + lane] = lane == 0 ? sq : lane == 12 ? sk : 0.f;
}

template <int DQK, int DV, int MODE>
__device__ __forceinline__ void attn_row(const float* q, const bf16_t* Kb, int kp, const bf16_t* Vb, int vp, int klo, int khi, float scale,
                                         int qpos, float slope, const float* relt, float (&res)[DV / 64]) {
    const int lane = threadIdx.x & 63;
    float m = -1e30f, l = 0.f, o[DV];
#pragma unroll
    for (int d = 0; d < DV; ++d) o[d] = 0.f;
    for (int k = klo + lane; k < khi; k += 64) {
        const bf16_t* kr = Kb + (size_t)k * kp;
        float s = 0.f;
#pragma unroll
        for (int c = 0; c < DQK / 8; ++c) {
            const u32x4 w = *(const u32x4*)(kr + c * 8);
            s += q[c * 8 + 0] * bflo(w.x) + q[c * 8 + 1] * bfhi(w.x) + q[c * 8 + 2] * bflo(w.y) + q[c * 8 + 3] * bfhi(w.y)
               + q[c * 8 + 4] * bflo(w.z) + q[c * 8 + 5] * bfhi(w.z) + q[c * 8 + 6] * bflo(w.w) + q[c * 8 + 7] * bfhi(w.w);
        }
        s *= scale;
        if (MODE == 0) s -= slope * fabsf((float)(qpos - k));
        if (MODE == 1) { int rel = qpos - k; rel = rel < -256 ? -256 : rel > 256 ? 256 : rel; s += relt[rel + 256]; }
        const float mn = fmaxf(m, s), al = __expf(m - mn), pe = __expf(s - mn);
        m = mn; l = l * al + pe;
        const bf16_t* vr = Vb + (size_t)k * vp;
#pragma unroll
        for (int c = 0; c < DV / 8; ++c) {
            const u32x4 w = *(const u32x4*)(vr + c * 8);
            o[c * 8 + 0] = o[c * 8 + 0] * al + pe * bflo(w.x); o[c * 8 + 1] = o[c * 8 + 1] * al + pe * bfhi(w.x);
            o[c * 8 + 2] = o[c * 8 + 2] * al + pe * bflo(w.y); o[c * 8 + 3] = o[c * 8 + 3] * al + pe * bfhi(w.y);
            o[c * 8 + 4] = o[c * 8 + 4] * al + pe * bflo(w.z); o[c * 8 + 5] = o[c * 8 + 5] * al + pe * bfhi(w.z);
            o[c * 8 + 6] = o[c * 8 + 6] * al + pe * bflo(w.w); o[c * 8 + 7] = o[c * 8 + 7] * al + pe * bfhi(w.w);
        }
    }
    const float M = wave_max(m), f = __expf(m - M);
    const float L = wave_sum(l * f), inv = 1.f / L;
#pragma unroll
    for (int i = 0; i < DV / 64; ++i) res[i] = 0.f;
#pragma unroll
    for (int d = 0; d < DV; ++d) { const float v = wave_sum(o[d] * f) * inv; if ((d & 63) == lane) res[d >> 6] = v; }
}

__global__ __launch_bounds__(64) void naive_attn_diff(bf16_t* Y, const float* lamp, const float* subln, float lam_init) {
    const int t = blockIdx.x >> 2, h = blockIdx.x & 3, b = t >> 12, pos = t & (S - 1), lane = threadIdx.x;
    const float slope = exp2f(-2.f * (float)(h + 1));
    const int khi = ((pos >> 6) + 1) * 64;
    const bf16_t* Yb = Y + (size_t)b * S * YP;
    float r0[2], r1[2], q[64];
    for (int mp = 0; mp < 2; ++mp) {
#pragma unroll
        for (int d = 0; d < 64; ++d) q[d] = bf2f(Y[(size_t)t * YP + C_DQ + h * 128 + mp * 64 + d]);
        if (mp == 0) attn_row<64, 128, 0>(q, Yb + C_DK + h * 128, YP, Yb + C_DV + h * 128, YP, 0, khi, 0.125f, pos, slope, nullptr, r0);
        else attn_row<64, 128, 0>(q, Yb + C_DK + h * 128 + 64, YP, Yb + C_DV + h * 128, YP, 0, khi, 0.125f, pos, slope, nullptr, r1);
    }
    const float lam = *lamp;
    const float y0 = r0[0] - lam * r1[0], y1 = r0[1] - lam * r1[1];
    const float rstd = rsqrtf(wave_sum(y0 * y0 + y1 * y1) * (1.f / 128.f) + EPS);
    Y[(size_t)t * YP + C_DQ + h * 128 + lane] = (bf16_t)f2bf(y0 * rstd * subln[lane] * (1.f - lam_init));
    Y[(size_t)t * YP + C_DQ + h * 128 + 64 + lane] = (bf16_t)f2bf(y1 * rstd * subln[64 + lane] * (1.f - lam_init));
}
__global__ __launch_bounds__(64) void naive_attn_band(bf16_t* Y, const float* rel) {
    const int t = blockIdx.x >> 3, h = blockIdx.x & 7, b = t >> 12, pos = t & (S - 1), lane = threadIdx.x;
    const int ch = pos >> 6, klo = (ch - 8 < 0 ? 0 : ch - 8) * 64, khi = (ch + 1) * 64;
    const bf16_t* Yb = Y + (size_t)b * S * YP;
    float q[64], r[1];
#pragma unroll
    for (int d = 0; d < 64; ++d) q[d] = bf2f(Y[(size_t)t * YP + C_CQ + h * 64 + d]);
    attn_row<64, 64, 1>(q, Yb + C_CK + h * 64, YP, Yb + C_CV + h * 64, YP, klo, khi, 0.125f, pos, 0.f, rel + h * 513, r);
    Y[(size_t)t * YP + C_CQ + h * 64 + lane] = (bf16_t)f2bf(r[0]);
}
__global__ __launch_bounds__(64) void naive_attn_mla(const bf16_t* Qm, const bf16_t* Km, const bf16_t* Vm, const float* rope, bf16_t* Y) {
    const int t = blockIdx.x >> 3, h = blockIdx.x & 7, b = t >> 12, pos = t & (S - 1), lane = threadIdx.x;
    const int khi = ((pos >> 6) + 1) * 64;
    float q[96], r[1];
#pragma unroll
    for (int d = 0; d < 96; ++d) q[d] = bf2f(Qm[(size_t)t * 768 + h * 96 + d]);
#pragma unroll
    for (int f = 0; f < 16; ++f) { const float c = rope[(pos * 16 + f) * 2], s = rope[(pos * 16 + f) * 2 + 1]; const float x1 = q[64 + f], x2 = q[80 + f];
        q[64 + f] = bf2f(f2bf(x1 * c - x2 * s)); q[80 + f] = bf2f(f2bf(x1 * s + x2 * c)); }
    attn_row<96, 64, 2>(q, Km + (size_t)b * S * 768 + h * 96, 768, Vm + (size_t)b * S * 512 + h * 64, 512, 0, khi, 0.10206207261596577f, pos, 0.f, nullptr, r);
    Y[(size_t)t * YP + C_MQ + h * 64 + lane] = (bf16_t)f2bf(r[0]);
}

#ifndef REP_MASK
#define REP_MASK 0
#endif
#ifndef ONE_LAUNCH
#define ONE_LAUNCH 1
#endif
#ifndef HEAVY_MASK
#define HEAVY_MASK (HV_INPROJ | HV_MLAPROJ | HV_BRANCH | HV_OUT | HV_GU | HV_DOWN | HV_DIFF | HV_BAND | HV_MLAATT)
#endif
static void launch_mega(const P& base, int lo, int hi, int heavy, int grid, hipStream_t stream) {
    P a = base; a.ph_lo = lo; a.ph_hi = hi; a.heavy = heavy; a.pad = REP_MASK;
    hipLaunchKernelGGL(mega, dim3(grid), dim3(512), LDS_BYTES, stream, a);
}

extern "C" void kernel_launch(void* const* d_in, const int* in_sizes, int n_in, void* d_out, int out_size, void* d_ws, size_t ws_size, hipStream_t stream) {
    static int grid = 0;
    if (grid == 0) {
        if (n_in != 27 || out_size != T * D || ws_size < WS_END) { fprintf(stderr, "kernel_launch: bad shapes n_in %d out %d ws %zu (need %zu)\n", n_in, out_size, ws_size, (size_t)WS_END); grid = -1; return; }
        int dev = 0, cus = 0;
        hipGetDevice(&dev); hipDeviceGetAttribute(&cus, hipDeviceAttributeMultiprocessorCount, dev);
        if (hipFuncSetAttribute((const void*)mega, hipFuncAttributeMaxDynamicSharedMemorySize, LDS_BYTES) != hipSuccess) { fprintf(stderr, "hipFuncSetAttribute failed\n"); grid = -1; return; }
        grid = cus > 0 ? cus : 256;
    }
    if (grid < 0) return;
    hipMemsetAsync((char*)d_ws + WS_CTL, 0, CTL_BYTES, stream);
    P p{};
    for (int i = 0; i < 27; ++i) p.in[i] = (const float*)d_in[i];
    p.out = (float*)d_out; p.ws = (unsigned char*)d_ws;
    unsigned char* ws = (unsigned char*)d_ws;
    bf16_t* Y = (bf16_t*)(ws + WS_Y); bf16_t* HB = (bf16_t*)(ws + WS_HB); bf16_t* KM = (bf16_t*)(ws + WS_KM); bf16_t* VM = (bf16_t*)(ws + WS_VM);
    bf16_t* HC = (bf16_t*)(ws + WS_HC); bf16_t* OS = (bf16_t*)(ws + WS_OS);
    float* SSQ = (float*)(ws + WS_SSQ); const float* MOD = (const float*)(ws + WS_MOD); const float* ROPE = (const float*)(ws + WS_ROPE);
    const int* LIST = (const int*)(ws + WS_LIST);
    const int HM = HEAVY_MASK;
    constexpr int ALLHV = HV_INPROJ | HV_MLAPROJ | HV_BRANCH | HV_OUT | HV_GU | HV_DOWN | HV_DIFF | HV_BAND | HV_MLAATT;
    if (HM == ALLHV && ONE_LAUNCH) { launch_mega(p, 0, NPHASE, HM, grid, stream); return; }
    launch_mega(p, 0, 1, HM, grid, stream);
    for (int l = 0; l < NL; ++l) {
        const int base = 1 + 9 * l;
        launch_mega(p, base, base + 1, HM, grid, stream);
        if (HM & HV_INPROJ) launch_mega(p, base + 1, base + 2, HM, grid, stream);
        else {
            hipLaunchKernelGGL((naive_gemm<RowPlain, NEpiInproj>), dim3(107, 256), dim3(256), 0, stream, HB, D, RowPlain{T}, p.in[I_WIN] + (size_t)l * D * INW, INW, D, INW, (const float*)nullptr, NEpiInproj{Y});
            hipLaunchKernelGGL(naive_ssq, dim3(T / 4), dim3(256), 0, stream, Y, SSQ);
        }
        launch_mega(p, base + 2, base + 3, HM, grid, stream);
        if (!(HM & HV_MLAPROJ)) {
            hipLaunchKernelGGL((naive_gemm<RowPlain, NEpiMlaQ>), dim3(12, 256), dim3(256), 0, stream, Y + C_MQ, YP, RowPlain{T}, p.in[I_WQB] + (size_t)l * 384 * 768, 768, 384, 768, p.in[I_QNG] + l * 384, NEpiMlaQ{HB, SSQ});
            hipLaunchKernelGGL((naive_gemm<RowPlain, NEpiMlaKV>), dim3(16, 256), dim3(256), 0, stream, Y + C_CKV, YP, RowPlain{T}, p.in[I_WKVB] + (size_t)l * 256 * 1024, 1024, 256, 1024, p.in[I_KVNG] + l * 256, NEpiMlaKV{KM, VM, SSQ});
        }
        const float lam_init = 0.8f - 0.6f * expf(-0.3f * (float)l);
        if (!(HM & HV_DIFF)) hipLaunchKernelGGL(naive_attn_diff, dim3(T * 4), dim3(64), 0, stream, Y, (const float*)(ws + WS_CTL) + CW_LAM + l, p.in[I_SUBLN] + l * 128, lam_init);
        if (!(HM & HV_BAND)) hipLaunchKernelGGL(naive_attn_band, dim3(T * 8), dim3(64), 0, stream, Y, p.in[I_REL] + (size_t)l * 8 * 513);
        if (HM & HV_MLAATT) launch_mega(p, base + 3, base + 4, HM, grid, stream);
        else hipLaunchKernelGGL(naive_attn_mla, dim3(T * 8), dim3(64), 0, stream, HB, KM, VM, ROPE, Y);
        if (HM & HV_BRANCH) launch_mega(p, base + 4, base + 5, HM, grid, stream);
        else {
            const float* wbr[3] = {p.in[I_WBD], p.in[I_WBC], p.in[I_WBM]}; const int acol[3] = {C_DQ, C_CQ, C_MQ};
            for (int br = 0; br < 3; ++br)
                hipLaunchKernelGGL((naive_gemm<RowPlain, NEpiBranch>), dim3(16, 256), dim3(256), 0, stream, Y + acol[br], YP, RowPlain{T}, wbr[br] + (size_t)l * 512 * D, D, 512, D, (const float*)nullptr, NEpiBranch{Y, HB, br});
        }
        if (HM & HV_OUT) launch_mega(p, base + 5, base + 6, HM, grid, stream);
        else hipLaunchKernelGGL((naive_gemm<RowPlain, NEpiOut>), dim3(16, 256), dim3(256), 0, stream, HB, D, RowPlain{T}, p.in[I_WOUT] + (size_t)l * D * D, D, D, D, (const float*)nullptr,
                           NEpiOut{l == 0 ? p.in[I_X] : (const float*)p.out, p.out, MOD, l});
        launch_mega(p, base + 6, base + 7, HM, grid, stream);
        const unsigned* cnts = (const unsigned*)(ws + WS_CTL) + CW_CNT + 64 * l;
        if (HM & HV_GU) launch_mega(p, base + 7, base + 8, HM, grid, stream);
        else for (int e = 0; e < NE; ++e) {
            const size_t wo = ((size_t)l * NE + e) * D * FF;
            hipLaunchKernelGGL((naive_gemm<RowList, NEpiGate>), dim3(8, 256), dim3(256), 0, stream, HB, D, RowList{cnts + e, LIST + e * 16384}, p.in[I_WEG] + wo, FF, D, FF, (const float*)nullptr, NEpiGate{HC, RowCompact{cnts, e}});
            hipLaunchKernelGGL((naive_gemm<RowList, NEpiUp>), dim3(8, 256), dim3(256), 0, stream, HB, D, RowList{cnts + e, LIST + e * 16384}, p.in[I_WEU] + wo, FF, D, FF, (const float*)nullptr, NEpiUp{HC, RowCompact{cnts, e}});
        }
        if (HM & HV_DOWN) launch_mega(p, base + 8, base + 9, HM, grid, stream);
        else for (int e = 0; e < NE; ++e) {
            const size_t wo = ((size_t)l * NE + e) * D * FF;
            hipLaunchKernelGGL((naive_gemm<RowCompact, NEpiDown>), dim3(16, 256), dim3(256), 0, stream, HC, FF, RowCompact{cnts, e}, p.in[I_WED] + wo, D, FF, D, (const float*)nullptr, NEpiDown{OS, LIST + e * 16384});
        }
    }
    launch_mega(p, 19, 20, 0, grid, stream);
}
```

```cpp
#include <hip/hip_runtime.h>
#include <cstdio>
#include <cstdint>

constexpr int T = 16384, D = 1024, NB = 4, S = 4096, NL = 2;
constexpr int YP = 3840;
constexpr int C_DQ = 0, C_DK = 512, C_DV = 1024, C_CQ = 1536, C_CK = 2048, C_CV = 2560, C_MQ = 3072, C_CKV = 3456, C_KR = 3712, C_G = 3840;
constexpr int INW = 6816;
constexpr float EPS = 1e-6f;
constexpr int NE = 16, FF = 512;
constexpr int HC_ROWS = 36864;

constexpr size_t MiB = 1u << 20;
constexpr size_t WS_CTL = 0, CTL_BYTES = 128 * 1024;
constexpr size_t WS_MODP = 1 * MiB;
constexpr size_t WS_MOD = 4 * MiB;
constexpr size_t WS_SSQ = 4 * MiB + 512 * 1024;
constexpr size_t WS_TOKW = 6 * MiB;
constexpr size_t WS_ROPE = 6 * MiB + 512 * 1024;
constexpr size_t WS_LIST = 7 * MiB;
constexpr size_t WS_WIN = 8 * MiB;
constexpr size_t WS_WQ = 22 * MiB;
constexpr size_t WS_WKV = 23 * MiB;
constexpr size_t WS_WBR = 24 * MiB;
constexpr size_t WS_WOUT = 27 * MiB;
constexpr size_t WS_WGU = 30 * MiB;
constexpr size_t WS_WD = 62 * MiB;
constexpr size_t WS_HB = 78 * MiB;
constexpr size_t WS_KM = 110 * MiB;
constexpr size_t WS_VM = 134 * MiB;
constexpr size_t WS_Y = 150 * MiB;
constexpr size_t WS_G = 270 * MiB;
constexpr size_t WS_QM = 318 * MiB;
constexpr size_t WS_HC = 150 * MiB;
constexpr size_t WS_OS = 186 * MiB;
constexpr size_t WS_END = 366 * MiB;
constexpr int CW_CNT = 64;
constexpr int CW_LAM = 256;
constexpr int CW_CMAX = 16384;
constexpr int CW_MLAP = 1024;
constexpr int CW_Q = 512;
constexpr int CW_GUD = 2048;
constexpr int CW_BRO = 2560;
constexpr int CW_OUT = 2816;
constexpr int CW_INQ = 3072;
constexpr int CW_BAR = 4096;

typedef unsigned short bf16_t;
typedef float f32x4 __attribute__((ext_vector_type(4)));
typedef float f32x2 __attribute__((ext_vector_type(2)));
typedef unsigned u32x4 __attribute__((ext_vector_type(4)));
typedef unsigned u32x2 __attribute__((ext_vector_type(2)));
#define LAS __attribute__((address_space(3)))
#define GAS __attribute__((address_space(1)))
typedef GAS unsigned char* gptr;
#define INP(i) ((const GAS float*)p.in[i])

__device__ __forceinline__ unsigned f2bf(float f) { unsigned u = __builtin_bit_cast(unsigned, f); return (u + 0x7fffu + ((u >> 16) & 1u)) >> 16; }
__device__ __forceinline__ float bf2f(unsigned h) { return __builtin_bit_cast(float, (h & 0xffffu) << 16); }
__device__ __forceinline__ float bflo(unsigned w) { return __builtin_bit_cast(float, w << 16); }
__device__ __forceinline__ float bfhi(unsigned w) { return __builtin_bit_cast(float, w & 0xffff0000u); }
__device__ __forceinline__ unsigned pk2(float lo, float hi) { return f2bf(lo) | (f2bf(hi) << 16); }
typedef _Float16 h16x2 __attribute__((ext_vector_type(2)));
__device__ __forceinline__ unsigned pkh(float lo, float hi) { h16x2 h; h.x = (_Float16)lo; h.y = (_Float16)hi; return __builtin_bit_cast(unsigned, h); }
__device__ __forceinline__ float hlo(unsigned w) { return (float)__builtin_bit_cast(h16x2, w).x; }
__device__ __forceinline__ float hhi(unsigned w) { return (float)__builtin_bit_cast(h16x2, w).y; }
__device__ __forceinline__ float wave_sum(float v) {
#pragma unroll
    for (int o = 1; o < 64; o <<= 1) v += __shfl_xor(v, o);
    return v;
}
__device__ __forceinline__ float wave_max(float v) {
#pragma unroll
    for (int o = 1; o < 64; o <<= 1) v = fmaxf(v, __shfl_xor(v, o));
    return v;
}
__device__ __forceinline__ float sigmoidf_(float x) { return 1.f / (1.f + __expf(-x)); }

__device__ __forceinline__ int ltid() { int t = threadIdx.x; asm volatile("" : "+v"(t)); return t; }
__device__ __forceinline__ int lsg(int v) { asm volatile("" : "+s"(v)); return v; }
struct P {
    const float* in[27];
    float* out;
    unsigned char* ws;
    int ph_lo, ph_hi, heavy, pad;
};
enum { I_X = 0, I_C, I_WMOD, I_BMOD, I_GMIX, I_GFFN, I_WIN, I_LQ1, I_LK1, I_LQ2, I_LK2, I_SUBLN, I_REL, I_QNG, I_WQB, I_KVNG, I_WKVB, I_WBD, I_WBC, I_WBM, I_WOUT, I_WR, I_RB, I_WEG, I_WEU, I_WED, I_GF };

__device__ __forceinline__ void ph0(const P& p, gptr ws, LAS unsigned char* lds, int vb, int nvb) {
    const int tid = ltid(), lane = tid & 63, wave = tid >> 6;
    LAS float* cact = (LAS float*)lds;
    for (int i = tid; i < 4096; i += 512) { const float c = INP(I_C)[i]; cact[i] = c / (1.f + expf(-c)); }
    __syncthreads();
    GAS float* modp = (GAS float*)(ws + WS_MODP);
    const int gw = vb * 8 + wave, NGW = nvb * 8;
    for (int task = gw; task < 1536; task += NGW) {
        const int l = task / 768, r = task % 768, kc = r / 48, jg = r % 48;
        const GAS float* w = INP(I_WMOD) + (size_t)l * 1024 * 6144 + (size_t)(kc * 64) * 6144 + jg * 128 + lane * 2;
        f32x2 acc[4] = {{0.f, 0.f}, {0.f, 0.f}, {0.f, 0.f}, {0.f, 0.f}};
#pragma unroll 32
        for (int k = 0; k < 64; ++k) {
            const f32x2 v = *(const GAS f32x2*)(w + (size_t)k * 6144);
#pragma unroll
            for (int b = 0; b < 4; ++b) { const float c = cact[b * 1024 + kc * 64 + k]; acc[b] += c * v; }
        }
#pragma unroll
        for (int b = 0; b < 4; ++b) *(GAS f32x2*)(modp + ((size_t)((kc * 2 + l) * 4 + b)) * 6144 + jg * 128 + lane * 2) = acc[b];
    }
    GAS float* rope = (GAS float*)(ws + WS_ROPE);
    for (int i = vb * 512 + tid; i < S * 16; i += nvb * 512) {
        const int pos = i >> 4, f = i & 15;
        const float invf = exp2f(-(float)f * (13.287712379549449f / 16.f));
        const float ang = (float)pos * invf;
        const float n = rintf(ang * 0.15915494309189535f);
        float r = fmaf(-n, 6.2831854820251465f, ang); r = fmaf(-n, -1.7484555e-7f, r);
        rope[2 * i] = cosf(r); rope[2 * i + 1] = sinf(r);
    }
    if (vb == 0 && wave == 0) {
        for (int l = 0; l < NL; ++l) {
            const float a = wave_sum(INP(I_LQ1)[l * 64 + lane] * INP(I_LK1)[l * 64 + lane]);
            const float b = wave_sum(INP(I_LQ2)[l * 64 + lane] * INP(I_LK2)[l * 64 + lane]);
            const float lam_init = 0.8f - 0.6f * expf(-0.3f * (float)l);
            if (lane == 0) ((GAS float*)(ws + WS_CTL))[CW_LAM + l] = expf(a) - expf(b) + lam_init;
        }
    }
}

template <int layer>
__device__ __forceinline__ void ph_norm1(const P& p, gptr ws, LAS unsigned char* lds, int vb, int nvb) {
    const int tid = ltid(), lane = tid & 63, wave = tid >> 6;
    LAS float* vec = (LAS float*)lds;
    const GAS float* modp = (const GAS float*)(ws + WS_MODP);
    GAS float* mod = (GAS float*)(ws + WS_MOD);
    const GAS float* tokw = (const GAS float*)(ws + WS_TOKW);
    const GAS bf16_t* os = (const GAS bf16_t*)(ws + WS_OS);
    GAS bf16_t* hb = (GAS bf16_t*)(ws + WS_HB);
    constexpr int RB = (layer == 0) ? 4 : 2;
    for (int ci = vb; ci < 256; ci += nvb) {
        const int b = ci >> 6;
        __syncthreads();
        for (int j = tid; j < 1024; j += 512) {
            if (layer < 2) {
                float sc, sh;
                if (layer == 0) {
                    sc = INP(I_BMOD)[1024 + j]; sh = INP(I_BMOD)[j];
                    for (int kc = 0; kc < 16; ++kc) { const GAS float* q = modp + ((size_t)((kc * 2 + 0) * 4 + b)) * 6144; sc += q[1024 + j]; sh += q[j]; }
                } else { sc = mod[(size_t)(4 + b) * 6144 + 1024 + j]; sh = mod[(size_t)(4 + b) * 6144 + j]; }
                vec[j] = INP(I_GMIX)[(layer < 2 ? layer : 0) * 1024 + j] * (1.f + sc); vec[1024 + j] = sh;
            } else { vec[j] = INP(I_GF)[j]; vec[1024 + j] = 0.f; }
            if (layer > 0) vec[2048 + j] = mod[(size_t)((layer > 0 ? layer - 1 : 0) * 4 + b) * 6144 + 5120 + j];
        }
        __syncthreads();
        for (int rr0 = 0; rr0 < 8; rr0 += RB) {
            f32x4 v[RB][4]; u32x2 oa[RB][4], oc[RB][4]; float w0[RB], w1[RB];
#pragma unroll
            for (int q = 0; q < RB; ++q) { const int row = ci * 64 + wave * 8 + rr0 + q;
                if (layer == 0) { const GAS float* xr = INP(I_X) + (size_t)row * D;
#pragma unroll
                    for (int j = 0; j < 4; ++j) v[q][j] = *(const GAS f32x4*)(xr + 4 * lane + 256 * j);
                } else { const GAS bf16_t* xr = (layer == 1 ? (const GAS bf16_t*)p.out : (const GAS bf16_t*)(ws + WS_KM)) + (size_t)row * D;
#pragma unroll
                    for (int j = 0; j < 4; ++j) { const u32x2 w = *(const GAS u32x2*)(xr + 4 * lane + 256 * j); v[q][j] = (f32x4){hlo(w.x), hhi(w.x), hlo(w.y), hhi(w.y)}; } }
                if (layer > 0) { w0[q] = tokw[row * 2]; w1[q] = tokw[row * 2 + 1];
#pragma unroll
                    for (int j = 0; j < 4; ++j) { oa[q][j] = *(const GAS u32x2*)(os + (size_t)(row * 2) * D + 4 * lane + 256 * j); oc[q][j] = *(const GAS u32x2*)(os + (size_t)(row * 2 + 1) * D + 4 * lane + 256 * j); } } }
#pragma unroll
            for (int q = 0; q < RB; ++q) { const int row = ci * 64 + wave * 8 + rr0 + q;
                if (layer > 0) {
#pragma unroll
                    for (int j = 0; j < 4; ++j) { const u32x2 a = oa[q][j], c = oc[q][j];
                        const f32x4 g = *(const LAS f32x4*)(vec + 2048 + 4 * lane + 256 * j);
                        v[q][j].x += g.x * (w0[q] * bflo(a.x) + w1[q] * bflo(c.x)); v[q][j].y += g.y * (w0[q] * bfhi(a.x) + w1[q] * bfhi(c.x));
                        v[q][j].z += g.z * (w0[q] * bflo(a.y) + w1[q] * bflo(c.y)); v[q][j].w += g.w * (w0[q] * bfhi(a.y) + w1[q] * bfhi(c.y)); }
                    if (layer < 2) {
#pragma unroll
                        for (int j = 0; j < 4; ++j) { u32x2 o; o.x = pkh(v[q][j].x, v[q][j].y); o.y = pkh(v[q][j].z, v[q][j].w); *(GAS u32x2*)(((GAS bf16_t*)p.out) + (size_t)row * D + 4 * lane + 256 * j) = o;
                            v[q][j] = (f32x4){hlo(o.x), hhi(o.x), hlo(o.y), hhi(o.y)}; }
                    }
                }
                float s = 0.f;
#pragma unroll
                for (int j = 0; j < 4; ++j) s += (v[q][j].x * v[q][j].x + v[q][j].y * v[q][j].y) + (v[q][j].z * v[q][j].z + v[q][j].w * v[q][j].w);
                const float rstd = rsqrtf(wave_sum(s) * (1.f / D) + EPS);
#pragma unroll
                for (int j = 0; j < 4; ++j) {
                    const f32x4 g = *(const LAS f32x4*)(vec + 4 * lane + 256 * j), sh = *(const LAS f32x4*)(vec + 1024 + 4 * lane + 256 * j);
                    const f32x4 y = v[q][j] * rstd * g + sh;
                    if (layer < 2) { u32x2 o; o.x = pk2(y.x, y.y); o.y = pk2(y.z, y.w); *(GAS u32x2*)(hb + (size_t)row * D + 4 * lane + 256 * j) = o; }
                    else *(GAS f32x4*)(((GAS float*)p.out) + (size_t)row * D + 4 * lane + 256 * j) = y;
                }
            }
        }
    }
    if (layer == 0) {
        for (int o = vb * 512 + tid; o < NL * 4 * 6144; o += nvb * 512) {
            const int l = o / (4 * 6144), r = o % (4 * 6144), b = r / 6144, j = r % 6144;
            float s = INP(I_BMOD)[l * 6144 + j];
            for (int kc = 0; kc < 16; ++kc) s += modp[((size_t)((kc * 2 + l) * 4 + b)) * 6144 + j];
            mod[o] = s;
        }
    }
}

__device__ __forceinline__ void ph_krope(const P& p, gptr ws, int vb, int nvb) {
    const GAS bf16_t* Y = (const GAS bf16_t*)(ws + WS_Y);
    GAS bf16_t* Km = (GAS bf16_t*)(ws + WS_KM);
    const GAS float* rope = (const GAS float*)(ws + WS_ROPE);
    const int tid = ltid();
    for (int i = vb * 512 + tid; i < T * 16; i += nvb * 512) {
        const int t = i >> 4, f = i & 15, pos = t & (S - 1);
        const float x1 = bf2f(Y[(size_t)t * YP + C_KR + f]), x2 = bf2f(Y[(size_t)t * YP + C_KR + 16 + f]);
        const float c = rope[(pos * 16 + f) * 2], s = rope[(pos * 16 + f) * 2 + 1];
        const bf16_t o1 = (bf16_t)f2bf(x1 * c - x2 * s), o2 = (bf16_t)f2bf(x1 * s + x2 * c);
#pragma unroll
        for (int h = 0; h < 8; ++h) { Km[(size_t)t * 768 + h * 96 + 64 + f] = o1; Km[(size_t)t * 768 + h * 96 + 80 + f] = o2; }
    }
}

__device__ __forceinline__ void ph_router(const P& p, gptr ws, LAS unsigned char* lds, int vb, int nvb, int layer, const GAS unsigned* dep) {
    const int tid = ltid(), lane = tid & 63, wave = tid >> 6;
    LAS float* wsw = (LAS float*)lds;
    LAS float* vec = (LAS float*)(lds + 65536);
    LAS int* lcnt = (LAS int*)(lds + 65536 + 8192);
    LAS int* rinfo = (LAS int*)(lds + 65536 + 8192 + 128);
    LAS float* rstd_l = (LAS float*)(lds + 65536 + 8192 + 2048);
    LAS float* lg = (LAS float*)(lds + 65536 + 8192 + 4096);
    const GAS float* mod = (const GAS float*)(ws + WS_MOD);
    GAS bf16_t* hb = (GAS bf16_t*)(ws + WS_HB);
    GAS float* tokw = (GAS float*)(ws + WS_TOKW);
    GAS int* list = (GAS int*)(ws + WS_LIST);
    GAS unsigned* cnt = (GAS unsigned*)(ws + WS_CTL) + CW_CNT + 64 * layer;
    const GAS bf16_t* xres = layer == 0 ? (const GAS bf16_t*)p.out : (const GAS bf16_t*)(ws + WS_KM);
    for (int i = tid; i < 16384; i += 512) { const int k = i >> 4, e = i & 15; wsw[((k >> 4) * 4 + ((k >> 2) & 3)) * 64 + e * 4 + (k & 3)] = INP(I_WR)[i]; }
    float rb[16];
#pragma unroll
    for (int e = 0; e < 16; ++e) rb[e] = INP(I_RB)[e];
    for (int ci = vb; ci < 256; ci += nvb) {
        const int b = ci >> 6;
        if (tid < 64) {
            if (tid == 0) { unsigned sp = 0; while (__hip_atomic_load((GAS unsigned*)dep + (ci >> 2), __ATOMIC_RELAXED, __HIP_MEMORY_SCOPE_AGENT) < 4u) { __builtin_amdgcn_s_sleep(2); if (++sp > (1u << 22)) break; } }
            __builtin_amdgcn_fence(__ATOMIC_ACQUIRE, "agent"); asm volatile("s_waitcnt vmcnt(0)" ::: "memory");
        }
        __syncthreads();
        for (int j = tid; j < 1024; j += 512) {
            vec[j] = INP(I_GFFN)[layer * 1024 + j] * (1.f + mod[(size_t)(layer * 4 + b) * 6144 + 4096 + j]);
            vec[1024 + j] = mod[(size_t)(layer * 4 + b) * 6144 + 3072 + j];
        }
        if (tid < 16) lcnt[tid] = 0;
#pragma unroll
        for (int r0 = 0; r0 < 8; r0 += 4) { f32x4 v[4][4];
#pragma unroll
            for (int q = 0; q < 4; ++q) { const GAS bf16_t* xr = xres + (size_t)(ci * 64 + wave * 8 + r0 + q) * D;
#pragma unroll
                for (int j = 0; j < 4; ++j) { const u32x2 w = *(const GAS u32x2*)(xr + 4 * lane + 256 * j); v[q][j] = (f32x4){hlo(w.x), hhi(w.x), hlo(w.y), hhi(w.y)}; } }
#pragma unroll
            for (int q = 0; q < 4; ++q) { float s = 0.f;
#pragma unroll
                for (int j = 0; j < 4; ++j) s += (v[q][j].x * v[q][j].x + v[q][j].y * v[q][j].y) + (v[q][j].z * v[q][j].z + v[q][j].w * v[q][j].w);
                s = wave_sum(s); if (lane == 0) rstd_l[wave * 8 + r0 + q] = rsqrtf(s * (1.f / D) + EPS); } }
        __syncthreads();
        { const int gI = wave & 3, hI = wave >> 2, r = lane & 15, kq = lane >> 4, row = ci * 64 + gI * 16 + r;
          const float rs = rstd_l[gI * 16 + r];
          const GAS bf16_t* xr = xres + (size_t)row * D + 4 * kq;
          GAS bf16_t* hr = hb + (size_t)row * D + 4 * kq;
          f32x4 acc = {0.f, 0.f, 0.f, 0.f};
#pragma unroll 8
          for (int jj = 0; jj < 32; ++jj) { const int j = hI * 32 + jj;
              const u32x2 xw = *(const GAS u32x2*)(xr + 16 * j); const f32x4 x4 = {hlo(xw.x), hhi(xw.x), hlo(xw.y), hhi(xw.y)};
              const f32x4 gv = *(const LAS f32x4*)(vec + 16 * j + 4 * kq), sv = *(const LAS f32x4*)(vec + 1024 + 16 * j + 4 * kq);
              const f32x4 w4 = *(const LAS f32x4*)(wsw + (j * 4 + kq) * 64 + r * 4);
              const f32x4 y = x4 * rs * gv + sv;
              u32x2 o; o.x = pk2(y.x, y.y); o.y = pk2(y.z, y.w); *(GAS u32x2*)(hr + 16 * j) = o;
              acc = __builtin_amdgcn_mfma_f32_16x16x4f32(y.x, w4.x, acc, 0, 0, 0); acc = __builtin_amdgcn_mfma_f32_16x16x4f32(y.y, w4.y, acc, 0, 0, 0);
              acc = __builtin_amdgcn_mfma_f32_16x16x4f32(y.z, w4.z, acc, 0, 0, 0); acc = __builtin_amdgcn_mfma_f32_16x16x4f32(y.w, w4.w, acc, 0, 0, 0); }
#pragma unroll
          for (int g = 0; g < 4; ++g) lg[((gI * 2 + hI) * 16 + 4 * kq + g) * 16 + r] = acc[g]; }
        __syncthreads();
        if (wave == 0) {
            const int lr = lane, gI = lr >> 4, r = lr & 15, row = ci * 64 + lr;
            float sc[16], sel[16];
#pragma unroll
            for (int e4 = 0; e4 < 4; ++e4) { const f32x4 a0 = *(const LAS f32x4*)(lg + ((gI * 2 + 0) * 16 + r) * 16 + 4 * e4), a1 = *(const LAS f32x4*)(lg + ((gI * 2 + 1) * 16 + r) * 16 + 4 * e4);
#pragma unroll
                for (int i = 0; i < 4; ++i) { const float lgt = a0[i] + a1[i]; sc[4 * e4 + i] = 1.f / (1.f + expf(-lgt)); sel[4 * e4 + i] = sc[4 * e4 + i] + rb[4 * e4 + i]; } }
            float gs[4];
#pragma unroll
            for (int g = 0; g < 4; ++g) {
                const float a = sel[4 * g], bq = sel[4 * g + 1], c = sel[4 * g + 2], d = sel[4 * g + 3];
                const float m1 = fmaxf(fmaxf(a, bq), fmaxf(c, d));
                const float m2 = fmaxf(fmaxf(fminf(a, bq), fminf(c, d)), fminf(fmaxf(a, bq), fmaxf(c, d)));
                gs[g] = m1 + m2;
            }
            int bg = 0; float bgs = gs[0];
#pragma unroll
            for (int g = 1; g < 4; ++g) if (gs[g] > bgs) { bgs = gs[g]; bg = g; }
            float s4[4], c4[4];
#pragma unroll
            for (int i = 0; i < 4; ++i) { s4[i] = bg == 0 ? sel[i] : bg == 1 ? sel[4 + i] : bg == 2 ? sel[8 + i] : sel[12 + i]; c4[i] = bg == 0 ? sc[i] : bg == 1 ? sc[4 + i] : bg == 2 ? sc[8 + i] : sc[12 + i]; }
            int i0 = 0; float b0 = s4[0];
#pragma unroll
            for (int i = 1; i < 4; ++i) if (s4[i] > b0) { b0 = s4[i]; i0 = i; }
            int i1 = -1; float b1 = -INFINITY;
#pragma unroll
            for (int i = 0; i < 4; ++i) if (i != i0 && s4[i] > b1) { b1 = s4[i]; i1 = i; }
            const float w0 = i0 == 0 ? c4[0] : i0 == 1 ? c4[1] : i0 == 2 ? c4[2] : c4[3];
            const float w1 = i1 == 0 ? c4[0] : i1 == 1 ? c4[1] : i1 == 2 ? c4[2] : c4[3];
            const float inv = 1.f / (w0 + w1);
            const int e0 = bg * 4 + i0, e1 = bg * 4 + i1;
            const int p0 = __hip_atomic_fetch_add(&lcnt[e0], 1, __ATOMIC_RELAXED, __HIP_MEMORY_SCOPE_WORKGROUP), p1 = __hip_atomic_fetch_add(&lcnt[e1], 1, __ATOMIC_RELAXED, __HIP_MEMORY_SCOPE_WORKGROUP);
            rinfo[lr * 4 + 0] = e0; rinfo[lr * 4 + 1] = e1; rinfo[lr * 4 + 2] = p0; rinfo[lr * 4 + 3] = p1;
            *(GAS f32x2*)(tokw + row * 2) = (f32x2){w0 * inv, w1 * inv};
        }
        __syncthreads();
        if (tid < 16) lcnt[16 + tid] = (int)__hip_atomic_fetch_add(cnt + tid, (unsigned)lcnt[tid], __ATOMIC_RELAXED, __HIP_MEMORY_SCOPE_AGENT);
        __syncthreads();
        if (tid < 128) {
            const int lr = tid >> 1, sl = tid & 1, e = rinfo[lr * 4 + sl], pos = rinfo[lr * 4 + 2 + sl];
            list[e * 16384 + lcnt[16 + e] + pos] = (ci * 64 + lr) * 2 + sl;
        }
    }
}


namespace pg8 {
typedef short bf16x8 __attribute__((ext_vector_type(8)));
constexpr int BM = 256, BK = 64, HALF = 128, HTB = HALF * BK * 2, STAGE_BYTES = 8 * HTB, NXCD = 8, WGM = 8;
__host__ __device__ __forceinline__ int lds_byte(int r, int c) { const int st = (r >> 4) * 2 + (c >> 5), rr = r & 15, cc = c & 31, ob = rr * 64 + cc * 2; return st * 1024 + (ob ^ (((ob >> 9) & 1) << 5)); }
__host__ __device__ __forceinline__ void stage_rc(int b, int& R, int& C) { const int st = b / 1024, sb = b % 1024, swz = sb ^ (((sb >> 9) & 1) << 5); R = (st >> 1) * 16 + swz / 64; C = (st & 1) * 32 + (swz % 64) / 2; }
__host__ __device__ __forceinline__ int perm32(int rho) { const int n = rho >> 4, i = rho & 15; return 8 * (i >> 2) + 4 * n + (i & 3); }
struct Unit { int pm, pn, x0, x1, x2; };
__device__ __forceinline__ void tile_of(int L, int nM, int nN, int& pm, int& pn) {
    const int nwg = nM * nN; int wgid = L;
    { const int q = nwg / NXCD, r = nwg % NXCD, xcd = wgid % NXCD, off = wgid / NXCD; wgid = (xcd < r ? xcd * (q + 1) : r * (q + 1) + (xcd - r) * q) + off; }
    const int nig = WGM * nN, gid = wgid / nig, fm = gid * WGM, gsz = (nM - fm) < WGM ? (nM - fm) : WGM;
    pm = fm + ((wgid % nig) % gsz); pn = (wgid % nig) / gsz;
}
__device__ __forceinline__ unsigned cvt_pk_bf16(float lo, float hi) { unsigned r; asm volatile("v_cvt_pk_bf16_f32 %0, %1, %2" : "=v"(r) : "v"(lo), "v"(hi)); return r; }

template <class Epi, class Sched, bool ALIGN_EPI>
__device__ __forceinline__ void gemm_phase(LAS unsigned char* lds, const int Kc, const Sched& S, const Epi& E) {
    const int K = lsg(Kc);
    constexpr bool GA = Sched::GATHER;
    const int tid = ltid(), wid = __builtin_amdgcn_readfirstlane(tid >> 6), lane = tid & 63, wr = wid >> 2, wc = wid & 3, fr = lane & 15, fq = lane >> 4;
    const int nt = K / BK;
    unsigned voffB[2], voffA[2];
#pragma unroll
    for (int i = 0; i < 2; ++i) { int R, C; stage_rc(tid * 16 + i * 8192, R, C); const int Rb = Epi::PERM ? ((R & ~31) + perm32(R & 31)) : R; voffB[i] = (unsigned)(Rb * K + C) * 2u; voffA[i] = S.a_lane(R, C); }
    const size_t kstep = (size_t)(BK * 2);
    const size_t hstepB = (size_t)HALF * K * 2;
    const unsigned ldsw = (unsigned)wid * 1024u;
    const int aoff = lds_byte(wr * 64 + fr, fq * 8), boff = lds_byte(wc * 32 + fr, fq * 8);
#define PG8_SA(b, h) (((b) * 2 + (h)) * HTB)
#define PG8_SB(b, h) ((4 + (b) * 2 + (h)) * HTB)
#define PG8_STAGE(bufoff, gbase, voff) do { _Pragma("unroll") for (int _i = 0; _i < 2; ++_i) \
        __builtin_amdgcn_global_load_lds((const GAS unsigned*)((const GAS char*)(gbase) + (voff)[_i]), (LAS unsigned*)(lds + (bufoff) + ldsw + _i * 8192), 16, 0, 0); } while (0)
#define PG8_LDA(dst, b, h) do { _Pragma("unroll") for (int m = 0; m < 4; ++m) _Pragma("unroll") for (int k = 0; k < 2; ++k) dst[m][k] = *(const LAS bf16x8*)(lds + PG8_SA(b, h) + aoff + m * 2048 + k * 1024); } while (0)
#define PG8_LDB(dst, b, h) do { _Pragma("unroll") for (int n = 0; n < 2; ++n) _Pragma("unroll") for (int k = 0; k < 2; ++k) dst[n][k] = *(const LAS bf16x8*)(lds + PG8_SB(b, h) + boff + n * 2048 + k * 1024); } while (0)
#define PG8_MMA(ai, bj, At, Bt) do { __builtin_amdgcn_s_setprio(1); _Pragma("unroll") for (int m = 0; m < 4; ++m) _Pragma("unroll") for (int n = 0; n < 2; ++n) _Pragma("unroll") for (int k = 0; k < 2; ++k) \
        acc[ai][bj][m][n] = __builtin_amdgcn_mfma_f32_16x16x32_bf16(Bt[n][k], At[m][k], acc[ai][bj][m][n], 0, 0, 0); __builtin_amdgcn_s_setprio(0); } while (0)
#define PG8_WAIT_V(n) asm volatile("s_waitcnt vmcnt(" #n ")" ::: "memory")
#define PG8_WAIT_L(n) asm volatile("s_waitcnt lgkmcnt(" #n ")" ::: "memory")
#define PG8_BAR __builtin_amdgcn_s_barrier()
#define PG8_SCHED __builtin_amdgcn_sched_barrier(0)
    Unit cur, nxt; int ui = 0;
    if (!S.next(0, cur)) return;
    f32x4 acc[2][2][4][2];
#pragma unroll
    for (int a = 0; a < 2; ++a)
#pragma unroll
        for (int b = 0; b < 2; ++b)
#pragma unroll
            for (int m = 0; m < 4; ++m)
#pragma unroll
                for (int n = 0; n < 2; ++n) { asm volatile("v_mov_b32 %0, 0" : "=v"(acc[a][b][m][n][0])); asm volatile("v_mov_b32 %0, 0" : "=v"(acc[a][b][m][n][1])); asm volatile("v_mov_b32 %0, 0" : "=v"(acc[a][b][m][n][2])); asm volatile("v_mov_b32 %0, 0" : "=v"(acc[a][b][m][n][3])); }
    bf16x8 At[4][2], B0[2][2], B1[2][2];
    const GAS char* cA0 = S.a_base(cur, 0); const GAS char* cA1 = S.a_base(cur, 1); const GAS char* cB = S.b_base(cur);
    unsigned cO[2][2];
    if constexpr (GA) S.a_offs(cur, cO); else { cO[0][0] = voffA[0]; cO[0][1] = voffA[1]; cO[1][0] = voffA[0]; cO[1][1] = voffA[1]; }
    if constexpr (Sched::DEPS) S.wait_ready(cur, true);
    PG8_STAGE(PG8_SB(0, 0), cB, voffB); PG8_STAGE(PG8_SB(0, 1), cB + hstepB, voffB); PG8_STAGE(PG8_SA(0, 0), cA0, cO[0]); PG8_STAGE(PG8_SA(0, 1), cA1, cO[1]);
    if (wr == 1) PG8_BAR;
    PG8_WAIT_V(2); PG8_BAR;
    PG8_STAGE(PG8_SB(1, 0), cB + kstep, voffB); PG8_STAGE(PG8_SA(1, 0), cA0 + kstep, cO[0]); PG8_STAGE(PG8_SB(1, 1), cB + hstepB + kstep, voffB);
    PG8_WAIT_V(6); PG8_BAR;
    for (;;) {
        const bool has_next = S.next(ui + 1, nxt);
        if constexpr (Sched::DEPS) { if (has_next) S.wait_ready(nxt, false); }
        const GAS char* nA0 = has_next ? S.a_base(nxt, 0) : cA0; const GAS char* nA1 = has_next ? S.a_base(nxt, 1) : cA1; const GAS char* nB = has_next ? S.b_base(nxt) : cB;
        unsigned nO[2][2];
        if constexpr (GA) { if (has_next) S.a_offs(nxt, nO); else { nO[0][0] = cO[0][0]; nO[0][1] = cO[0][1]; nO[1][0] = cO[1][0]; nO[1][1] = cO[1][1]; } }
        for (int t = 0; t < nt; t += 2) {
            const bool last = (t == nt - 2);
            const GAS char* a1 = cA1 + (size_t)(t + 1) * kstep;
            const GAS char* a20 = last ? nA0 : cA0 + (size_t)(t + 2) * kstep; const GAS char* a21 = last ? nA1 : cA1 + (size_t)(t + 2) * kstep; const GAS char* b2 = last ? nB : cB + (size_t)(t + 2) * kstep;
            const GAS char* a30 = a20 + kstep; const GAS char* b3 = b2 + kstep;
            unsigned o2[2][2];
            if constexpr (GA) { o2[0][0] = last ? nO[0][0] : cO[0][0]; o2[0][1] = last ? nO[0][1] : cO[0][1]; o2[1][0] = last ? nO[1][0] : cO[1][0]; o2[1][1] = last ? nO[1][1] : cO[1][1]; }
            else { o2[0][0] = voffA[0]; o2[0][1] = voffA[1]; o2[1][0] = voffA[0]; o2[1][1] = voffA[1]; }
            PG8_LDB(B0, 0, 0); PG8_LDB(B1, 0, 1); PG8_SCHED; PG8_LDA(At, 0, 0); PG8_STAGE(PG8_SA(1, 1), a1, cO[1]);
            PG8_WAIT_V(8); PG8_WAIT_L(0); PG8_BAR; PG8_MMA(0, 0, At, B0); PG8_MMA(0, 1, At, B1); PG8_BAR; PG8_SCHED;
            PG8_LDA(At, 0, 1); PG8_STAGE(PG8_SB(0, 0), b2, voffB); PG8_STAGE(PG8_SB(0, 1), b2 + hstepB, voffB); PG8_STAGE(PG8_SA(0, 0), a20, o2[0]);
            PG8_WAIT_V(8); PG8_WAIT_L(0); PG8_BAR; PG8_MMA(1, 0, At, B0); PG8_MMA(1, 1, At, B1); PG8_BAR; PG8_SCHED;
            PG8_LDB(B0, 1, 0); PG8_LDB(B1, 1, 1); PG8_SCHED; PG8_LDA(At, 1, 0); PG8_STAGE(PG8_SA(0, 1), a21, o2[1]);
            PG8_WAIT_V(8); PG8_WAIT_L(0); PG8_BAR; PG8_MMA(0, 0, At, B0); PG8_MMA(0, 1, At, B1); PG8_BAR; PG8_SCHED;
            PG8_LDA(At, 1, 1); PG8_STAGE(PG8_SB(1, 0), b3, voffB); PG8_STAGE(PG8_SB(1, 1), b3 + hstepB, voffB); PG8_STAGE(PG8_SA(1, 0), a30, o2[0]);
            PG8_WAIT_V(8); PG8_WAIT_L(0); PG8_BAR; PG8_MMA(1, 0, At, B0); PG8_MMA(1, 1, At, B1); PG8_BAR; PG8_SCHED;
        }
        if constexpr (ALIGN_EPI) { if (wr == 0) PG8_BAR; }
        E(acc, cur, wr, wc, fr, fq);
        if constexpr (Epi::PUBLISH) { if (E.pub(cur)) { asm volatile("s_waitcnt vmcnt(0)" ::: "memory"); PG8_BAR; asm volatile("" ::: "memory"); E.publish(cur, tid); } }
        if (!has_next) break;
        if (!E.keep(cur))
#pragma unroll
        for (int a = 0; a < 2; ++a)
#pragma unroll
            for (int b = 0; b < 2; ++b)
#pragma unroll
                for (int m = 0; m < 4; ++m)
#pragma unroll
                    for (int n = 0; n < 2; ++n) { asm volatile("v_mov_b32 %0, 0" : "=v"(acc[a][b][m][n][0])); asm volatile("v_mov_b32 %0, 0" : "=v"(acc[a][b][m][n][1])); asm volatile("v_mov_b32 %0, 0" : "=v"(acc[a][b][m][n][2])); asm volatile("v_mov_b32 %0, 0" : "=v"(acc[a][b][m][n][3])); }
        cur = nxt; cA0 = nA0; cA1 = nA1; cB = nB; ++ui;
        if constexpr (GA) { cO[0][0] = nO[0][0]; cO[0][1] = nO[0][1]; cO[1][0] = nO[1][0]; cO[1][1] = nO[1][1]; }
        if constexpr (ALIGN_EPI) { if (wr == 1) PG8_BAR; }
    }
    PG8_WAIT_V(0);
    if constexpr (!ALIGN_EPI) { if (wr == 0) PG8_BAR; }
    PG8_BAR;
#undef PG8_SA
#undef PG8_SB
#undef PG8_STAGE
#undef PG8_LDA
#undef PG8_LDB
#undef PG8_MMA
#undef PG8_WAIT_V
#undef PG8_WAIT_L
#undef PG8_BAR
#undef PG8_SCHED
}

struct SchedPlain {
    static constexpr bool GATHER = false, DEPS = false;
    const GAS char* A; const GAS char* Bt; int lda, K, nM, nN, G, c;
    __device__ __forceinline__ bool next(int i, Unit& u) const { const int L = i * G + c; if (L >= nM * nN) return false; tile_of(L, nM, nN, u.pm, u.pn); u.x0 = 0; u.x1 = 0; u.x2 = 0; return true; }
    __device__ __forceinline__ unsigned a_lane(int R, int C) const { return (unsigned)(R * lda + C) * 2u; }
    __device__ __forceinline__ const GAS char* a_base(const Unit& u, int h) const { return A + (size_t)(u.pm * 256 + h * 128) * lda * 2; }
    __device__ __forceinline__ void a_offs(const Unit&, unsigned (&)[2][2]) const {}
    __device__ __forceinline__ const GAS char* b_base(const Unit& u) const { return Bt + (size_t)u.pn * 256 * K * 2; }
};

struct EpiInproj {
    __device__ __forceinline__ bool keep(const Unit&) const { return false; }
    static constexpr bool PERM = true, PUBLISH = true;
    __device__ __forceinline__ bool pub(const Unit& u) const { return u.pn == 12 || u.pn == 13; }
    __device__ __forceinline__ void publish(const Unit& u, int tid) const { if (tid == 0) __hip_atomic_fetch_add(dep + u.pm, 1u, __ATOMIC_RELAXED, __HIP_MEMORY_SCOPE_AGENT); }
    GAS unsigned* dep;
    GAS bf16_t* Y; GAS float* ssq; GAS unsigned* cmax; GAS bf16_t* G;
    __device__ __forceinline__ void operator()(const f32x4 (&acc)[2][2][4][2], const Unit& u, int wr, int wc, int fr, int fq) const {
        const int row0 = u.pm * BM + wr * 64 + fr, col0 = u.pn * BM + wc * 32 + 8 * fq;
        const bool sg = u.pn >= 15, sq = (u.pn >= 12 && u.pn <= 14), wt = (u.pn == 12 || u.pn == 13);
        if (u.pn == 2 || u.pn == 3) {
#pragma unroll
            for (int bj = 0; bj < 2; ++bj) { float cm[8];
#pragma unroll
                for (int e = 0; e < 8; ++e) { float m_ = 0.f;
#pragma unroll
                    for (int ai = 0; ai < 2; ++ai)
#pragma unroll
                        for (int m = 0; m < 4; ++m) m_ = fmaxf(m_, fabsf(acc[ai][bj][m][e >> 2][e & 3]));
#pragma unroll
                    for (int sh = 1; sh < 16; sh <<= 1) m_ = fmaxf(m_, __shfl_xor(m_, sh));
                    cm[e] = m_; }
                if (fr == 0) {
#pragma unroll
                    for (int e = 0; e < 8; ++e) __hip_atomic_fetch_max(cmax + (u.pm >> 4) * 512 + (col0 + bj * HALF - 512) + e, __float_as_uint(cm[e]), __ATOMIC_RELAXED, __HIP_MEMORY_SCOPE_AGENT); } }
        }
#pragma unroll
        for (int ai = 0; ai < 2; ++ai)
#pragma unroll
            for (int m = 0; m < 4; ++m) { const int row = row0 + ai * HALF + m * 16; GAS bf16_t* rowp = Y + (size_t)row * YP + col0;
#pragma unroll
                for (int bj = 0; bj < 2; ++bj) { f32x4 v0 = acc[ai][bj][m][0], v1 = acc[ai][bj][m][1];
                    if (sg) {
#pragma unroll
                        for (int e = 0; e < 4; ++e) { v0[e] = __builtin_amdgcn_rcpf(1.f + __builtin_amdgcn_exp2f(-1.4426950408889634f * v0[e])); v1[e] = __builtin_amdgcn_rcpf(1.f + __builtin_amdgcn_exp2f(-1.4426950408889634f * v1[e])); }
                    }
                    u32x4 w; w.x = cvt_pk_bf16(v0[0], v0[1]); w.y = cvt_pk_bf16(v0[2], v0[3]); w.z = cvt_pk_bf16(v1[0], v1[1]); w.w = cvt_pk_bf16(v1[2], v1[3]);
                    if (sg) {
                        u32x2 q2 = {0u, 0u};
#pragma unroll
                        for (int e = 0; e < 4; ++e) { q2.x = __builtin_amdgcn_cvt_pk_u8_f32(v0[e] * 255.f, e, q2.x); q2.y = __builtin_amdgcn_cvt_pk_u8_f32(v1[e] * 255.f, e, q2.y); }
                        __builtin_nontemporal_store(q2, (GAS u32x2*)((GAS unsigned char*)G + ((size_t)(u.pm * 12 + (u.pn - 15)) * 16 + (ai * 4 + m) * 2 + bj) * 4096 + ((wr * 4 + wc) * 64 + fq * 16 + fr) * 8)); }
                    else if (wt) asm volatile("global_store_dwordx4 %0, %1, off sc1\n\ts_nop 1" :: "v"(rowp + bj * HALF), "v"(w) : "memory");
                    else __builtin_nontemporal_store(w, (GAS u32x4*)(rowp + bj * HALF));
                    if (sq) { float s = (v0[0] * v0[0] + v0[1] * v0[1]) + (v0[2] * v0[2] + v0[3] * v0[3]) + (v1[0] * v1[0] + v1[1] * v1[1]) + (v1[2] * v1[2] + v1[3] * v1[3]);
                        s += __shfl_xor(s, 16); s += __shfl_xor(s, 32);
                        if (fq == 0) { if (wt) __hip_atomic_store(ssq + (size_t)row * 24 + (u.pn - 12) * 8 + bj * 4 + wc, s, __ATOMIC_RELAXED, __HIP_MEMORY_SCOPE_AGENT); else ssq[(size_t)row * 24 + (u.pn - 12) * 8 + bj * 4 + wc] = s; } } } }
    }
};

__device__ __forceinline__ void store16_wt(GAS void* p, u32x4 v) { *(GAS u32x4*)p = v; }
struct EpiMlaQ {
    __device__ __forceinline__ bool keep(const Unit&) const { return false; }
    static constexpr bool PERM = true, PUBLISH = false;
    GAS bf16_t* Qm; const GAS float* ssq;
    __device__ __forceinline__ void operator()(const f32x4 (&acc)[2][2][4][2], const Unit& u, int wr, int wc, int fr, int fq) const {
        const int row0 = u.pm * BM + wr * 64 + fr, col0 = u.pn * BM + wc * 32 + 8 * fq;
        float rs[2][4];
#pragma unroll
        for (int ai = 0; ai < 2; ++ai)
#pragma unroll
            for (int m = 0; m < 4; ++m) { const int row = row0 + ai * HALF + m * 16;
                const f32x4 s0 = *(const GAS f32x4*)(ssq + (size_t)row * 24), s1 = *(const GAS f32x4*)(ssq + (size_t)row * 24 + 4), s2 = *(const GAS f32x4*)(ssq + (size_t)row * 24 + 8);
                const float s = ((s0[0] + s0[1]) + (s0[2] + s0[3])) + ((s1[0] + s1[1]) + (s1[2] + s1[3])) + ((s2[0] + s2[1]) + (s2[2] + s2[3]));
                rs[ai][m] = rsqrtf(s * (1.f / 384.f) + EPS); }
#pragma unroll
        for (int ai = 0; ai < 2; ++ai)
#pragma unroll
            for (int m = 0; m < 4; ++m) { const int row = row0 + ai * HALF + m * 16;
#pragma unroll
                for (int bj = 0; bj < 2; ++bj) { const f32x4 v0 = acc[ai][bj][m][0] * rs[ai][m], v1 = acc[ai][bj][m][1] * rs[ai][m];
                    u32x4 w; w.x = cvt_pk_bf16(v0[0], v0[1]); w.y = cvt_pk_bf16(v0[2], v0[3]); w.z = cvt_pk_bf16(v1[0], v1[1]); w.w = cvt_pk_bf16(v1[2], v1[3]);
                    store16_wt(Qm + (size_t)row * 768 + col0 + bj * HALF, w); } }
    }
};
struct EpiMlaKV {
    __device__ __forceinline__ bool keep(const Unit&) const { return false; }
    static constexpr bool PERM = true, PUBLISH = false;
    GAS bf16_t* Km; GAS bf16_t* Vm; const GAS float* ssq;
    __device__ __forceinline__ void operator()(const f32x4 (&acc)[2][2][4][2], const Unit& u, int wr, int wc, int fr, int fq) const {
        const int row0 = u.pm * BM + wr * 64 + fr, col0 = u.pn * BM + wc * 32 + 8 * fq;
        float rs[2][4];
#pragma unroll
        for (int ai = 0; ai < 2; ++ai)
#pragma unroll
            for (int m = 0; m < 4; ++m) { const int row = row0 + ai * HALF + m * 16;
                const f32x4 s0 = *(const GAS f32x4*)(ssq + (size_t)row * 24 + 12), s1 = *(const GAS f32x4*)(ssq + (size_t)row * 24 + 16);
                const float s = ((s0[0] + s0[1]) + (s0[2] + s0[3])) + ((s1[0] + s1[1]) + (s1[2] + s1[3]));
                rs[ai][m] = rsqrtf(s * (1.f / 256.f) + EPS); }
#pragma unroll
        for (int ai = 0; ai < 2; ++ai)
#pragma unroll
            for (int m = 0; m < 4; ++m) { const int row = row0 + ai * HALF + m * 16;
#pragma unroll
                for (int bj = 0; bj < 2; ++bj) { const f32x4 v0 = acc[ai][bj][m][0] * rs[ai][m], v1 = acc[ai][bj][m][1] * rs[ai][m];
                    u32x4 w; w.x = cvt_pk_bf16(v0[0], v0[1]); w.y = cvt_pk_bf16(v0[2], v0[3]); w.z = cvt_pk_bf16(v1[0], v1[1]); w.w = cvt_pk_bf16(v1[2], v1[3]);
                    const int n = col0 + bj * HALF;
                    GAS bf16_t* dst = n < 512 ? Km + (size_t)row * 768 + (n >> 6) * 96 + (n & 63) : Vm + (size_t)row * 512 + (n - 512);
                    store16_wt(dst, w); } }
    }
};
struct SchedPlainDep {
    static constexpr bool GATHER = false, DEPS = true;
    const GAS char* A; const GAS char* Bt; int lda, K, nM, nN, G, c; const GAS unsigned* dep; int need;
    __device__ __forceinline__ bool next(int i, Unit& u) const { const int L = i * G + c; if (L >= nM * nN) return false; tile_of(L, nM, nN, u.pm, u.pn); u.x0 = 0; u.x1 = 0; u.x2 = 0; return true; }
    __device__ __forceinline__ void wait_ready(const Unit& u, bool first) const {
        const int t = ltid();
        if ((t >> 6) == 0) {
            if (t == 0) { unsigned sp = 0; while (__hip_atomic_load((GAS unsigned*)dep + u.pm, __ATOMIC_RELAXED, __HIP_MEMORY_SCOPE_AGENT) < (unsigned)need) { __builtin_amdgcn_s_sleep(2); if (++sp > (1u << 22)) break; } }
            __builtin_amdgcn_fence(__ATOMIC_ACQUIRE, "agent"); asm volatile("s_waitcnt vmcnt(0)" ::: "memory");
        }
        if (first) { asm volatile("s_waitcnt vmcnt(0) lgkmcnt(0)" ::: "memory"); __builtin_amdgcn_s_barrier(); asm volatile("" ::: "memory"); }
    }
    __device__ __forceinline__ unsigned a_lane(int R, int C) const { return (unsigned)(R * lda + C) * 2u; }
    __device__ __forceinline__ const GAS char* a_base(const Unit& u, int h) const { return A + (size_t)(u.pm * 256 + h * 128) * lda * 2; }
    __device__ __forceinline__ void a_offs(const Unit&, unsigned (&)[2][2]) const {}
    __device__ __forceinline__ const GAS char* b_base(const Unit& u) const { return Bt + (size_t)u.pn * 256 * K * 2; }
};
struct SchedBranch {
    static constexpr bool GATHER = false, DEPS = false;
    const GAS char* Y; const GAS char* WBR; int G, c;
    __device__ __forceinline__ bool next(int i, Unit& u) const { const int rnd = i / 3, br = i - rnd * 3; const int L = rnd * G + c; if (L >= 256) return false; tile_of(L, 64, 4, u.pm, u.pn); u.x0 = br; u.x1 = 0; u.x2 = 0; return true; }
    __device__ __forceinline__ unsigned a_lane(int R, int C) const { return (unsigned)(R * YP + C) * 2u; }
    __device__ __forceinline__ const GAS char* a_base(const Unit& u, int h) const { return Y + (u.x0 == 0 ? C_DQ : u.x0 == 1 ? C_CQ : C_MQ) * 2 + (size_t)(u.pm * 256 + h * 128) * YP * 2; }
    __device__ __forceinline__ void a_offs(const Unit&, unsigned (&)[2][2]) const {}
    __device__ __forceinline__ const GAS char* b_base(const Unit& u) const { return WBR + ((size_t)u.x0 * 1024 + (size_t)u.pn * 256) * 512 * 2; }
};
struct EpiBranch {
    static constexpr bool PERM = true, PUBLISH = true;
    const GAS bf16_t* Y; GAS bf16_t* MG; GAS unsigned* dep;
    __device__ __forceinline__ bool keep(const Unit& u) const { return u.x0 < 2; }
    __device__ __forceinline__ bool pub(const Unit& u) const { return u.x0 == 2; }
    __device__ __forceinline__ void publish(const Unit& u, int tid) const { if (tid == 0) __hip_atomic_fetch_add(dep + u.pm, 1u, __ATOMIC_RELAXED, __HIP_MEMORY_SCOPE_AGENT); }
    __device__ __forceinline__ void operator()(f32x4 (&acc)[2][2][4][2], const Unit& u, int wr, int wc, int fr, int fq) const {
        const int row0 = u.pm * BM + wr * 64 + fr, col0 = u.pn * BM + wc * 32 + 8 * fq, br = u.x0;
#pragma unroll
        for (int ai = 0; ai < 2; ++ai) {
            u32x2 g[4][2], gn[4][2];
#pragma unroll
            for (int m = 0; m < 4; ++m)
#pragma unroll
                for (int bj = 0; bj < 2; ++bj) { const int row = row0 + ai * HALF + m * 16, col = col0 + bj * HALF;
                    const size_t go = ((size_t)(u.pm * 12 + br * 4 + u.pn) * 16 + (ai * 4 + m) * 2 + bj) * 4096 + ((wr * 4 + wc) * 64 + fq * 16 + fr) * 8;
                    g[m][bj] = *(const GAS u32x2*)((const GAS unsigned char*)Y + go);
                    if (br < 2) gn[m][bj] = *(const GAS u32x2*)((const GAS unsigned char*)Y + go + (size_t)4 * 16 * 4096); else gn[m][bj] = (u32x2){0x01010101u, 0x01010101u}; }
#pragma unroll
            for (int m = 0; m < 4; ++m)
#pragma unroll
                for (int bj = 0; bj < 2; ++bj) { const int row = row0 + ai * HALF + m * 16, col = col0 + bj * HALF;
                    const u32x2 gg = g[m][bj], nn = gn[m][bj];
                    float s[8];
#pragma unroll
                    for (int e = 0; e < 8; ++e) { const float gq = (float)((gg[e >> 2] >> (8 * (e & 3))) & 255u), nq = (float)((nn[e >> 2] >> (8 * (e & 3))) & 255u);
                        s[e] = (br < 2) ? gq * __builtin_amdgcn_rcpf(fmaxf(nq, 1.f)) : gq * (1.f / 255.f); }
                    f32x4 v0 = acc[ai][bj][m][0], v1 = acc[ai][bj][m][1];
                    v0[0] *= s[0]; v0[1] *= s[1]; v0[2] *= s[2]; v0[3] *= s[3]; v1[0] *= s[4]; v1[1] *= s[5]; v1[2] *= s[6]; v1[3] *= s[7];
                    if (br < 2) { acc[ai][bj][m][0] = v0; acc[ai][bj][m][1] = v1; }
                    else { u32x4 w; w.x = cvt_pk_bf16(v0[0], v0[1]); w.y = cvt_pk_bf16(v0[2], v0[3]); w.z = cvt_pk_bf16(v1[0], v1[1]); w.w = cvt_pk_bf16(v1[2], v1[3]);
                        asm volatile("global_store_dwordx4 %0, %1, off sc1\n\ts_nop 1" :: "v"(MG + (size_t)row * D + col), "v"(w) : "memory"); } }
        }
    }
};
template <bool XBF>
struct EpiOut {
    __device__ __forceinline__ bool keep(const Unit&) const { return false; }
    static constexpr bool PERM = true, PUBLISH = true;
    __device__ __forceinline__ bool pub(const Unit&) const { return true; }
    __device__ __forceinline__ void publish(const Unit& u, int tid) const { if (tid == 0) __hip_atomic_fetch_add(dep + u.pm, 1u, __ATOMIC_RELAXED, __HIP_MEMORY_SCOPE_AGENT); }
    GAS unsigned* dep;
    const GAS void* xcur; GAS bf16_t* xo; const GAS float* gt;
    __device__ __forceinline__ void operator()(const f32x4 (&acc)[2][2][4][2], const Unit& u, int wr, int wc, int fr, int fq) const {
        const int row0 = u.pm * BM + wr * 64 + fr, col0 = u.pn * BM + wc * 32 + 8 * fq;
        const GAS float* g = gt + (size_t)(u.pm >> 4) * 6144;
#pragma unroll
        for (int bj = 0; bj < 2; ++bj) { const int col = col0 + bj * HALF; const f32x4 g0 = *(const GAS f32x4*)(g + col), g1 = *(const GAS f32x4*)(g + col + 4);
            if constexpr (XBF) {
                u32x4 xb[2][4];
#pragma unroll
                for (int ai = 0; ai < 2; ++ai)
#pragma unroll
                    for (int m = 0; m < 4; ++m) xb[ai][m] = *(const GAS u32x4*)((const GAS bf16_t*)xcur + (size_t)(row0 + ai * HALF + m * 16) * D + col);
#pragma unroll
                for (int ai = 0; ai < 2; ++ai)
#pragma unroll
                    for (int m = 0; m < 4; ++m) { const u32x4 x = xb[ai][m]; const f32x4 a0 = acc[ai][bj][m][0], a1 = acc[ai][bj][m][1];
                        u32x4 w; w.x = pkh(hlo(x.x) + g0.x * a0.x, hhi(x.x) + g0.y * a0.y); w.y = pkh(hlo(x.y) + g0.z * a0.z, hhi(x.y) + g0.w * a0.w);
                        w.z = pkh(hlo(x.z) + g1.x * a1.x, hhi(x.z) + g1.y * a1.y); w.w = pkh(hlo(x.w) + g1.z * a1.z, hhi(x.w) + g1.w * a1.w);
                        asm volatile("global_store_dwordx4 %0, %1, off sc1\n\ts_nop 1" :: "v"(xo + (size_t)(row0 + ai * HALF + m * 16) * D + col), "v"(w) : "memory"); }
            } else {
#pragma unroll
                for (int ai = 0; ai < 2; ++ai) { f32x4 xa[4][2];
#pragma unroll
                    for (int m = 0; m < 4; ++m) { const GAS float* xr = (const GAS float*)xcur + (size_t)(row0 + ai * HALF + m * 16) * D + col; xa[m][0] = *(const GAS f32x4*)xr; xa[m][1] = *(const GAS f32x4*)(xr + 4); }
#pragma unroll
                    for (int m = 0; m < 4; ++m) { const f32x4 v0 = xa[m][0] + g0 * acc[ai][bj][m][0], v1 = xa[m][1] + g1 * acc[ai][bj][m][1];
                        u32x4 w; w.x = pkh(v0[0], v0[1]); w.y = pkh(v0[2], v0[3]); w.z = pkh(v1[0], v1[1]); w.w = pkh(v1[2], v1[3]);
                        asm volatile("global_store_dwordx4 %0, %1, off sc1\n\ts_nop 1" :: "v"(xo + (size_t)(row0 + ai * HALF + m * 16) * D + col), "v"(w) : "memory"); } }
            } }
    }
};
template <bool GA_> struct SchedMoe {
    static constexpr bool GATHER = GA_, DEPS = !GA_;
    const GAS char* A; const GAS char* Bt; const GAS int* list; const LAS int* tab; int lda, K, nN, G, c; GAS unsigned* dep;
    __device__ __forceinline__ void wait_ready(const Unit& u, bool first) const {
        const int t = ltid();
        if ((t >> 6) == 0) {
            if (t == 0) { unsigned sp = 0; while (__hip_atomic_load(dep + u.pm, __ATOMIC_RELAXED, __HIP_MEMORY_SCOPE_AGENT) < (unsigned)nN) { __builtin_amdgcn_s_sleep(2); if (++sp > (1u << 22)) break; } }
            __builtin_amdgcn_fence(__ATOMIC_ACQUIRE, "agent"); asm volatile("s_waitcnt vmcnt(0)" ::: "memory");
        }
        if (first) { asm volatile("s_waitcnt vmcnt(0) lgkmcnt(0)" ::: "memory"); __builtin_amdgcn_s_barrier(); asm volatile("" ::: "memory"); }
    }
    __device__ __forceinline__ bool next(int i, Unit& u) const {
        const int total = __builtin_amdgcn_readfirstlane(tab[16]) * nN; int L = i * G + c;
        const int d = total - 2 * G;
        if (G == 256 && d > 0 && d <= 48) {
            const int ca = 3 * d, cb = G - 5 * d, cc = 2 * d;
            if constexpr (GA_) { if (i == 0) L = c; else if (i == 1) { if (c >= ca + cb) return false; L = G + c; } else if (i == 2) { if (c >= ca) return false; L = G + ca + cb + c; } else return false; }
            else { if (c < ca) { if (i > 0) return false; L = 4 * cc + 2 * cb + c; }
                   else if (c < ca + cb) { if (i > 1) return false; L = 4 * cc + (c - ca) + cb * i; }
                   else { if (i > 3) return false; L = (c - ca - cb) + cc * i; } }
        } else if constexpr (!GA_) {
            const int ra = total % G, v = c >= ra ? c - ra : c + G - ra, nl = G - ra;
            L = v < nl ? (i == 0 ? v : nl + (i - 1) * G + v) : nl + i * G + v;
        }
        if (L >= total) return false;
        const int mt = L / nN, pn = L - mt * nN; int e = 0;
#pragma unroll
        for (int j = 1; j < 16; ++j) e += (mt >= __builtin_amdgcn_readfirstlane(tab[j])) ? 1 : 0;
        const int lt = mt - __builtin_amdgcn_readfirstlane(tab[e]); const int rem = __builtin_amdgcn_readfirstlane(tab[32 + e]) - lt * 256;
        u.pm = mt; u.pn = pn; u.x0 = e; u.x1 = lt * 256; u.x2 = rem < 256 ? rem : 256; return true;
    }
    __device__ __forceinline__ unsigned a_lane(int R, int C) const { return (unsigned)(R * lda + C) * 2u; }
    __device__ __forceinline__ const GAS char* a_base(const Unit& u, int h) const { return GA_ ? A : A + (size_t)(u.pm * 256 + h * 128) * lda * 2; }
    __device__ __forceinline__ void a_offs(const Unit& u, unsigned (&o)[2][2]) const {
        const int t2 = ltid();
#pragma unroll
        for (int h = 0; h < 2; ++h)
#pragma unroll
            for (int i = 0; i < 2; ++i) { int R, C; stage_rc(t2 * 16 + i * 8192, R, C); const int rl = h * 128 + R; int tok = 0; if (rl < u.x2) tok = list[u.x0 * 16384 + u.x1 + rl] >> 1; o[h][i] = (unsigned)(tok * lda + C) * 2u; }
    }
    __device__ __forceinline__ const GAS char* b_base(const Unit& u) const { return Bt + ((size_t)u.x0 * 1024 + (size_t)u.pn * 256) * K * 2; }
};
struct EpiGU {
    __device__ __forceinline__ bool keep(const Unit&) const { return false; }
    static constexpr bool PERM = true, PUBLISH = true;
    GAS bf16_t* HC; GAS unsigned* dep;
    __device__ __forceinline__ void operator()(const f32x4 (&acc)[2][2][4][2], const Unit& u, int wr, int wc, int fr, int fq) const {
        const int row0 = u.pm * BM + wr * 64 + fr, col0 = u.pn * 128 + wc * 32 + 8 * fq;
#pragma unroll
        for (int ai = 0; ai < 2; ++ai)
#pragma unroll
            for (int m = 0; m < 4; ++m) { const int row = row0 + ai * HALF + m * 16;
                f32x4 h0, h1;
#pragma unroll
                for (int e = 0; e < 4; ++e) { const float g0 = acc[ai][0][m][0][e], g1 = acc[ai][0][m][1][e];
                    h0[e] = g0 * __builtin_amdgcn_rcpf(1.f + __builtin_amdgcn_exp2f(-1.4426950408889634f * g0)) * acc[ai][1][m][0][e];
                    h1[e] = g1 * __builtin_amdgcn_rcpf(1.f + __builtin_amdgcn_exp2f(-1.4426950408889634f * g1)) * acc[ai][1][m][1][e]; }
                u32x4 w; w.x = cvt_pk_bf16(h0[0], h0[1]); w.y = cvt_pk_bf16(h0[2], h0[3]); w.z = cvt_pk_bf16(h1[0], h1[1]); w.w = cvt_pk_bf16(h1[2], h1[3]);
                asm volatile("global_store_dwordx4 %0, %1, off sc1\n\ts_nop 1" :: "v"(HC + (size_t)row * FF + col0), "v"(w) : "memory"); }
    }
    __device__ __forceinline__ bool pub(const Unit&) const { return true; }
    __device__ __forceinline__ void publish(const Unit& u, int tid) const { if (tid == 0) __hip_atomic_fetch_add(dep + u.pm, 1u, __ATOMIC_RELAXED, __HIP_MEMORY_SCOPE_AGENT); }
};
struct EpiDown {
    __device__ __forceinline__ bool keep(const Unit&) const { return false; }
    static constexpr bool PERM = true, PUBLISH = false;
    GAS bf16_t* OS; const GAS int* list;
    __device__ __forceinline__ void operator()(const f32x4 (&acc)[2][2][4][2], const Unit& u, int wr, int wc, int fr, int fq) const {
        const int col0 = u.pn * BM + wc * 32 + 8 * fq;
        int ts[2][4];
#pragma unroll
        for (int ai = 0; ai < 2; ++ai)
#pragma unroll
            for (int m = 0; m < 4; ++m) { const int rl = ai * HALF + wr * 64 + m * 16 + fr; ts[ai][m] = rl < u.x2 ? list[u.x0 * 16384 + u.x1 + rl] : -1; }
#pragma unroll
        for (int ai = 0; ai < 2; ++ai)
#pragma unroll
            for (int m = 0; m < 4; ++m) {
                if (ts[ai][m] >= 0) {
#pragma unroll
                    for (int bj = 0; bj < 2; ++bj) { const f32x4 v0 = acc[ai][bj][m][0], v1 = acc[ai][bj][m][1];
                        u32x4 w; w.x = cvt_pk_bf16(v0[0], v0[1]); w.y = cvt_pk_bf16(v0[2], v0[3]); w.z = cvt_pk_bf16(v1[0], v1[1]); w.w = cvt_pk_bf16(v1[2], v1[3]);
                        *(GAS u32x4*)(OS + (size_t)ts[ai][m] * D + col0 + bj * HALF) = w; } } }
    }
};
}


namespace att {
typedef short bf16x8 __attribute__((ext_vector_type(8)));
typedef short s16x4 __attribute__((ext_vector_type(4)));
typedef float f32x16 __attribute__((ext_vector_type(16)));
#define ASBAR() __builtin_amdgcn_sched_barrier(0)
template <bool B> struct BoolC { static constexpr bool value = B; };
__device__ __forceinline__ int crow(int r, int hi) { return (r & 3) + 8 * (r >> 2) + 4 * hi; }
__device__ __forceinline__ unsigned cvtpk(float lo, float hi) { unsigned r; asm volatile("v_cvt_pk_bf16_f32 %0, %1, %2" : "=v"(r) : "v"(lo), "v"(hi)); return r; }
template <int OFF> __device__ __forceinline__ s16x4 tr_read(int vb) { s16x4 r; asm volatile("ds_read_b64_tr_b16 %0, %1 offset:%2" : "=&v"(r) : "v"(vb), "i"(OFF) : "memory"); return r; }
__device__ __forceinline__ int v_rd_base(int lane) { return ((lane & 3) << 3) | (((lane >> 2) & 3) << 6) | (((lane >> 4) & 1) << 5) | (((lane >> 5) & 1) << 8); }

struct Args {
    const GAS bf16_t* Q; int qp, qgs;
    const GAS bf16_t* K; int kp, kgs;
    const GAS bf16_t* V; int vp;
    GAS bf16_t* O; int op;
    int q0;
    int jlo, jhi;
    float C;
    float sl2;
    const GAS float* relb;
    const GAS float* rope;
    float lam, osc; const GAS float* subln;
    const GAS unsigned* cmax;
};

template <int DQK, int DV, int NG, int MODE>
struct Body {
    static constexpr int KROWB = (DQK == 64) ? 128 : 256, KTILE = 64 * KROWB, VTILE = 64 * DV * 2, NSLOT = 4, KA = NSLOT - 1, VA = NSLOT - 2;
    static constexpr int OFF_K = 0, OFF_V = NSLOT * NG * KTILE, OFF_WS = OFF_V + NSLOT * VTILE, OFF_TB = OFF_WS + 8 * 64 * 4, LDS_END = OFF_TB + 2304;
    static constexpr int ND0 = DQK / 16, NDV = DV / 32, KCPR = DQK / 8;
    static constexpr int NKD = NG * KTILE / 1024 / 8, NVD = VTILE / 1024 / 8;
    static constexpr int WPG = 8 / NG;
    static constexpr float THR2 = 11.5f, SKIP2 = 40.f;
    static __device__ __forceinline__ int kswz(int row, int ch) { return row * KROWB + ((ch ^ (KROWB == 128 ? ((row >> 1) & 7) : (row & 15))) << 4); }
    static constexpr int v_rd_off(int d0, int ks, int half) { return d0 * 512 + ks * (2 * NDV * 512) + half * (NDV * 512); }

    template <int D0> static __device__ __forceinline__ void pv_one(f32x16& od, int vb, bf16x8 pa0, bf16x8 pa1, bf16x8 pa2, bf16x8 pa3) {
        const s16x4 l0 = tr_read<v_rd_off(D0, 0, 0)>(vb), h0 = tr_read<v_rd_off(D0, 0, 1)>(vb), l1 = tr_read<v_rd_off(D0, 1, 0)>(vb), h1 = tr_read<v_rd_off(D0, 1, 1)>(vb);
        const s16x4 l2 = tr_read<v_rd_off(D0, 2, 0)>(vb), h2 = tr_read<v_rd_off(D0, 2, 1)>(vb), l3 = tr_read<v_rd_off(D0, 3, 0)>(vb), h3 = tr_read<v_rd_off(D0, 3, 1)>(vb);
        asm volatile("s_waitcnt lgkmcnt(0)" ::: "memory"); ASBAR();
#define APK(L, H) (bf16x8){L[0], L[1], L[2], L[3], H[0], H[1], H[2], H[3]}
        od = __builtin_amdgcn_mfma_f32_32x32x16_bf16(pa0, APK(l0, h0), od, 0, 0, 0);
        od = __builtin_amdgcn_mfma_f32_32x32x16_bf16(pa1, APK(l1, h1), od, 0, 0, 0);
        od = __builtin_amdgcn_mfma_f32_32x32x16_bf16(pa2, APK(l2, h2), od, 0, 0, 0);
        od = __builtin_amdgcn_mfma_f32_32x32x16_bf16(pa3, APK(l3, h3), od, 0, 0, 0);
#undef APK
    }
    static __device__ __forceinline__ void pv_ld0(int vb, s16x4 (&f)[8]) {
        f[0] = tr_read<v_rd_off(0, 0, 0)>(vb); f[1] = tr_read<v_rd_off(0, 0, 1)>(vb); f[2] = tr_read<v_rd_off(0, 1, 0)>(vb); f[3] = tr_read<v_rd_off(0, 1, 1)>(vb);
        f[4] = tr_read<v_rd_off(0, 2, 0)>(vb); f[5] = tr_read<v_rd_off(0, 2, 1)>(vb); f[6] = tr_read<v_rd_off(0, 3, 0)>(vb); f[7] = tr_read<v_rd_off(0, 3, 1)>(vb);
    }
    static __device__ __forceinline__ void pv_mm0(f32x16& od, const s16x4 (&f)[8], bf16x8 pa0, bf16x8 pa1, bf16x8 pa2, bf16x8 pa3) {
        asm volatile("s_waitcnt lgkmcnt(0)" ::: "memory"); ASBAR();
#define APK(L, H) (bf16x8){L[0], L[1], L[2], L[3], H[0], H[1], H[2], H[3]}
        od = __builtin_amdgcn_mfma_f32_32x32x16_bf16(pa0, APK(f[0], f[1]), od, 0, 0, 0);
        od = __builtin_amdgcn_mfma_f32_32x32x16_bf16(pa1, APK(f[2], f[3]), od, 0, 0, 0);
        od = __builtin_amdgcn_mfma_f32_32x32x16_bf16(pa2, APK(f[4], f[5]), od, 0, 0, 0);
        od = __builtin_amdgcn_mfma_f32_32x32x16_bf16(pa3, APK(f[6], f[7]), od, 0, 0, 0);
#undef APK
    }
    static __device__ __forceinline__ void pv_all(f32x16 (&o)[NDV], int vb, bf16x8 pa0, bf16x8 pa1, bf16x8 pa2, bf16x8 pa3) {
        pv_one<0>(o[0], vb, pa0, pa1, pa2, pa3); pv_one<1>(o[1], vb, pa0, pa1, pa2, pa3);
        if constexpr (NDV == 4) { pv_one<2>(o[2], vb, pa0, pa1, pa2, pa3); pv_one<3>(o[3], vb, pa0, pa1, pa2, pa3); }
    }
    static __device__ __forceinline__ void qkt(f32x16& p0, f32x16& p1, const LAS unsigned char* Ks, const bf16x8 (&qr)[ND0], const f32x16& c0, float c1off, int r32, int hi) {
        constexpr int KAH = (MODE == 0) ? 0 : 2, KW = KAH + 1;
        bf16x8 f0[KW], f1[KW];
#pragma unroll
        for (int d0 = 0; d0 < KAH; ++d0) { f0[d0] = *(const LAS bf16x8*)(Ks + kswz(r32, d0 * 2 + hi)); f1[d0] = *(const LAS bf16x8*)(Ks + kswz(32 + r32, d0 * 2 + hi)); }
#pragma unroll
        for (int d0 = 0; d0 < ND0; ++d0) {
            if (d0 + KAH < ND0) { f0[(d0 + KAH) % KW] = *(const LAS bf16x8*)(Ks + kswz(r32, (d0 + KAH) * 2 + hi)); f1[(d0 + KAH) % KW] = *(const LAS bf16x8*)(Ks + kswz(32 + r32, (d0 + KAH) * 2 + hi)); }
            const bf16x8 b0 = f0[d0 % KW], b1 = f1[d0 % KW];
            if (d0 == 0) { p0 = __builtin_amdgcn_mfma_f32_32x32x16_bf16(b0, qr[0], c0, 0, 0, 0);
                if constexpr (MODE == 0) { f32x16 t;
#pragma unroll
                    for (int r = 0; r < 16; ++r) t[r] = c0[r] + c1off;
                    p1 = __builtin_amdgcn_mfma_f32_32x32x16_bf16(b1, qr[0], t, 0, 0, 0); }
                else p1 = __builtin_amdgcn_mfma_f32_32x32x16_bf16(b1, qr[0], c0, 0, 0, 0); }
            else { p0 = __builtin_amdgcn_mfma_f32_32x32x16_bf16(b0, qr[d0], p0, 0, 0, 0); p1 = __builtin_amdgcn_mfma_f32_32x32x16_bf16(b1, qr[d0], p1, 0, 0, 0); }
        }
    }
    static __device__ __forceinline__ void finishSM(f32x16& p0, f32x16& p1, float alpha, float& l_reg, bf16x8& pa0, bf16x8& pa1, bf16x8& pa2, bf16x8& pa3) {
        if constexpr (MODE != 0) {
#pragma unroll
            for (int r = 0; r < 16; ++r) p1[r] = __builtin_amdgcn_exp2f(p1[r]); }
        float ps = 0.f;
#pragma unroll
        for (int r = 0; r < 16; ++r) ps += p0[r];
#pragma unroll
        for (int r = 0; r < 16; ++r) ps += p1[r];
        { auto rr = __builtin_amdgcn_permlane32_swap(__float_as_uint(ps), __float_as_uint(ps), false, false); ps = __uint_as_float(rr[0]) + __uint_as_float(rr[1]); }
        l_reg = l_reg * alpha + ps;
#define APK4(P, BASE, OUT) do { unsigned a0 = cvtpk(P[BASE + 0], P[BASE + 1]), a1 = cvtpk(P[BASE + 2], P[BASE + 3]); \
        unsigned b0 = cvtpk(P[BASE + 4], P[BASE + 5]), b1 = cvtpk(P[BASE + 6], P[BASE + 7]); \
        auto r0 = __builtin_amdgcn_permlane32_swap(a0, b0, false, false); auto r1 = __builtin_amdgcn_permlane32_swap(a1, b1, false, false); \
        u32x4 w = {r0[0], r1[0], r0[1], r1[1]}; OUT = __builtin_bit_cast(bf16x8, w); } while (0)
        APK4(p0, 0, pa0); APK4(p0, 8, pa1); APK4(p1, 0, pa2); APK4(p1, 8, pa3);
#undef APK4
    }

    static __device__ __forceinline__ void unit(LAS unsigned char* lds, const Args& a) {
        const int tid = ltid(), wid = __builtin_amdgcn_readfirstlane(tid >> 6), lane = tid & 63, r32 = lane & 31, hi = lane >> 5;
        const int grp = wid / WPG, wg = wid % WPG;
        const int qrow = wg * 32 + r32, qpos = a.q0 + qrow, q0w = a.q0 + wg * 32, cw = q0w >> 6;
        const int wlo = (MODE == 1) ? cw - 8 : 0, whi = cw;
        LAS float* wsf = (LAS float*)(lds + OFF_WS) + wid * 64; LAS float* li_l = wsf; LAS float* al_l = wsf + 32;
        unsigned koff[NKD], voff[NVD]; int kdst[NKD], vdst[NVD];
#pragma unroll
        for (int c = 0; c < NKD; ++c) { const int pi = wid + 8 * c, g = pi / (KTILE / 1024), lp = pi % (KTILE / 1024), si = lp * 64 + lane;
            int row, ch; if (KROWB == 128) { row = si >> 3; ch = (si & 7) ^ ((row >> 1) & 7); } else { row = si >> 4; ch = (si & 15) ^ (row & 15); if (ch >= KCPR) ch = 0; }
            koff[c] = (unsigned)(g * a.kgs + row * a.kp + ch * 8) * 2u; kdst[c] = OFF_K + g * KTILE + lp * 1024; }
#pragma unroll
        for (int c = 0; c < NVD; ++c) { const int pi = wid + 8 * c, si = pi * 64 + lane, blk = si >> 5, kkh = blk / NDV, cblk = blk % NDV, within = si & 31, kk = kkh * 8 + (within >> 2);
            const int k = (kk & ~0xC) | ((kk & 4) << 1) | ((kk & 8) >> 1), cc = cblk * 32 + (within & 3) * 8;
            voff[c] = (unsigned)(k * a.vp + cc) * 2u; vdst[c] = OFF_V + pi * 1024; }
        const int NT = a.jhi - a.jlo + 1;
#define DMA_K(i) do { const GAS char* kb_ = (const GAS char*)a.K + (size_t)(a.jhi - (i)) * 64 * a.kp * 2; const int so_ = ((i) % NSLOT) * NG * KTILE; \
        _Pragma("unroll") for (int c = 0; c < NKD; ++c) __builtin_amdgcn_global_load_lds((const GAS unsigned*)(kb_ + koff[c]), (LAS unsigned*)(lds + so_ + kdst[c]), 16, 0, 0); } while (0)
#define DMA_V(i) do { const GAS char* vb_ = (const GAS char*)a.V + (size_t)(a.jhi - (i)) * 64 * a.vp * 2; const int so_ = ((i) % NSLOT) * VTILE; \
        _Pragma("unroll") for (int c = 0; c < NVD; ++c) __builtin_amdgcn_global_load_lds((const GAS unsigned*)(vb_ + voff[c]), (LAS unsigned*)(lds + so_ + vdst[c]), 16, 0, 0); } while (0)
#define WAITBAR(i) do { if ((i) + KA < NT) asm volatile("s_waitcnt vmcnt(%0)" :: "n"((KA - 1) * (NKD + NVD)) : "memory"); else asm volatile("s_waitcnt vmcnt(0)" ::: "memory"); \
        asm volatile("s_waitcnt lgkmcnt(0)" ::: "memory"); __builtin_amdgcn_s_barrier(); asm volatile("" ::: "memory"); } while (0)
        asm volatile("s_waitcnt vmcnt(0) lgkmcnt(0)" ::: "memory"); __builtin_amdgcn_s_barrier(); asm volatile("" ::: "memory");
        _Pragma("unroll") for (int t = 0; t < KA; ++t) { if (t < NT) DMA_K(t); if (t >= 1 && t - 1 < NT) DMA_V(t - 1); }
        LAS float* tb = (LAS float*)(lds + OFF_TB);
        if constexpr (MODE == 1) { for (int i = tid; i < 513; i += 512) tb[i] = a.relb[i] * 1.4426950408889634f; }
        bf16x8 qr[ND0];
        { const GAS bf16_t* Qw = a.Q + (size_t)qrow * a.qp + grp * a.qgs + hi * 8;
          u32x4 qraw[ND0];
#pragma unroll
          for (int d0 = 0; d0 < ND0; ++d0) qraw[d0] = *(const GAS u32x4*)(Qw + d0 * 16);
          if constexpr (MODE == 2) {
              const GAS float* rp = a.rope + ((size_t)qpos * 16 + hi * 8) * 2;
              const u32x4 w1 = qraw[4], w2 = qraw[5]; u32x4 o1, o2;
#pragma unroll
              for (int e = 0; e < 4; ++e) {
                  const f32x4 cs = *(const GAS f32x4*)(rp + e * 4);
                  const float x1a = bflo(w1[e]), x1b = bfhi(w1[e]), x2a = bflo(w2[e]), x2b = bfhi(w2[e]);
                  o1[e] = cvtpk((x1a * cs[0] - x2a * cs[1]) * a.C, (x1b * cs[2] - x2b * cs[3]) * a.C);
                  o2[e] = cvtpk((x1a * cs[1] + x2a * cs[0]) * a.C, (x1b * cs[3] + x2b * cs[2]) * a.C);
              }
              qr[4] = __builtin_bit_cast(bf16x8, o1); qr[5] = __builtin_bit_cast(bf16x8, o2);
          }
#pragma unroll
          for (int d0 = 0; d0 < ((MODE == 2) ? 4 : ND0); ++d0) { u32x4 w;
#pragma unroll
              for (int e = 0; e < 4; ++e) w[e] = cvtpk(bflo(qraw[d0][e]) * a.C, bfhi(qraw[d0][e]) * a.C);
              qr[d0] = __builtin_bit_cast(bf16x8, w); }
        }
        float bq = 0.f;
        if constexpr (MODE == 0) {
#pragma unroll
            for (int d0 = 0; d0 < ND0; ++d0) { const u32x4 cma = *(const GAS u32x4*)(a.cmax + grp * 64 + d0 * 16 + hi * 8), cmb = *(const GAS u32x4*)(a.cmax + grp * 64 + d0 * 16 + hi * 8 + 4);
                const u32x4 qw = __builtin_bit_cast(u32x4, qr[d0]);
                bq += fabsf(bflo(qw[0])) * __uint_as_float(cma[0]) + fabsf(bfhi(qw[0])) * __uint_as_float(cma[1]) + fabsf(bflo(qw[1])) * __uint_as_float(cma[2]) + fabsf(bfhi(qw[1])) * __uint_as_float(cma[3])
                    + fabsf(bflo(qw[2])) * __uint_as_float(cmb[0]) + fabsf(bfhi(qw[2])) * __uint_as_float(cmb[1]) + fabsf(bflo(qw[3])) * __uint_as_float(cmb[2]) + fabsf(bfhi(qw[3])) * __uint_as_float(cmb[3]); }
            { auto rr = __builtin_amdgcn_permlane32_swap(__float_as_uint(bq), __float_as_uint(bq), false, false); bq = (__uint_as_float(rr[0]) + __uint_as_float(rr[1])) * 1.01f; }
        }
        LAS int* flg = (LAS int*)(lds + OFF_TB);
        if constexpr (MODE == 0) { if (tid < 16) flg[tid] = 0; }
        float m_reg = 0.f, l_reg = 0.f; f32x16 o[NDV];
#pragma unroll
        for (int d = 0; d < NDV; ++d) o[d] = f32x16{};
        f32x16 cin0;
        const float c1off_ = (MODE == 0) ? a.sl2 * 32.f : 0.f;
#pragma unroll
        for (int r = 0; r < 16; ++r) { const float kr = (float)crow(r, hi); cin0[r] = (MODE == 0) ? a.sl2 * kr : 0.f; }
        const int vb0 = (int)(uintptr_t)(lds + OFF_V) + v_rd_base(lane);
        f32x16 pA0, pA1, pB0, pB1; float alA = 1.f, alB = 1.f; bool liveA = false, liveB = false; bf16x8 pa0, pa1, pa2, pa3;
        asm volatile("s_waitcnt vmcnt(0) lgkmcnt(0)" ::: "memory"); __builtin_amdgcn_s_barrier(); asm volatile("" ::: "memory");
#define ISSUE(i) do { if ((i) + KA < NT) DMA_K((i) + KA); if ((i) + VA < NT) DMA_V((i) + VA); } while (0)
#define RESC(al) do { if (__any((al) < 1.f)) { if (hi == 0) al_l[r32] = (al); asm volatile("s_waitcnt lgkmcnt(0)" ::: "memory"); \
        _Pragma("unroll") for (int d = 0; d < NDV; ++d) _Pragma("unroll") for (int r = 0; r < 16; ++r) o[d][r] *= al_l[crow(r, hi)]; } } while (0)
        auto head_first = [&](f32x16& p0, f32x16& p1, int j) __attribute__((always_inline)) {
            float tj = 0.f;
            if constexpr (MODE == 0) {
                tj = -a.sl2 * (float)(qpos - j * 64);
                const int dk = j * 64 + 4 * hi - qpos;
#pragma unroll
                for (int r = 0; r < 16; ++r) { const int d0_ = dk + (r & 3) + 8 * (r >> 2); if (d0_ > 0) p0[r] -= 2.f * a.sl2 * (float)d0_; if (d0_ + 32 > 0) p1[r] -= 2.f * a.sl2 * (float)(d0_ + 32); }
            } else if constexpr (MODE == 1) {
                const int dq = qpos - j * 64 - 4 * hi + 256;
#pragma unroll
                for (int r = 0; r < 16; ++r) { const int c0 = (r & 3) + 8 * (r >> 2); int i0 = dq - c0, i1 = dq - c0 - 32; i0 = i0 < 0 ? 0 : i0 > 512 ? 512 : i0; i1 = i1 < 0 ? 0 : i1 > 512 ? 512 : i1;
                    p0[r] += tb[i0]; p1[r] += tb[i1]; }
            }
            float pm = fmaxf(fmaxf(p0[0], p0[1]), p1[0]);
#pragma unroll
            for (int r = 2; r < 16; r += 2) pm = fmaxf(fmaxf(pm, p0[r]), p0[r + 1]);
#pragma unroll
            for (int r = 1; r < 15; r += 2) pm = fmaxf(fmaxf(pm, p1[r]), p1[r + 1]);
            pm = fmaxf(pm, p1[15]);
            { auto rr = __builtin_amdgcn_permlane32_swap(__float_as_uint(pm), __float_as_uint(pm), false, false); pm = fmaxf(__uint_as_float(rr[0]), __uint_as_float(rr[1])); }
            const float dl = pm + tj; m_reg += dl; tj -= dl;
#pragma unroll
            for (int r = 0; r < 16; ++r) { cin0[r] -= dl; p0[r] += tj; p1[r] += tj; }
#pragma unroll
            for (int r = 0; r < 16; ++r) p0[r] = __builtin_amdgcn_exp2f(p0[r]);
            if constexpr (MODE == 0) {
#pragma unroll
                for (int r = 0; r < 16; ++r) p1[r] = __builtin_amdgcn_exp2f(p1[r]); }
        };
        auto head = [&](f32x16& p0, f32x16& p1, float& alpha, bool& live, int j, auto doexp_c) __attribute__((always_inline)) { constexpr bool DOEXP = decltype(doexp_c)::value;
            float tj = 0.f;
            if constexpr (MODE == 0) tj = -a.sl2 * (float)(qpos - j * 64);
            else if constexpr (MODE == 1) {
                if (j <= cw - 5) tj = tb[512];
                else { const int dq = qpos - j * 64 - 4 * hi + 256;
#pragma unroll
                    for (int r = 0; r < 16; ++r) { const int c0 = (r & 3) + 8 * (r >> 2); int i0 = dq - c0, i1 = dq - c0 - 32; i0 = i0 < 0 ? 0 : i0 > 512 ? 512 : i0; i1 = i1 < 0 ? 0 : i1 > 512 ? 512 : i1;
                        p0[r] += tb[i0]; p1[r] += tb[i1]; } }
            }
            float pm = fmaxf(fmaxf(p0[0], p0[1]), p1[0]);
#pragma unroll
            for (int r = 2; r < 16; r += 2) pm = fmaxf(fmaxf(pm, p0[r]), p0[r + 1]);
#pragma unroll
            for (int r = 1; r < 15; r += 2) pm = fmaxf(fmaxf(pm, p1[r]), p1[r + 1]);
            pm = fmaxf(pm, p1[15]);
            { auto rr = __builtin_amdgcn_permlane32_swap(__float_as_uint(pm), __float_as_uint(pm), false, false); pm = fmaxf(__uint_as_float(rr[0]), __uint_as_float(rr[1])); }
            pm += tj;
            alpha = 1.f; live = true;
            if constexpr (MODE == 0) { if (__all(pm < -SKIP2)) { live = false; return; } }
            if (__builtin_expect(!__all(pm <= THR2), 0)) {
                const float dl = fmaxf(pm, 0.f);
                alpha = __builtin_amdgcn_exp2f(-dl); m_reg += dl; tj -= dl;
#pragma unroll
                for (int r = 0; r < 16; ++r) { cin0[r] -= dl; }
            }
            if (MODE != 2) {
#pragma unroll
                for (int r = 0; r < 16; ++r) { p0[r] += tj; p1[r] += tj; }
            } else if (tj != 0.f) {
#pragma unroll
                for (int r = 0; r < 16; ++r) { p0[r] += tj; p1[r] += tj; }
            }
            if constexpr (DOEXP) {
#pragma unroll
                for (int r = 0; r < 16; ++r) p0[r] = __builtin_amdgcn_exp2f(p0[r]); }
        };
#define KSLOT(i) (lds + OFF_K + (((i) % NSLOT) * NG + grp) * KTILE)
#define VSLOT(i) (vb0 + ((i) % NSLOT) * VTILE)
#define SSTEP(X0, X1, ALX, LIVEX, Y0, Y1, ALY, LIVEY, i) do { \
        ISSUE(i); \
        if constexpr (MODE != 0) { ASBAR(); qkt(X0, X1, KSLOT(i), qr, cin0, c1off_, r32, hi); } \
        if constexpr (MODE != 0) { s16x4 vf_[8]; pv_ld0(VSLOT((i) + NSLOT - 1), vf_); finishSM(Y0, Y1, ALY, l_reg, pa0, pa1, pa2, pa3); ASBAR(); \
              \
            head(X0, X1, ALX, LIVEX, a.jhi - (i), BoolC<false>{}); ASBAR(); \
            pv_mm0(o[0], vf_, pa0, pa1, pa2, pa3); \
            _Pragma("unroll") for (int r_ = 0; r_ < 8; ++r_) { X0[r_] = __builtin_amdgcn_exp2f(X0[r_]); asm volatile("" : "+v"(X0[r_])); }   \
            pv_one<1>(o[1], VSLOT((i) + NSLOT - 1), pa0, pa1, pa2, pa3); \
            _Pragma("unroll") for (int r_ = 8; r_ < 16; ++r_) { X0[r_] = __builtin_amdgcn_exp2f(X0[r_]); asm volatile("" : "+v"(X0[r_])); } ASBAR(); } \
        else if (LIVEY) {   \
            ASBAR(); qkt(X0, X1, KSLOT(i), qr, cin0, c1off_, r32, hi); finishSM(Y0, Y1, ALY, l_reg, pa0, pa1, pa2, pa3); ASBAR(); \
            head(X0, X1, ALX, LIVEX, a.jhi - (i), BoolC<false>{}); ASBAR(); \
            pv_one<0>(o[0], VSLOT((i) + NSLOT - 1), pa0, pa1, pa2, pa3); \
            _Pragma("unroll") for (int r_ = 0; r_ < 4; ++r_) { X0[r_] = __builtin_amdgcn_exp2f(X0[r_]); asm volatile("" : "+v"(X0[r_])); X1[r_] = __builtin_amdgcn_exp2f(X1[r_]); asm volatile("" : "+v"(X1[r_])); } \
            pv_one<1>(o[1], VSLOT((i) + NSLOT - 1), pa0, pa1, pa2, pa3); \
            _Pragma("unroll") for (int r_ = 4; r_ < 8; ++r_) { X0[r_] = __builtin_amdgcn_exp2f(X0[r_]); asm volatile("" : "+v"(X0[r_])); X1[r_] = __builtin_amdgcn_exp2f(X1[r_]); asm volatile("" : "+v"(X1[r_])); } \
            pv_one<NDV == 4 ? 2 : 0>(o[NDV == 4 ? 2 : 0], VSLOT((i) + NSLOT - 1), pa0, pa1, pa2, pa3); \
            _Pragma("unroll") for (int r_ = 8; r_ < 12; ++r_) { X0[r_] = __builtin_amdgcn_exp2f(X0[r_]); asm volatile("" : "+v"(X0[r_])); X1[r_] = __builtin_amdgcn_exp2f(X1[r_]); asm volatile("" : "+v"(X1[r_])); } \
            pv_one<NDV == 4 ? 3 : 1>(o[NDV == 4 ? 3 : 1], VSLOT((i) + NSLOT - 1), pa0, pa1, pa2, pa3); \
            _Pragma("unroll") for (int r_ = 12; r_ < 16; ++r_) { X0[r_] = __builtin_amdgcn_exp2f(X0[r_]); asm volatile("" : "+v"(X0[r_])); X1[r_] = __builtin_amdgcn_exp2f(X1[r_]); asm volatile("" : "+v"(X1[r_])); } ASBAR(); } \
        else { ASBAR(); qkt(X0, X1, KSLOT(i), qr, cin0, c1off_, r32, hi); ASBAR(); head(X0, X1, ALX, LIVEX, a.jhi - (i), BoolC<true>{}); \
            _Pragma("unroll") for (int r_ = 0; r_ < 16; ++r_) X1[r_] = __builtin_amdgcn_exp2f(X1[r_]); } \
        if constexpr (MODE == 0) { const int jn_ = a.jhi - (i);   \
            const bool fin_ = __all(bq - a.sl2 * (float)(qpos - 64 * jn_ + 1) - m_reg < -SKIP2); if (lane == 0) flg[((i) & 1) * 8 + wid] = fin_ ? 1 : 0; } \
        WAITBAR(i); \
        if constexpr (MODE == 0) { const u32x4 f0_ = *(const LAS u32x4*)(flg + ((i) & 1) * 8), f1_ = *(const LAS u32x4*)(flg + ((i) & 1) * 8 + 4); \
            stop = __builtin_amdgcn_readfirstlane((int)(f0_.x & f0_.y & f0_.z & f0_.w & f1_.x & f1_.y & f1_.z & f1_.w)) != 0; } \
        if (MODE != 0 || LIVEX) RESC(ALX); } while (0)
        const int jmin_ = wlo > a.jlo ? wlo : a.jlo;
        const int ia = a.jhi - whi, ib = a.jhi - jmin_;
        bool stop = false, lastB = false;
        int i = 0;
        for (; i < ia; ++i) { ISSUE(i); if constexpr (MODE == 0) { if (lane == 0) flg[(i & 1) * 8 + wid] = 0; } WAITBAR(i); }
        { ISSUE(i); ASBAR(); qkt(pA0, pA1, KSLOT(i), qr, cin0, c1off_, r32, hi); head_first(pA0, pA1, a.jhi - i); liveA = true; alA = 1.f;
          if constexpr (MODE == 0) { if (lane == 0) flg[(i & 1) * 8 + wid] = 0; }
          WAITBAR(i); ++i; }
        for (; i + 1 <= ib; i += 2) {
            SSTEP(pB0, pB1, alB, liveB, pA0, pA1, alA, liveA, i); if (MODE == 0 && stop) { lastB = true; ++i; break; }
            SSTEP(pA0, pA1, alA, liveA, pB0, pB1, alB, liveB, i + 1); if (MODE == 0 && stop) { lastB = false; i += 2; break; }
        }
        if (!stop && i <= ib) { SSTEP(pB0, pB1, alB, liveB, pA0, pA1, alA, liveA, i); ++i; lastB = true; }
        if (lastB) { if (MODE != 0 || liveB) { finishSM(pB0, pB1, alB, l_reg, pa0, pa1, pa2, pa3); ASBAR(); pv_all(o, VSLOT(i + NSLOT - 1), pa0, pa1, pa2, pa3); } }
        else if (MODE != 0 || liveA) { finishSM(pA0, pA1, alA, l_reg, pa0, pa1, pa2, pa3); ASBAR(); pv_all(o, VSLOT(i + NSLOT - 1), pa0, pa1, pa2, pa3); }
        if (!stop) { for (; i < NT; ++i) { ISSUE(i); WAITBAR(i); } }
        asm volatile("s_waitcnt vmcnt(0)" ::: "memory");
#undef ISSUE
#undef SSTEP
#undef KSLOT
#undef VSLOT
        int r32e = r32, hie = hi; asm volatile("" : "+v"(r32e), "+v"(hie));
        if (hi == 0) li_l[r32] = l_reg; asm volatile("s_waitcnt lgkmcnt(0)" ::: "memory");
        float rli[16];
#pragma unroll
        for (int r = 0; r < 16; ++r) rli[r] = __builtin_amdgcn_rcpf(li_l[crow(r, hi)]);
        if constexpr (MODE != 0) {
            GAS bf16_t* Ow = a.O + (size_t)(wg * 32) * a.op;
#pragma unroll
            for (int r = 0; r < 16; ++r) { const int orow = crow(r, hie);
#pragma unroll
                for (int d0 = 0; d0 < NDV; ++d0) Ow[(size_t)orow * a.op + d0 * 32 + r32e] = (bf16_t)f2bf(o[d0][r] * rli[r]); }
        } else {
            asm volatile("s_waitcnt lgkmcnt(0)" ::: "memory"); __builtin_amdgcn_s_barrier(); asm volatile("" ::: "memory");
            LAS float* xs = (LAS float*)lds + wg * 4096;
            if (grp == 1) {
#pragma unroll
                for (int d0 = 0; d0 < NDV; ++d0)
#pragma unroll
                    for (int r = 0; r < 16; ++r) xs[(d0 * 16 + r) * 64 + lane] = o[d0][r] * rli[r];
            }
            asm volatile("s_waitcnt lgkmcnt(0)" ::: "memory"); __builtin_amdgcn_s_barrier(); asm volatile("" ::: "memory");
            if (grp == 0) {
                float ss[16];
#pragma unroll
                for (int r = 0; r < 16; ++r) { float s = 0.f;
#pragma unroll
                    for (int d0 = 0; d0 < NDV; ++d0) { const float y = o[d0][r] * rli[r] - a.lam * xs[(d0 * 16 + r) * 64 + lane]; o[d0][r] = y; s += y * y; }
                    ss[r] = s; }
#pragma unroll
                for (int r = 0; r < 16; ++r) { float s = ss[r];
#pragma unroll
                    for (int sh = 1; sh < 32; sh <<= 1) s += __shfl_xor(s, sh);
                    ss[r] = rsqrtf(s * (1.f / 128.f) + EPS) * a.osc; }
                GAS bf16_t* Ow = a.O + (size_t)(wg * 32) * a.op;
#pragma unroll
                for (int d0 = 0; d0 < NDV; ++d0) { const float g = a.subln[d0 * 32 + r32e];
#pragma unroll
                    for (int r = 0; r < 16; ++r) Ow[(size_t)crow(r, hie) * a.op + d0 * 32 + r32e] = (bf16_t)f2bf(o[d0][r] * ss[r] * g); }
            }
        }
#undef DMA_K
#undef DMA_V
#undef WAITBAR
#undef RESC
    }
};
typedef Body<64, 128, 2, 0> Diff;
typedef Body<64, 64, 1, 1> Band;
typedef Body<96, 64, 1, 2> Mla;
#undef ASBAR
}

struct TrItem { const GAS float* src; const GAS float* ksc; GAS bf16_t* dst; int ldw, Kd; };
__device__ __forceinline__ void tr_load(const TrItem& t, float (&v)[32], int lane) {
#pragma unroll
    for (int i = 0; i < 32; ++i) v[i] = __builtin_nontemporal_load(t.src + (size_t)(2 * i) * t.ldw);
}
__device__ __forceinline__ void tr_store(const TrItem& t, float (&v)[32], LAS float* scr, int lane) {
    if (t.ksc) {
#pragma unroll
        for (int i = 0; i < 32; ++i) v[i] *= t.ksc[2 * i + (lane >> 5)];
    }
#pragma unroll
    for (int i = 0; i < 32; ++i) scr[(2 * i + (lane >> 5)) * 33 + (lane & 31)] = v[i];
    asm volatile("s_waitcnt lgkmcnt(0)" ::: "memory");
    const int c = lane & 7;
#pragma unroll
    for (int j = 0; j < 4; ++j) { const int n = (lane >> 3) + 8 * j; const LAS float* s = scr + (8 * c) * 33 + n;
        u32x4 o; o.x = pk2(s[0 * 33], s[1 * 33]); o.y = pk2(s[2 * 33], s[3 * 33]); o.z = pk2(s[4 * 33], s[5 * 33]); o.w = pk2(s[6 * 33], s[7 * 33]);
        *(GAS u32x4*)(t.dst + (size_t)n * t.Kd + 8 * c) = o; }
    asm volatile("s_waitcnt lgkmcnt(0)" ::: "memory");
}
__device__ __forceinline__ TrItem tr_decode(const P& p, gptr ws, int l, int it, int lane) {
    GAS bf16_t* WIN = (GAS bf16_t*)(ws + WS_WIN); GAS bf16_t* WQ = (GAS bf16_t*)(ws + WS_WQ); GAS bf16_t* WKV = (GAS bf16_t*)(ws + WS_WKV); GAS bf16_t* WBR = (GAS bf16_t*)(ws + WS_WBR);
    GAS bf16_t* WOUT = (GAS bf16_t*)(ws + WS_WOUT); GAS bf16_t* WGU = (GAS bf16_t*)(ws + WS_WGU); GAS bf16_t* WD = (GAS bf16_t*)(ws + WS_WD);
    constexpr int I_IN = 16 * 213, I_Q = 6 * 24, I_KV = 4 * 32, I_BR = 3 * 8 * 32, I_O = 16 * 32, I_G = 16 * 16 * 16;
    const GAS float* W; const GAS float* ks = nullptr; GAS bf16_t* WT; int ldw, Kd, k0, n0, dst0;
    int r = it;
    if (r < I_IN) { const int kb = r / 213, nb = r % 213; W = INP(I_WIN) + (size_t)l * D * INW; ldw = INW; k0 = kb * 64; n0 = nb * 32; WT = WIN; Kd = D; dst0 = n0 < 3744 ? n0 : n0 + 96; }
    else if ((r -= I_IN) < I_Q) { const int kb = r / 24, nb = r % 24; W = INP(I_WQB) + (size_t)l * 384 * 768; ldw = 768; k0 = kb * 64; n0 = nb * 32; WT = WQ; Kd = 384; dst0 = n0; ks = INP(I_QNG) + l * 384; }
    else if ((r -= I_Q) < I_KV) { const int kb = r / 32, nb = r % 32; n0 = nb * 32; const int h = n0 >> 7, d = n0 & 127; W = INP(I_WKVB) + (size_t)l * 256 * 1024; ldw = 1024; k0 = kb * 64; WT = WKV; Kd = 256; dst0 = d < 64 ? h * 64 + d : 512 + h * 64 + d - 64; ks = INP(I_KVNG) + l * 256; }
    else if ((r -= I_KV) < I_BR) { const int br = r / 256, q = r % 256, kb = q / 32, nb = q % 32; W = (br == 0 ? INP(I_WBD) : br == 1 ? INP(I_WBC) : INP(I_WBM)) + (size_t)l * 512 * D; ldw = D; k0 = kb * 64; n0 = nb * 32; WT = WBR + (size_t)br * D * 512; Kd = 512; dst0 = n0; }
    else if ((r -= I_BR) < I_O) { const int kb = r / 32, nb = r % 32; W = INP(I_WOUT) + (size_t)l * D * D; ldw = D; k0 = kb * 64; n0 = nb * 32; WT = WOUT; Kd = D; dst0 = n0; }
    else if ((r -= I_O) < 2 * I_G) { const int up = r / I_G, q = r % I_G, e = q / 256, q2 = q % 256, kb = q2 / 16, nb = q2 % 16; n0 = nb * 32;
        W = (up ? INP(I_WEU) : INP(I_WEG)) + ((size_t)l * NE + e) * D * FF; ldw = FF; k0 = kb * 64; WT = WGU + (size_t)e * D * D; Kd = D; dst0 = (n0 >> 7) * 256 + up * 128 + (n0 & 127); }
    else { r -= 2 * I_G; const int e = r / 256, q2 = r % 256, kb = q2 / 32, nb = q2 % 32; W = INP(I_WED) + ((size_t)l * NE + e) * FF * D; ldw = D; k0 = kb * 64; n0 = nb * 32; WT = WD + (size_t)e * D * FF; Kd = FF; dst0 = n0; }
    TrItem t; t.src = W + (size_t)(k0 + (lane >> 5)) * ldw + n0 + (lane & 31); t.ksc = ks ? ks + k0 : nullptr; t.dst = WT + (size_t)dst0 * Kd + k0; t.ldw = ldw; t.Kd = Kd; return t;
}
constexpr int CV_EARLY = 16 * 213 + 6 * 24 + 4 * 32, CV_NIT = CV_EARLY + 3 * 8 * 32 + 16 * 32 + 2 * 16 * 16 * 16 + 16 * 8 * 32, CV_UNITS = (CV_NIT - CV_EARLY) / 64;
static_assert((CV_NIT - CV_EARLY) % 64 == 0, "late items per unit");
__device__ __forceinline__ void ph_convert(const P& p, gptr ws, LAS unsigned char* lds, int l, int gw, int NGW, int NIT) {
    const int tid = ltid(), lane = tid & 63, wave = tid >> 6;
    LAS float* scr = (LAS float*)(lds + wave * 16384);
    float va[32], vb_[32];
    int it = gw;
    TrItem ta, tb; if (it < NIT) { ta = tr_decode(p, ws, l, it, lane); tr_load(ta, va, lane); }
    while (it < NIT) {
        const int it1 = it + NGW;
        if (it1 < NIT) { tb = tr_decode(p, ws, l, it1, lane); tr_load(tb, vb_, lane); }
        tr_store(ta, va, scr, lane);
        const int it2 = it1 + NGW;
        if (it1 >= NIT) break;
        if (it2 < NIT) { ta = tr_decode(p, ws, l, it2, lane); tr_load(ta, va, lane); }
        tr_store(tb, vb_, scr, lane);
        it = it2;
    }
}
__device__ __forceinline__ void ph_convert_early(const P& p, gptr ws, LAS unsigned char* lds, int vb, int nvb, int l) {
    const int tid = ltid();
    ph_convert(p, ws, lds, l, vb * 8 + (tid >> 6), nvb * 8, CV_EARLY);
    GAS bf16_t* WIN = (GAS bf16_t*)(ws + WS_WIN);
    for (int i = vb * 512 + tid; i < 96 * D / 8; i += nvb * 512) *(GAS u32x4*)(WIN + (size_t)3744 * D + (size_t)i * 8) = (u32x4){0u, 0u, 0u, 0u};
}


__device__ __forceinline__ void moe_table(gptr ws, LAS int* tab, int layer) {
    const int tid = ltid();
    __syncthreads();
    if (tid < 16) tab[32 + tid] = (int)__hip_atomic_load((GAS unsigned*)(ws + WS_CTL) + CW_CNT + 64 * layer + tid, __ATOMIC_RELAXED, __HIP_MEMORY_SCOPE_AGENT);
    __syncthreads();
    if (tid == 0) { int s = 0; tab[0] = 0; for (int e = 0; e < 16; ++e) { s += (tab[32 + e] + 255) >> 8; tab[e + 1] = s; } }
    __syncthreads();
}

#define XB_TMO      128
#define XB_XCNT(j)  (256  + 64 * (j))
#define XB_XSUB(j)  (1280 + 64 * (j))
#define XB_XGEN(j)  (2304 + 64 * (j))
#define XB_TOP      3328
#define XB_TOPGEN   3392
#define XCD_BAR_WORDS 3456
#define XB_SPIN_CAP (1u << 18)
__device__ __forceinline__ unsigned xb_ld(unsigned* p)              { return __hip_atomic_load(p, __ATOMIC_RELAXED, __HIP_MEMORY_SCOPE_AGENT); }
__device__ __forceinline__ unsigned xb_add(unsigned* p, unsigned v) { return __hip_atomic_fetch_add(p, v, __ATOMIC_RELAXED, __HIP_MEMORY_SCOPE_AGENT); }
__device__ __forceinline__ unsigned xb_xcc_id() { return (unsigned)__builtin_amdgcn_s_getreg((3 << 11) | 20) & 0xFu; }
#define XB_SPIN(cond, bar) do { unsigned _sp = 0; while (cond) { __builtin_amdgcn_s_sleep(1); \
    if ((++_sp & 255u) == 0u) { if (xb_ld(&(bar)[XB_TMO])) break; if (_sp > XB_SPIN_CAP) { atomicAdd(&(bar)[XB_TMO], 1u); break; } } } } while (0)
struct XcdBarrier { unsigned* bar; unsigned x; volatile LAS unsigned* st; };
__device__ __forceinline__ XcdBarrier xcd_barrier_post(unsigned* bar, volatile LAS unsigned* st) {
    XcdBarrier b; b.bar = bar; b.x = xb_xcc_id(); b.st = st;
    if (threadIdx.x == 0) (void)xb_add(&bar[XB_XCNT(b.x)], 1u);
    return b;
}
__device__ __forceinline__ void xcd_barrier_complete(unsigned* bar, unsigned x, unsigned& nloc, unsigned& nx) {
    const unsigned G = gridDim.x * gridDim.y * gridDim.z;
    unsigned sum, cnt, mine, sp = 0u;
    for (;;) {
        sum = 0u; cnt = 0u; mine = 0u;
#pragma unroll
        for (unsigned j = 0; j < 16; ++j) { const unsigned c = xb_ld(&bar[XB_XCNT(j)]); sum += c; cnt += (c > 0u) ? 1u : 0u; mine = (j == x) ? c : mine; }
        if (sum == G) break;
        __builtin_amdgcn_s_sleep(1);
        if ((++sp & 255u) == 0u) { if (xb_ld(&bar[XB_TMO])) break; if (sp > XB_SPIN_CAP) { atomicAdd(&bar[XB_TMO], 1u); break; } }
    }
    nloc = mine > 0u ? mine : 1u; nx = cnt > 0u ? cnt : 1u;
}
__device__ __forceinline__ void xcd_barrier(const XcdBarrier& b) {
    asm volatile("s_waitcnt vmcnt(0)" ::: "memory");
    __syncthreads();
    if (threadIdx.x == 0) {
        unsigned* bar = b.bar;
        __builtin_amdgcn_s_waitcnt(0);
        unsigned nloc = b.st[0], nx = b.st[1];
        if (nloc == 0u) { xcd_barrier_complete(bar, b.x, nloc, nx); b.st[0] = nloc; b.st[1] = nx; }
        const unsigned old = xb_add(&bar[XB_XSUB(b.x)], 1u);
        const unsigned gen = old / nloc;
        if (old + 1u == (gen + 1u) * nloc) {
            __builtin_amdgcn_fence(__ATOMIC_RELEASE, "agent");
            asm volatile("s_waitcnt vmcnt(0)" ::: "memory");
            const unsigned og = xb_add(&bar[XB_TOP], 1u);
            const unsigned tg = og / nx;
            if (og + 1u == (tg + 1u) * nx) xb_add(&bar[XB_TOPGEN], 1u);
            else XB_SPIN(xb_ld(&bar[XB_TOPGEN]) == tg, bar);
            __builtin_amdgcn_fence(__ATOMIC_ACQUIRE, "agent");
            xb_add(&bar[XB_XGEN(b.x)], 1u);
            asm volatile("s_waitcnt vmcnt(0)" ::: "memory");
        } else {
            XB_SPIN(xb_ld(&bar[XB_XGEN(b.x)]) == gen, bar);
            __builtin_amdgcn_fence(__ATOMIC_ACQUIRE, "agent");
            asm volatile("s_waitcnt vmcnt(0)" ::: "memory");
        }
    }
    __syncthreads();
}

constexpr int LDS_BYTES = 147456;
constexpr int MISC_OFF = 131072 + 8192;
constexpr int NPHASE = 20;
enum { HV_INPROJ = 1, HV_MLAPROJ = 2, HV_DIFF = 4, HV_BAND = 8, HV_MLAATT = 16, HV_BRANCH = 32, HV_OUT = 64, HV_GU = 128, HV_DOWN = 256 };

__device__ const unsigned short ATT_ORDER[1536] = {223,1247,2271,3295,222,1246,2270,3294,159,1183,2207,3231,221,1245,2269,3293,158,1182,2206,3230,220,1244,2268,3292,157,1181,2205,3229,219,1243,2267,3291,156,1180,2204,3228,218,1242,2266,3290,155,1179,2203,3227,217,1241,2265,3289,154,1178,2202,3226,216,1240,2264,3288,153,1177,2201,3225,215,1239,2263,3287,152,1176,2200,3224,214,1238,2262,3286,151,1175,2199,3223,95,1119,2143,3167,213,1237,2261,3285,150,1174,2198,3222,94,1118,2142,3166,212,1236,2260,3284,93,1117,2141,3165,149,1173,2197,3221,92,1116,2140,3164,211,1235,2259,3283,148,1172,2196,3220,91,1115,2139,3163,210,1234,2258,3282,147,1171,2195,3219,90,1114,2138,3162,89,1113,2137,3161,146,1170,2194,3218,209,1233,2257,3281,88,1112,2136,3160,145,1169,2193,3217,208,1232,2256,3280,87,1111,2135,3159,144,1168,2192,3216,86,1110,2134,3158,207,1231,2255,3279,31,1055,2079,3103,30,1054,2078,3102,85,1109,2133,3157,143,1167,2191,3215,206,1230,2254,3278,29,1053,2077,3101,84,1108,2132,3156,28,1052,2076,3100,142,1166,2190,3214,205,1229,2253,3277,27,1051,2075,3099,83,1107,2131,3155,4111,26,4175,1050,4239,2074,4303,3098,4367,141,4431,1165,4495,2189,4559,3213,5135,82,5199,1106,5263,2130,5327,3154,5391,204,5455,1228,5519,2252,5583,3276,6159,25,6223,1049,6287,2073,6351,3097,6415,81,6479,1105,6543,2129,6607,3153,7183,24,7247,1048,7311,2072,7375,3096,7439,140,7503,1164,7567,2188,7631,3212,4110,203,4174,1227,4238,2251,4302,3275,4366,23,4430,1047,4494,2071,4558,3095,5134,80,5198,1104,5262,2128,5326,3152,5390,22,5454,1046,5518,2070,5582,3094,6158,139,6222,1163,6286,2187,6350,3211,6414,79,6478,1103,6542,2127,6606,3151,7182,202,7246,1226,7310,2250,7374,3274,7438,21,7502,1045,7566,2069,7630,3093,4109,20,4173,1044,4237,2068,4301,3092,4365,78,4429,1102,4493,2126,4557,3150,5133,138,5197,1162,5261,2186,5325,3210,5389,201,5453,1225,5517,2249,5581,3273,6157,19,6221,1043,6285,2067,6349,3091,6413,77,6477,1101,6541,2125,6605,3149,7181,18,7245,1042,7309,2066,7373,3090,7437,137,7501,1161,7565,2185,7629,3209,4108,76,4172,1100,4236,2124,4300,3148,4364,200,4428,1224,4492,2248,4556,3272,5132,17,5196,1041,5260,2065,5324,3089,5388,136,5452,1160,5516,2184,5580,3208,6156,16,6220,1040,6284,2064,6348,3088,6412,75,6476,1099,6540,2123,6604,3147,7180,199,7244,1223,7308,2247,7372,3271,7436,15,7500,1039,7564,2063,7628,3087,4107,74,4171,1098,4235,2122,4299,3146,4363,135,4427,1159,4491,2183,4555,3207,5131,14,5195,1038,5259,2062,5323,3086,5387,198,5451,1222,5515,2246,5579,3270,6155,13,6219,1037,6283,2061,6347,3085,6411,73,6475,1097,6539,2121,6603,3145,7179,134,7243,1158,7307,2182,7371,3206,7435,12,7499,1036,7563,2060,7627,3084,4106,72,4170,1096,4234,2120,4298,3144,4362,197,4426,1221,4490,2245,4554,3269,5130,11,5194,1035,5258,2059,5322,3083,5386,133,5450,1157,5514,2181,5578,3205,6154,71,6218,1095,6282,2119,6346,3143,6410,10,6474,1034,6538,2058,6602,3082,7178,196,7242,1220,7306,2244,7370,3268,7434,9,7498,1033,7562,2057,7626,3081,4105,70,4169,1094,4233,2118,4297,3142,4361,132,4425,1156,4489,2180,4553,3204,5129,8,5193,1032,5257,2056,5321,3080,5385,69,5449,1093,5513,2117,5577,3141,6153,195,6217,1219,6281,2243,6345,3267,6409,7,6473,1031,6537,2055,6601,3079,7177,131,7241,1155,7305,2179,7369,3203,7433,6,7497,1030,7561,2054,7625,3078,4104,68,4168,1092,4232,2116,4296,3140,4360,4424,4488,4552,5128,5192,5256,5320,5384,5448,5512,5576,6152,6216,6280,6344,6408,6472,6536,6600,7176,7240,7304,7368,7432,7496,7560,7624,4103,4167,4231,4295,4359,4423,4487,4551,5127,5191,5255,5319,5383,5447,5511,5575,6151,6215,6279,6343,6407,6471,6535,6599,7175,7239,7303,7367,7431,7495,7559,7623,4102,4166,4230,4294,4358,4422,4486,4550,5126,5190,5254,5318,5382,5446,5510,5574,6150,6214,6278,6342,6406,6470,6534,6598,7174,7238,7302,7366,7430,7494,7558,7622,4101,4165,4229,4293,4357,4421,4485,4549,5125,5189,5253,5317,5381,5445,5509,5573,6149,6213,6277,6341,6405,6469,6533,6597,7173,7237,7301,7365,7429,7493,7557,7621,4100,4164,4228,4292,4356,4420,4484,4548,5124,5188,5252,5316,5380,5444,5508,5572,6148,6212,6276,6340,6404,6468,6532,6596,7172,7236,7300,7364,7428,7492,7556,7620,4099,4163,4227,4291,4355,4419,4483,4547,5123,5187,5251,5315,5379,5443,5507,5571,6147,6211,6275,6339,6403,6467,6531,6595,7171,7235,7299,7363,7427,7491,7555,7619,4098,4162,4226,4290,4354,4418,4482,4546,5122,5186,5250,5314,5378,5442,5506,5570,6146,6210,6274,6338,6402,6466,6530,6594,7170,7234,7298,7362,7426,7490,7554,7618,8194,8258,8322,8386,8450,8514,8578,8642,9218,9282,9346,9410,9474,9538,9602,9666,10242,10306,10370,10434,10498,10562,10626,10690,11266,11330,11394,11458,11522,11586,11650,11714,8195,8259,8323,8387,8451,8515,8579,8643,9219,9283,9347,9411,9475,9539,9603,9667,10243,10307,10371,10435,10499,10563,10627,10691,11267,11331,11395,11459,11523,11587,11651,11715,8196,8260,8324,8388,8452,8516,8580,8644,9220,9284,9348,9412,9476,9540,9604,9668,10244,10308,10372,10436,10500,10564,10628,10692,11268,11332,11396,11460,11524,11588,11652,11716,8197,8261,8325,8389,8453,8517,8581,8645,9221,9285,9349,9413,9477,9541,9605,9669,10245,10309,10373,10437,10501,10565,10629,10693,11269,11333,11397,11461,11525,11589,11653,11717,8198,8262,8326,8390,8454,8518,8582,8646,9222,9286,9350,9414,9478,9542,9606,9670,10246,10310,10374,10438,10502,10566,10630,10694,11270,11334,11398,11462,11526,11590,11654,11718,8199,8263,8327,8391,8455,8519,8583,8647,9223,9287,9351,9415,9479,9543,9607,9671,10247,10311,10375,10439,10503,10567,10631,10695,11271,11335,11399,11463,11527,11591,11655,11719,8200,8264,8328,8392,8456,8520,8584,8648,9224,9288,9352,9416,9480,9544,9608,9672,10248,10312,10376,10440,10504,10568,10632,10696,11272,11336,11400,11464,11528,11592,11656,11720,8201,8265,8329,8393,8457,8521,8585,8649,9225,9289,9353,9417,9481,9545,9609,9673,10249,10313,10377,10441,10505,10569,10633,10697,11273,11337,11401,11465,11529,11593,11657,11721,8202,8266,8330,8394,8458,8522,8586,8650,9226,9290,9354,9418,9482,9546,9610,9674,10250,10314,10378,10442,10506,10570,10634,10698,11274,11338,11402,11466,11530,11594,11658,11722,8203,8267,8331,8395,8459,8523,8587,8651,9227,9291,9355,9419,9483,9547,9611,9675,10251,10315,10379,10443,10507,10571,10635,10699,11275,11339,11403,11467,11531,11595,11659,11723,8204,8268,8332,8396,8460,8524,8588,8652,9228,9292,9356,9420,9484,9548,9612,9676,10252,10316,10380,10444,10508,10572,10636,10700,11276,11340,11404,11468,11532,11596,11660,11724,8205,8269,8333,8397,8461,8525,8589,8653,9229,9293,9357,9421,9485,9549,9613,9677,10253,10317,10381,10445,10509,10573,10637,10701,11277,11341,11405,11469,11533,11597,11661,11725,8206,8270,8334,8398,8462,8526,8590,8654,9230,9294,9358,9422,9486,9550,9614,9678,10254,10318,10382,10446,10510,10574,10638,10702,11278,11342,11406,11470,11534,11598,11662,11726,8207,8271,8335,8399,8463,8527,8591,8655,9231,9295,9359,9423,9487,9551,9615,9679,10255,10319,10383,10447,10511,10575,10639,10703,11279,11343,11407,11471,11535,11599,11663,11727,4097,4161,4225,4289,4353,4417,4481,4545,5121,5185,5249,5313,5377,5441,5505,5569,6145,6209,6273,6337,6401,6465,6529,6593,7169,7233,7297,7361,7425,7489,7553,7617,194,1218,2242,3266,5,1029,2053,3077,130,1154,2178,3202,67,1091,2115,3139,4,1028,2052,3076,66,1090,2114,3138,8193,8257,8321,8385,8449,8513,8577,8641,9217,9281,9345,9409,9473,9537,9601,9665,10241,10305,10369,10433,10497,10561,10625,10689,11265,11329,11393,11457,11521,11585,11649,11713,193,1217,2241,3265,3,1027,2051,3075,129,1153,2177,3201,4096,4160,4224,4288,4352,4416,4480,4544,5120,5184,5248,5312,5376,5440,5504,5568,6144,6208,6272,6336,6400,6464,6528,6592,7168,7232,7296,7360,7424,7488,7552,7616,2,1026,2050,3074,65,1089,2113,3137,8192,8256,8320,8384,8448,8512,8576,8640,9216,9280,9344,9408,9472,9536,9600,9664,10240,10304,10368,10432,10496,10560,10624,10688,11264,11328,11392,11456,11520,11584,11648,11712,192,1216,2240,3264,1,1025,2049,3073,128,1152,2176,3200,64,1088,2112,3136,0,1024,2048,3072};
#define IN(k) (lo <= (k) && (k) < hi)
#define LP() unsigned char* ws_ = p.ws; asm volatile("" : "+s"(ws_)); gptr ws = (gptr)ws_; LAS unsigned char* ldsl = (LAS unsigned char*)lds; asm volatile("" : "+s"(ldsl)); const int vb = lsg(vb0), nvb = lsg(nvb0); (void)ws; (void)vb; (void)nvb; (void)ldsl
#define SEAM(k) do { if (IN(k) && IN((k) + 1)) { XcdBarrier b2 = bar; asm volatile("" : "+s"(b2.bar), "+s"(b2.x)); xcd_barrier(b2); } } while (0)
#define NREP(bit) (1 + ((p.pad >> (bit)) & 1))
template <int l>
__device__ __forceinline__ void layer_body(const P& p, unsigned char* lds, const XcdBarrier& bar, int vb0, int nvb0, int lo, int hi) {
        const int base = 1 + 9 * l;
        if (IN(base + 0)) { LP(); if (l > 0) { for (int rep = 0, nr = NREP(10); rep < nr; ++rep) { ph_convert_early(p, ws, ldsl, vb, nvb, l); __syncthreads(); } } for (int rep = 0, nr = (l == 0 ? NREP(11) : 1); rep < nr; ++rep) { ph_norm1<l>(p, ws, ldsl, vb, nvb); __syncthreads(); } } SEAM(base + 0);
        if (IN(base + 1)) { LP();
            if (p.heavy & HV_INPROJ) for (int rep = 0, nr = NREP(0); rep < nr; ++rep) { pg8::SchedPlain S{(const GAS char*)(ws + WS_HB), (const GAS char*)(ws + WS_WIN), D, D, 64, 27, nvb, vb}; pg8::EpiInproj E{(GAS unsigned*)(ws + WS_CTL) + CW_INQ + 64 * l, (GAS bf16_t*)(ws + WS_Y), (GAS float*)(ws + WS_SSQ), (GAS unsigned*)(ws + WS_CTL) + CW_CMAX + 2048 * l, (GAS bf16_t*)(ws + WS_G)};
                pg8::gemm_phase<pg8::EpiInproj, pg8::SchedPlain, true>(ldsl, D, S, E); }
            if ((p.heavy & HV_MLAPROJ) && nvb == 256 && vb >= 192) {
                pg8::SchedPlainDep S{(const GAS char*)(ws + WS_Y) + C_MQ * 2, (const GAS char*)(ws + WS_WQ), YP, 384, 64, 3, 64, vb - 192, (const GAS unsigned*)(ws + WS_CTL) + CW_INQ + 64 * l, 2};
                pg8::EpiMlaQ E{(GAS bf16_t*)(ws + WS_QM), (const GAS float*)(ws + WS_SSQ)};
                pg8::gemm_phase<pg8::EpiMlaQ, pg8::SchedPlainDep, true>(ldsl, 384, S, E); }
        } SEAM(base + 1);
        if (IN(base + 2)) { LP();
            constexpr float LOG2E = 1.4426950408889634f;
            ph_krope(p, ws, vb, nvb);
            if (p.heavy & HV_MLAPROJ) for (int rep = 0, nr = NREP(1); rep < nr; ++rep) {
                if (nvb != 256) { pg8::SchedPlain S{(const GAS char*)(ws + WS_Y) + C_MQ * 2, (const GAS char*)(ws + WS_WQ), YP, 384, 64, 3, nvb, vb}; pg8::EpiMlaQ E{(GAS bf16_t*)(ws + WS_QM), (const GAS float*)(ws + WS_SSQ)};
                  pg8::gemm_phase<pg8::EpiMlaQ, pg8::SchedPlain, true>(ldsl, 384, S, E); }
                { pg8::SchedPlain S{(const GAS char*)(ws + WS_Y) + C_CKV * 2, (const GAS char*)(ws + WS_WKV), YP, 256, 64, 4, nvb, vb}; pg8::EpiMlaKV E{(GAS bf16_t*)(ws + WS_KM), (GAS bf16_t*)(ws + WS_VM), (const GAS float*)(ws + WS_SSQ)};
                  pg8::gemm_phase<pg8::EpiMlaKV, pg8::SchedPlain, true>(ldsl, 256, S, E); }
            }
            { const int tid_ = ltid();
              asm volatile("s_waitcnt vmcnt(0)" ::: "memory"); __builtin_amdgcn_s_barrier(); asm volatile("" ::: "memory");
              if (tid_ == 0) { __builtin_amdgcn_fence(__ATOMIC_RELEASE, "agent"); asm volatile("s_waitcnt vmcnt(0)" ::: "memory"); }
              if (tid_ == 0) __hip_atomic_fetch_add((GAS unsigned*)(ws + WS_CTL) + CW_MLAP + 64 * l, 1u, __ATOMIC_RELAXED, __HIP_MEMORY_SCOPE_AGENT); }
            {
                const float lam = ((const GAS float*)(ws + WS_CTL))[CW_LAM + l];
                GAS unsigned* qctr = (GAS unsigned*)(ws + WS_CTL) + CW_Q + 64 * l;
                GAS unsigned* mlap = (GAS unsigned*)(ws + WS_CTL) + CW_MLAP + 64 * l;
                LAS int* qslot = (LAS int*)(ldsl + 143360 + 64);
                const int tid_ = ltid();
                bool mla_ready = false;
                int u = vb;
                while (u < 1536 + CV_UNITS) {
                    unsigned nxt = 0u;
                    if (tid_ == 0) nxt = __hip_atomic_fetch_add(qctr, 1u, __ATOMIC_RELAXED, __HIP_MEMORY_SCOPE_AGENT);
                    const bool cvu = (u & 7) == 7 && (u >> 3) < CV_UNITS;
                    const int ncb = ((u + 1) >> 3) < CV_UNITS ? ((u + 1) >> 3) : CV_UNITS, ai_ = cvu ? 0 : u - ncb;
                    const int code = cvu ? (3 << 12) : __builtin_amdgcn_readfirstlane((int)ATT_ORDER[ai_]), ty = code >> 12, b = (code >> 10) & 3, h = (code >> 6) & 15, qb = code & 63;
                    if (ty == 3) { const int i0 = CV_EARLY + (u >> 3) * 64; ph_convert(p, ws, ldsl, l, i0 + (ltid() >> 6), 8, i0 + 64); }
                    else if (ty == 0) {
                        GAS bf16_t* Yb = (GAS bf16_t*)(ws + WS_Y) + (size_t)b * S * YP;
                        att::Args a; a.Q = Yb + (size_t)(qb * 128) * YP + C_DQ + h * 128; a.qp = YP; a.qgs = 64; a.K = Yb + C_DK + h * 128; a.kp = YP; a.kgs = 64; a.V = Yb + C_DV + h * 128; a.vp = YP;
                        a.O = Yb + (size_t)(qb * 128) * YP + C_DQ + h * 128; a.op = YP; a.q0 = qb * 128; a.jlo = 0; a.jhi = 2 * qb + 1; a.C = 0.125f * LOG2E; a.sl2 = exp2f(-2.f * (float)(h + 1)) * LOG2E;
                        a.relb = nullptr; a.rope = nullptr; a.lam = lam; a.osc = (l == 0) ? 0.8f : 0.64449093f; a.subln = INP(I_SUBLN) + l * 128;
                        a.cmax = (const GAS unsigned*)(ws + WS_CTL) + CW_CMAX + 2048 * l + b * 512 + h * 128;
                        att::Diff::unit(ldsl, a);
                    } else if (ty == 1) {
                        if (!mla_ready) {
                            if (tid_ == 0) { unsigned sp = 0; while (__hip_atomic_load(mlap, __ATOMIC_RELAXED, __HIP_MEMORY_SCOPE_AGENT) < (unsigned)nvb) { __builtin_amdgcn_s_sleep(2); if (++sp > (1u << 22)) break; } }
                            asm volatile("s_waitcnt vmcnt(0) lgkmcnt(0)" ::: "memory"); __builtin_amdgcn_s_barrier(); asm volatile("" ::: "memory");
                            __builtin_amdgcn_fence(__ATOMIC_ACQUIRE, "agent"); asm volatile("s_waitcnt vmcnt(0)" ::: "memory");
                            mla_ready = true;
                        }
                        att::Args a; a.Q = (const GAS bf16_t*)(ws + WS_QM) + (size_t)(b * S + qb * 256) * 768 + h * 96; a.qp = 768; a.qgs = 0;
                        a.K = (const GAS bf16_t*)(ws + WS_KM) + (size_t)b * S * 768 + h * 96; a.kp = 768; a.kgs = 0; a.V = (const GAS bf16_t*)(ws + WS_VM) + (size_t)b * S * 512 + h * 64; a.vp = 512;
                        a.O = (GAS bf16_t*)(ws + WS_Y) + (size_t)(b * S + qb * 256) * YP + C_MQ + h * 64; a.op = YP; a.q0 = qb * 256; a.jlo = 0; a.jhi = 4 * qb + 3; a.C = 0.10206207261596577f * LOG2E; a.sl2 = 0.f;
                        a.relb = nullptr; a.rope = (const GAS float*)(ws + WS_ROPE); a.lam = 0.f; a.osc = 0.f; a.subln = nullptr; a.cmax = nullptr;
                        att::Mla::unit(ldsl, a);
                    } else { const int c0 = 4 * qb;
                        GAS bf16_t* Yb = (GAS bf16_t*)(ws + WS_Y) + (size_t)b * S * YP;
                        att::Args a; a.Q = Yb + (size_t)(qb * 256) * YP + C_CQ + h * 64; a.qp = YP; a.qgs = 0; a.K = Yb + C_CK + h * 64; a.kp = YP; a.kgs = 0; a.V = Yb + C_CV + h * 64; a.vp = YP;
                        a.O = Yb + (size_t)(qb * 256) * YP + C_CQ + h * 64; a.op = YP; a.q0 = qb * 256; a.jlo = c0 - 8 < 0 ? 0 : c0 - 8; a.jhi = c0 + 3; a.C = 0.125f * LOG2E; a.sl2 = 0.f;
                        a.relb = INP(I_REL) + (size_t)(l * 8 + h) * 513; a.rope = nullptr; a.lam = 0.f; a.osc = 0.f; a.subln = nullptr; a.cmax = nullptr;
                        att::Band::unit(ldsl, a);
                    }
                    if (ltid() == 0) qslot[0] = nvb + (int)nxt;
                    asm volatile("s_waitcnt vmcnt(0) lgkmcnt(0)" ::: "memory"); __builtin_amdgcn_s_barrier(); asm volatile("" ::: "memory");
                    u = __builtin_amdgcn_readfirstlane(qslot[0]);
                    asm volatile("s_waitcnt lgkmcnt(0)" ::: "memory"); __builtin_amdgcn_s_barrier(); asm volatile("" ::: "memory");
                }
            }
        }
        if (IN(base + 3)) { } SEAM(base + 3);
        if (IN(base + 4)) { LP();
            if (p.heavy & HV_BRANCH) for (int rep = 0, nr = NREP(5); rep < nr; ++rep) { pg8::SchedBranch S{(const GAS char*)(ws + WS_Y), (const GAS char*)(ws + WS_WBR), nvb, vb}; pg8::EpiBranch E{(const GAS bf16_t*)(ws + WS_G), (GAS bf16_t*)(ws + WS_HB), (GAS unsigned*)(ws + WS_CTL) + CW_BRO + 64 * l};
                pg8::gemm_phase<pg8::EpiBranch, pg8::SchedBranch, true>(ldsl, 512, S, E); }
        }
        if (IN(base + 4)) { LP();
            if (p.heavy & HV_OUT) { pg8::SchedPlainDep S{(const GAS char*)(ws + WS_HB), (const GAS char*)(ws + WS_WOUT), D, D, 64, 4, nvb, vb, (const GAS unsigned*)(ws + WS_CTL) + CW_BRO + 64 * l, 4};
                pg8::EpiOut<(l > 0)> E{(GAS unsigned*)(ws + WS_CTL) + CW_OUT + 64 * l, l == 0 ? (const GAS void*)INP(I_X) : (const GAS void*)p.out, l == 0 ? (GAS bf16_t*)p.out : (GAS bf16_t*)(ws + WS_KM), (const GAS float*)(ws + WS_MOD) + (size_t)(l * 4) * 6144 + 2048};
                pg8::gemm_phase<pg8::EpiOut<(l > 0)>, pg8::SchedPlainDep, true>(ldsl, D, S, E); }
        }
        if (IN(base + 4)) { LP(); ph_router(p, ws, ldsl, vb, nvb, l, (const GAS unsigned*)(ws + WS_CTL) + CW_OUT + 64 * l); }
        if (IN(base + 5)) { } if (IN(base + 6)) { } SEAM(base + 6);
        if (IN(base + 7)) { LP();
            if (p.heavy & HV_GU) for (int rep = 0, nr = NREP(7); rep < nr; ++rep) { LAS int* tab = (LAS int*)(ldsl + 131072); moe_table(ws, tab, l);
                pg8::SchedMoe<true> S{(const GAS char*)(ws + WS_HB), (const GAS char*)(ws + WS_WGU), (const GAS int*)(ws + WS_LIST), tab, D, D, 4, nvb, vb, nullptr}; pg8::EpiGU E{(GAS bf16_t*)(ws + WS_HC), (GAS unsigned*)(ws + WS_CTL) + CW_GUD + 256 * l};
                pg8::gemm_phase<pg8::EpiGU, pg8::SchedMoe<true>, true>(ldsl, D, S, E); }
            if (p.heavy & HV_DOWN) for (int rep = 0, nr = NREP(8); rep < nr; ++rep) { LAS int* tab = (LAS int*)(ldsl + 131072); moe_table(ws, tab, l);
                pg8::SchedMoe<false> S{(const GAS char*)(ws + WS_HC), (const GAS char*)(ws + WS_WD), (const GAS int*)(ws + WS_LIST), tab, FF, FF, 4, nvb, vb, (GAS unsigned*)(ws + WS_CTL) + CW_GUD + 256 * l}; pg8::EpiDown E{(GAS bf16_t*)(ws + WS_OS), (const GAS int*)(ws + WS_LIST)};
                pg8::gemm_phase<pg8::EpiDown, pg8::SchedMoe<false>, true>(ldsl, FF, S, E); }
        }
        if (IN(base + 8)) { } SEAM(base + 8);
}
__global__ void __launch_bounds__(512, 2) mega(P p) {
    extern __shared__ __attribute__((aligned(16))) unsigned char lds[];
    const int tid = threadIdx.x;
    volatile LAS unsigned* misc = (volatile LAS unsigned*)((LAS unsigned char*)lds + MISC_OFF);
    if (tid < 4) misc[tid] = 0u;
    __syncthreads();
    XcdBarrier bar = xcd_barrier_post((unsigned*)(p.ws + WS_CTL) + CW_BAR, misc);
    const int vb0 = blockIdx.x, nvb0 = gridDim.x;
    const int lo = p.ph_lo, hi = p.ph_hi;
    if (IN(0)) { LP(); for (int rep = 0, nr = NREP(12); rep < nr; ++rep) { ph0(p, ws, ldsl, vb, nvb); __syncthreads(); } for (int rep = 0, nr = NREP(10); rep < nr; ++rep) { ph_convert_early(p, ws, ldsl, vb, nvb, 0); __syncthreads(); } } SEAM(0);
    layer_body<0>(p, lds, bar, vb0, nvb0, lo, hi);
    layer_body<1>(p, lds, bar, vb0, nvb0, lo, hi);
    if (IN(19)) { LP(); ph_norm1<2>(p, ws, ldsl, vb, nvb); }
#undef IN
#undef SEAM
}

struct RowPlain { int M; __device__ int rows() const { return M; } __device__ int src(int m) const { return m; } };
struct RowList { const unsigned* cnt; const int* list; __device__ int rows() const { return (int)*cnt; } __device__ int src(int m) const { return list[m] >> 1; } };
struct RowCompact { const unsigned* cnts; int e; __device__ int rows() const { return (int)cnts[e]; }
    __device__ int base() const { int b = 0; for (int i = 0; i < e; ++i) b += ((int)cnts[i] + 255) / 256 * 256; return b; }
    __device__ int src(int m) const { return base() + m; } };

template <class RowMap, class Epi>
__global__ __launch_bounds__(256) void naive_gemm(const bf16_t* A, int lda, RowMap rm, const float* W, int ldw, int K, int N, const float* kscale, Epi epi) {
    const int M = rm.rows();
    const int m0 = blockIdx.y * 64, n0 = blockIdx.x * 64;
    if (m0 >= M) return;
    __shared__ float As[16][65];
    __shared__ float Ws[16][64];
    const int tid = threadIdx.x, tx = tid & 15, ty = tid >> 4;
    float acc[4][4];
#pragma unroll
    for (int i = 0; i < 4; ++i)
#pragma unroll
        for (int j = 0; j < 4; ++j) acc[i][j] = 0.f;
    const int ar = tid >> 2, akq = (tid & 3) * 4;
    const int grow = m0 + ar;
    const int srow = grow < M ? rm.src(grow) : rm.src(0);
    const int wk = tid >> 4, wn = (tid & 15) * 4;
    for (int k0 = 0; k0 < K; k0 += 16) {
        const u32x2 a = *(const u32x2*)(A + (size_t)srow * lda + k0 + akq);
        float a0 = bflo(a.x), a1 = bfhi(a.x), a2 = bflo(a.y), a3 = bfhi(a.y);
        if (kscale) { a0 *= kscale[k0 + akq]; a1 *= kscale[k0 + akq + 1]; a2 *= kscale[k0 + akq + 2]; a3 *= kscale[k0 + akq + 3]; }
        As[akq][ar] = a0; As[akq + 1][ar] = a1; As[akq + 2][ar] = a2; As[akq + 3][ar] = a3;
        f32x4 w = {0.f, 0.f, 0.f, 0.f};
        if (n0 + wn < N) w = *(const f32x4*)(W + (size_t)(k0 + wk) * ldw + n0 + wn);
        *(f32x4*)&Ws[wk][wn] = w;
        __syncthreads();
#pragma unroll
        for (int kk = 0; kk < 16; ++kk) {
            float av[4], wv[4];
#pragma unroll
            for (int i = 0; i < 4; ++i) { av[i] = As[kk][ty * 4 + i]; wv[i] = Ws[kk][tx * 4 + i]; }
#pragma unroll
            for (int i = 0; i < 4; ++i)
#pragma unroll
                for (int j = 0; j < 4; ++j) acc[i][j] += av[i] * wv[j];
        }
        __syncthreads();
    }
#pragma unroll
    for (int i = 0; i < 4; ++i)
#pragma unroll
        for (int j = 0; j < 4; ++j) { const int row = m0 + ty * 4 + i, col = n0 + tx * 4 + j; if (row < M && col < N) epi(row, col, acc[i][j]); }
}

struct NEpiInproj { bf16_t* Y; __device__ void operator()(int row, int col, float v) const {
    const int yc = col < 3744 ? col : col + 96; if (col >= 3744) v = sigmoidf_(v); Y[(size_t)row * YP + yc] = (bf16_t)f2bf(v); } };
struct NEpiMlaQ { bf16_t* Qm; const float* ssq; __device__ void operator()(int row, int col, float v) const {
    float s = 0.f; for (int i = 0; i < 12; ++i) s += ssq[row * 24 + i];
    Qm[(size_t)row * 768 + col] = (bf16_t)f2bf(v * rsqrtf(s * (1.f / 384.f) + EPS)); } };
struct NEpiMlaKV { bf16_t* Km; bf16_t* Vm; const float* ssq; __device__ void operator()(int row, int col, float v) const {
    float s = 0.f; for (int i = 12; i < 20; ++i) s += ssq[row * 24 + i];
    v *= rsqrtf(s * (1.f / 256.f) + EPS); const int h = col >> 7, d = col & 127;
    if (d < 64) Km[(size_t)row * 768 + h * 96 + d] = (bf16_t)f2bf(v); else Vm[(size_t)row * 512 + h * 64 + d - 64] = (bf16_t)f2bf(v); } };
struct NEpiBranch { const bf16_t* Y; bf16_t* MG; int br; __device__ void operator()(int row, int col, float v) const {
    const float g = bf2f(Y[(size_t)row * YP + C_G + br * 1024 + col]); float m = g * v; if (br) m += bf2f(MG[(size_t)row * D + col]); MG[(size_t)row * D + col] = (bf16_t)f2bf(m); } };
struct NEpiOut { const float* xcur; float* xo; const float* mod; int layer; __device__ void operator()(int row, int col, float v) const {
    const int b = row >> 12; xo[(size_t)row * D + col] = xcur[(size_t)row * D + col] + mod[(size_t)(layer * 4 + b) * 6144 + 2048 + col] * v; } };
struct NEpiGate { bf16_t* HC; RowCompact rc; __device__ void operator()(int row, int col, float v) const {
    HC[(size_t)(rc.base() + row) * FF + col] = (bf16_t)f2bf(v / (1.f + __expf(-v))); } };
struct NEpiUp { bf16_t* HC; RowCompact rc; __device__ void operator()(int row, int col, float v) const {
    const size_t o = (size_t)(rc.base() + row) * FF + col; HC[o] = (bf16_t)f2bf(bf2f(HC[o]) * v); } };
struct NEpiDown { bf16_t* OS; const int* list; __device__ void operator()(int row, int col, float v) const {
    OS[(size_t)list[row] * D + col] = (bf16_t)f2bf(v); } };

__global__ __launch_bounds__(256) void naive_ssq(const bf16_t* Y, float* ssq) {
    const int row = blockIdx.x * 4 + (threadIdx.x >> 6), lane = threadIdx.x & 63;
    float sq = 0.f, sk = 0.f;
    for (int i = lane; i < 384; i += 64) { const float v = bf2f(Y[(size_t)row * YP + C_MQ + i]); sq += v * v; }
    for (int i = lane; i < 256; i += 64) { const float v = bf2f(Y[(size_t)row * YP + C_CKV + i]); sk += v * v; }
    sq = wave_sum(sq); sk = wave_sum(sk);
    if (lane < 24) ssq[row * 24 + lane] = lane == 0 ? sq : lane == 12 ? sk : 0.f;
}

template <int DQK, int DV, int MODE>
__device__ __forceinline__ void attn_row(const float* q, const bf16_t* Kb, int kp, const bf16_t* Vb, int vp, int klo, int khi, float scale,
                                         int qpos, float slope, const float* relt, float (&res)[DV / 64]) {
    const int lane = threadIdx.x & 63;
    float m = -1e30f, l = 0.f, o[DV];
#pragma unroll
    for (int d = 0; d < DV; ++d) o[d] = 0.f;
    for (int k = klo + lane; k < khi; k += 64) {
        const bf16_t* kr = Kb + (size_t)k * kp;
        float s = 0.f;
#pragma unroll
        for (int c = 0; c < DQK / 8; ++c) {
            const u32x4 w = *(const u32x4*)(kr + c * 8);
            s += q[c * 8 + 0] * bflo(w.x) + q[c * 8 + 1] * bfhi(w.x) + q[c * 8 + 2] * bflo(w.y) + q[c * 8 + 3] * bfhi(w.y)
               + q[c * 8 + 4] * bflo(w.z) + q[c * 8 + 5] * bfhi(w.z) + q[c * 8 + 6] * bflo(w.w) + q[c * 8 + 7] * bfhi(w.w);
        }
        s *= scale;
        if (MODE == 0) s -= slope * fabsf((float)(qpos - k));
        if (MODE == 1) { int rel = qpos - k; rel = rel < -256 ? -256 : rel > 256 ? 256 : rel; s += relt[rel + 256]; }
        const float mn = fmaxf(m, s), al = __expf(m - mn), pe = __expf(s - mn);
        m = mn; l = l * al + pe;
        const bf16_t* vr = Vb + (size_t)k * vp;
#pragma unroll
        for (int c = 0; c < DV / 8; ++c) {
            const u32x4 w = *(const u32x4*)(vr + c * 8);
            o[c * 8 + 0] = o[c * 8 + 0] * al + pe * bflo(w.x); o[c * 8 + 1] = o[c * 8 + 1] * al + pe * bfhi(w.x);
            o[c * 8 + 2] = o[c * 8 + 2] * al + pe * bflo(w.y); o[c * 8 + 3] = o[c * 8 + 3] * al + pe * bfhi(w.y);
            o[c * 8 + 4] = o[c * 8 + 4] * al + pe * bflo(w.z); o[c * 8 + 5] = o[c * 8 + 5] * al + pe * bfhi(w.z);
            o[c * 8 + 6] = o[c * 8 + 6] * al + pe * bflo(w.w); o[c * 8 + 7] = o[c * 8 + 7] * al + pe * bfhi(w.w);
        }
    }
    const float M = wave_max(m), f = __expf(m - M);
    const float L = wave_sum(l * f), inv = 1.f / L;
#pragma unroll
    for (int i = 0; i < DV / 64; ++i) res[i] = 0.f;
#pragma unroll
    for (int d = 0; d < DV; ++d) { const float v = wave_sum(o[d] * f) * inv; if ((d & 63) == lane) res[d >> 6] = v; }
}

__global__ __launch_bounds__(64) void naive_attn_diff(bf16_t* Y, const float* lamp, const float* subln, float lam_init) {
    const int t = blockIdx.x >> 2, h = blockIdx.x & 3, b = t >> 12, pos = t & (S - 1), lane = threadIdx.x;
    const float slope = exp2f(-2.f * (float)(h + 1));
    const int khi = ((pos >> 6) + 1) * 64;
    const bf16_t* Yb = Y + (size_t)b * S * YP;
    float r0[2], r1[2], q[64];
    for (int mp = 0; mp < 2; ++mp) {
#pragma unroll
        for (int d = 0; d < 64; ++d) q[d] = bf2f(Y[(size_t)t * YP + C_DQ + h * 128 + mp * 64 + d]);
        if (mp == 0) attn_row<64, 128, 0>(q, Yb + C_DK + h * 128, YP, Yb + C_DV + h * 128, YP, 0, khi, 0.125f, pos, slope, nullptr, r0);
        else attn_row<64, 128, 0>(q, Yb + C_DK + h * 128 + 64, YP, Yb + C_DV + h * 128, YP, 0, khi, 0.125f, pos, slope, nullptr, r1);
    }
    const float lam = *lamp;
    const float y0 = r0[0] - lam * r1[0], y1 = r0[1] - lam * r1[1];
    const float rstd = rsqrtf(wave_sum(y0 * y0 + y1 * y1) * (1.f / 128.f) + EPS);
    Y[(size_t)t * YP + C_DQ + h * 128 + lane] = (bf16_t)f2bf(y0 * rstd * subln[lane] * (1.f - lam_init));
    Y[(size_t)t * YP + C_DQ + h * 128 + 64 + lane] = (bf16_t)f2bf(y1 * rstd * subln[64 + lane] * (1.f - lam_init));
}
__global__ __launch_bounds__(64) void naive_attn_band(bf16_t* Y, const float* rel) {
    const int t = blockIdx.x >> 3, h = blockIdx.x & 7, b = t >> 12, pos = t & (S - 1), lane = threadIdx.x;
    const int ch = pos >> 6, klo = (ch - 8 < 0 ? 0 : ch - 8) * 64, khi = (ch + 1) * 64;
    const bf16_t* Yb = Y + (size_t)b * S * YP;
    float q[64], r[1];
#pragma unroll
    for (int d = 0; d < 64; ++d) q[d] = bf2f(Y[(size_t)t * YP + C_CQ + h * 64 + d]);
    attn_row<64, 64, 1>(q, Yb + C_CK + h * 64, YP, Yb + C_CV + h * 64, YP, klo, khi, 0.125f, pos, 0.f, rel + h * 513, r);
    Y[(size_t)t * YP + C_CQ + h * 64 + lane] = (bf16_t)f2bf(r[0]);
}
__global__ __launch_bounds__(64) void naive_attn_mla(const bf16_t* Qm, const bf16_t* Km, const bf16_t* Vm, const float* rope, bf16_t* Y) {
    const int t = blockIdx.x >> 3, h = blockIdx.x & 7, b = t >> 12, pos = t & (S - 1), lane = threadIdx.x;
    const int khi = ((pos >> 6) + 1) * 64;
    float q[96], r[1];
#pragma unroll
    for (int d = 0; d < 96; ++d) q[d] = bf2f(Qm[(size_t)t * 768 + h * 96 + d]);
#pragma unroll
    for (int f = 0; f < 16; ++f) { const float c = rope[(pos * 16 + f) * 2], s = rope[(pos * 16 + f) * 2 + 1]; const float x1 = q[64 + f], x2 = q[80 + f];
        q[64 + f] = bf2f(f2bf(x1 * c - x2 * s)); q[80 + f] = bf2f(f2bf(x1 * s + x2 * c)); }
    attn_row<96, 64, 2>(q, Km + (size_t)b * S * 768 + h * 96, 768, Vm + (size_t)b * S * 512 + h * 64, 512, 0, khi, 0.10206207261596577f, pos, 0.f, nullptr, r);
    Y[(size_t)t * YP + C_MQ + h * 64 + lane] = (bf16_t)f2bf(r[0]);
}

#ifndef REP_MASK
#define REP_MASK 0
#endif
#ifndef ONE_LAUNCH
#define ONE_LAUNCH 1
#endif
#ifndef HEAVY_MASK
#define HEAVY_MASK (HV_INPROJ | HV_MLAPROJ | HV_BRANCH | HV_OUT | HV_GU | HV_DOWN | HV_DIFF | HV_BAND | HV_MLAATT)
#endif
static void launch_mega(const P& base, int lo, int hi, int heavy, int grid, hipStream_t stream) {
    P a = base; a.ph_lo = lo; a.ph_hi = hi; a.heavy = heavy; a.pad = REP_MASK;
    hipLaunchKernelGGL(mega, dim3(grid), dim3(512), LDS_BYTES, stream, a);
}

extern "C" void kernel_launch(void* const* d_in, const int* in_sizes, int n_in, void* d_out, int out_size, void* d_ws, size_t ws_size, hipStream_t stream) {
    static int grid = 0;
    if (grid == 0) {
        if (n_in != 27 || out_size != T * D || ws_size < WS_END) { fprintf(stderr, "kernel_launch: bad shapes n_in %d out %d ws %zu (need %zu)\n", n_in, out_size, ws_size, (size_t)WS_END); grid = -1; return; }
        int dev = 0, cus = 0;
        hipGetDevice(&dev); hipDeviceGetAttribute(&cus, hipDeviceAttributeMultiprocessorCount, dev);
        if (hipFuncSetAttribute((const void*)mega, hipFuncAttributeMaxDynamicSharedMemorySize, LDS_BYTES) != hipSuccess) { fprintf(stderr, "hipFuncSetAttribute failed\n"); grid = -1; return; }
        grid = cus > 0 ? cus : 256;
    }
    if (grid < 0) return;
    hipMemsetAsync((char*)d_ws + WS_CTL, 0, CTL_BYTES, stream);
    P p{};
    for (int i = 0; i < 27; ++i) p.in[i] = (const float*)d_in[i];
    p.out = (float*)d_out; p.ws = (unsigned char*)d_ws;
    unsigned char* ws = (unsigned char*)d_ws;
    bf16_t* Y = (bf16_t*)(ws + WS_Y); bf16_t* HB = (bf16_t*)(ws + WS_HB); bf16_t* KM = (bf16_t*)(ws + WS_KM); bf16_t* VM = (bf16_t*)(ws + WS_VM);
    bf16_t* HC = (bf16_t*)(ws + WS_HC); bf16_t* OS = (bf16_t*)(ws + WS_OS);
    float* SSQ = (float*)(ws + WS_SSQ); const float* MOD = (const float*)(ws + WS_MOD); const float* ROPE = (const float*)(ws + WS_ROPE);
    const int* LIST = (const int*)(ws + WS_LIST);
    const int HM = HEAVY_MASK;
    constexpr int ALLHV = HV_INPROJ | HV_MLAPROJ | HV_BRANCH | HV_OUT | HV_GU | HV_DOWN | HV_DIFF | HV_BAND | HV_MLAATT;
    if (HM == ALLHV && ONE_LAUNCH) { launch_mega(p, 0, NPHASE, HM, grid, stream); return; }
    launch_mega(p, 0, 1, HM, grid, stream);
    for (int l = 0; l < NL; ++l) {
        const int base = 1 + 9 * l;
        launch_mega(p, base, base + 1, HM, grid, stream);
        if (HM & HV_INPROJ) launch_mega(p, base + 1, base + 2, HM, grid, stream);
        else {
            hipLaunchKernelGGL((naive_gemm<RowPlain, NEpiInproj>), dim3(107, 256), dim3(256), 0, stream, HB, D, RowPlain{T}, p.in[I_WIN] + (size_t)l * D * INW, INW, D, INW, (const float*)nullptr, NEpiInproj{Y});
            hipLaunchKernelGGL(naive_ssq, dim3(T / 4), dim3(256), 0, stream, Y, SSQ);
        }
        launch_mega(p, base + 2, base + 3, HM, grid, stream);
        if (!(HM & HV_MLAPROJ)) {
            hipLaunchKernelGGL((naive_gemm<RowPlain, NEpiMlaQ>), dim3(12, 256), dim3(256), 0, stream, Y + C_MQ, YP, RowPlain{T}, p.in[I_WQB] + (size_t)l * 384 * 768, 768, 384, 768, p.in[I_QNG] + l * 384, NEpiMlaQ{HB, SSQ});
            hipLaunchKernelGGL((naive_gemm<RowPlain, NEpiMlaKV>), dim3(16, 256), dim3(256), 0, stream, Y + C_CKV, YP, RowPlain{T}, p.in[I_WKVB] + (size_t)l * 256 * 1024, 1024, 256, 1024, p.in[I_KVNG] + l * 256, NEpiMlaKV{KM, VM, SSQ});
        }
        const float lam_init = 0.8f - 0.6f * expf(-0.3f * (float)l);
        if (!(HM & HV_DIFF)) hipLaunchKernelGGL(naive_attn_diff, dim3(T * 4), dim3(64), 0, stream, Y, (const float*)(ws + WS_CTL) + CW_LAM + l, p.in[I_SUBLN] + l * 128, lam_init);
        if (!(HM & HV_BAND)) hipLaunchKernelGGL(naive_attn_band, dim3(T * 8), dim3(64), 0, stream, Y, p.in[I_REL] + (size_t)l * 8 * 513);
        if (HM & HV_MLAATT) launch_mega(p, base + 3, base + 4, HM, grid, stream);
        else hipLaunchKernelGGL(naive_attn_mla, dim3(T * 8), dim3(64), 0, stream, HB, KM, VM, ROPE, Y);
        if (HM & HV_BRANCH) launch_mega(p, base + 4, base + 5, HM, grid, stream);
        else {
            const float* wbr[3] = {p.in[I_WBD], p.in[I_WBC], p.in[I_WBM]}; const int acol[3] = {C_DQ, C_CQ, C_MQ};
            for (int br = 0; br < 3; ++br)
                hipLaunchKernelGGL((naive_gemm<RowPlain, NEpiBranch>), dim3(16, 256), dim3(256), 0, stream, Y + acol[br], YP, RowPlain{T}, wbr[br] + (size_t)l * 512 * D, D, 512, D, (const float*)nullptr, NEpiBranch{Y, HB, br});
        }
        if (HM & HV_OUT) launch_mega(p, base + 5, base + 6, HM, grid, stream);
        else hipLaunchKernelGGL((naive_gemm<RowPlain, NEpiOut>), dim3(16, 256), dim3(256), 0, stream, HB, D, RowPlain{T}, p.in[I_WOUT] + (size_t)l * D * D, D, D, D, (const float*)nullptr,
                           NEpiOut{l == 0 ? p.in[I_X] : (const float*)p.out, p.out, MOD, l});
        launch_mega(p, base + 6, base + 7, HM, grid, stream);
        const unsigned* cnts = (const unsigned*)(ws + WS_CTL) + CW_CNT + 64 * l;
        if (HM & HV_GU) launch_mega(p, base + 7, base + 8, HM, grid, stream);
        else for (int e = 0; e < NE; ++e) {
            const size_t wo = ((size_t)l * NE + e) * D * FF;
            hipLaunchKernelGGL((naive_gemm<RowList, NEpiGate>), dim3(8, 256), dim3(256), 0, stream, HB, D, RowList{cnts + e, LIST + e * 16384}, p.in[I_WEG] + wo, FF, D, FF, (const float*)nullptr, NEpiGate{HC, RowCompact{cnts, e}});
            hipLaunchKernelGGL((naive_gemm<RowList, NEpiUp>), dim3(8, 256), dim3(256), 0, stream, HB, D, RowList{cnts + e, LIST + e * 16384}, p.in[I_WEU] + wo, FF, D, FF, (const float*)nullptr, NEpiUp{HC, RowCompact{cnts, e}});
        }
        if (HM & HV_DOWN) launch_mega(p, base + 8, base + 9, HM, grid, stream);
        else for (int e = 0; e < NE; ++e) {
            const size_t wo = ((size_t)l * NE + e) * D * FF;
            hipLaunchKernelGGL((naive_gemm<RowCompact, NEpiDown>), dim3(16, 256), dim3(256), 0, stream, HC, FF, RowCompact{cnts, e}, p.in[I_WED] + wo, D, FF, D, (const float*)nullptr, NEpiDown{OS, LIST + e * 16384});
        }
    }
    launch_mega(p, 19, 20, 0, grid, stream);
}
```
